# Optimizing an MI355X kernel written in HIP

```python
import math
import jax, jax.numpy as jnp
from jax import lax
import numpy as np

D_MODEL = 1024
BATCH = 32
SEQ = 2048
DEPTH = 4
DEC_BATCH = 8
DEC_SEQ = 2048
PAST_LEN = 128

GRID_W = 64
HEAD_DIM = 64
N_MIXERS = 4
GROUP_W = D_MODEL // N_MIXERS
N_HEADS_G = GROUP_W // HEAD_DIM
N_KV = 2
REP = N_HEADS_G // N_KV
KV_W = N_KV * HEAD_DIM
D_MIX = N_MIXERS * GROUP_W
RWKV_DECAY_RANK = 64
RWKV_A_RANK = 64
RWKV_SHIFT_W = 3 * GROUP_W + RWKV_DECAY_RANK + RWKV_A_RANK
LRU_C = 8.0
LRU_BLOCKS = 4
LRU_BLK = GROUP_W // LRU_BLOCKS
CONV_W = 4
CONV_LEFT = 2
Q_BLOCK = 128
WINDOW = 128
ROPE_THETA = 10000.0
NORM_EPS = 1e-6
GN_EPS = 64e-5
NEG = -1e30
A_W = RWKV_SHIFT_W + GROUP_W
B_W = GROUP_W + 2 * KV_W + GROUP_W
C_W = 2 * GROUP_W
D_W = GROUP_W + 2 * KV_W + GROUP_W
D_IN = A_W + B_W + C_W + D_W

kernel_name = "hybrid_bidir_parallel_heads_encoder"


def _rmsnorm(x, g, eps=NORM_EPS):
    xf = x.astype(jnp.float32)
    return xf * lax.rsqrt(jnp.mean(xf * xf, -1, keepdims=True) + eps) * g.astype(jnp.float32)


def _rwkv_scan(r, w, k, v, kk, a, reverse):
    xs = tuple(jnp.moveaxis(t, 1, 0) for t in (r, w, k, v, kk, a))
    bsz, nh, n = r.shape[0], r.shape[2], r.shape[3]

    def step(S, inp):
        rt, wt, kt, vt, kkt, at = inp
        sk = jnp.einsum('bhij,bhj->bhi', S, kkt)
        S = S * wt[:, :, None, :] - sk[..., None] * (kkt * at)[:, :, None, :] + vt[..., None] * kt[:, :, None, :]
        return S, jnp.einsum('bhij,bhj->bhi', S, rt)

    S0 = jnp.zeros((bsz, nh, n, n), jnp.float32)
    _, y = lax.scan(step, S0, xs, reverse=reverse)
    return jnp.moveaxis(y, 0, 1)


def _rwkv_mixer(z, shift, w0, w_up, a0, a_up, k_k, k_a, r_k, ln_g, ln_b):
    b_, t_, _ = z.shape
    xs = z[..., :RWKV_SHIFT_W]
    gate = z[..., RWKV_SHIFT_W:]
    prev = jnp.pad(xs, ((0, 0), (1, 0), (0, 0)))[:, :t_]
    nxt = jnp.pad(xs, ((0, 0), (0, 1), (0, 0)))[:, 1:]
    xs = xs + shift[0] * (prev - xs) + shift[1] * (nxt - xs)
    r = xs[..., :GROUP_W]
    k = xs[..., GROUP_W:2 * GROUP_W]
    v = xs[..., 2 * GROUP_W:3 * GROUP_W]
    wl = jnp.tanh(xs[..., 3 * GROUP_W:3 * GROUP_W + RWKV_DECAY_RANK])
    al = xs[..., 3 * GROUP_W + RWKV_DECAY_RANK:]
    hd = lambda t: t.reshape(b_, t_, N_HEADS_G, HEAD_DIM)
    kk = hd(k * k_k)
    kk = kk / jnp.maximum(jnp.sqrt(jnp.sum(kk * kk, -1, keepdims=True)), 1e-12)
    y = jnp.zeros((b_, t_, N_HEADS_G, HEAD_DIM), jnp.float32)
    ksum = jnp.zeros_like(k)
    for d, rev in ((0, False), (1, True)):
        logw = -jnp.exp(-jax.nn.softplus(-(w0[d] + wl @ w_up[d])) - 0.5)
        a = jax.nn.sigmoid(a0[d] + al @ a_up[d])
        kd = k * (1.0 + (a - 1.0) * k_a)
        y = y + _rwkv_scan(hd(r), hd(jnp.exp(logw)), hd(kd), hd(v), kk, hd(a), rev)
        ksum = ksum + kd
    mu = jnp.mean(y, -1, keepdims=True)
    var = jnp.mean(jnp.square(y - mu), -1, keepdims=True)
    y = ((y - mu) * lax.rsqrt(var + GN_EPS)).reshape(b_, t_, GROUP_W) * ln_g + ln_b
    bonus = jnp.sum(hd(r) * hd(ksum) * r_k, -1, keepdims=True) * hd(v)
    y = y + bonus.reshape(b_, t_, GROUP_W)
    return y * jax.nn.silu(gate)


def _axial_angles(t_):
    rows = t_ // GRID_W
    row = jnp.repeat(jnp.arange(rows), GRID_W).astype(jnp.float32)
    col = jnp.tile(jnp.arange(GRID_W), rows).astype(jnp.float32)
    half = HEAD_DIM // 2
    inv = ROPE_THETA ** (-jnp.arange(0, half, 2, dtype=jnp.float32) / half)
    return row[:, None] * inv, col[:, None] * inv


def _rope_half(x, ang):
    n = x.shape[-1] // 2
    c = jnp.cos(ang)[:, None, :]
    s = jnp.sin(ang)[:, None, :]
    x1, x2 = x[..., :n], x[..., n:]
    return jnp.concatenate([x1 * c - x2 * s, x1 * s + x2 * c], -1)


def _axial_rope(x, ang_r, ang_c):
    h = HEAD_DIM // 2
    return jnp.concatenate([_rope_half(x[..., :h], ang_r), _rope_half(x[..., h:], ang_c)], -1)


def _global_attn_mixer(z, q_norm, k_norm):
    b_, t_, _ = z.shape
    q = z[..., :GROUP_W].reshape(b_, t_, N_HEADS_G, HEAD_DIM)
    k = z[..., GROUP_W:GROUP_W + KV_W].reshape(b_, t_, N_KV, HEAD_DIM)
    v = z[..., GROUP_W + KV_W:GROUP_W + 2 * KV_W].reshape(b_, t_, N_KV, HEAD_DIM)
    gate = z[..., GROUP_W + 2 * KV_W:]
    ang_r, ang_c = _axial_angles(t_)
    q = _axial_rope(_rmsnorm(q, q_norm), ang_r, ang_c)
    k = _axial_rope(_rmsnorm(k, k_norm), ang_r, ang_c)
    scale = HEAD_DIM ** -0.5
    nb = t_ // Q_BLOCK
    qb = q.reshape(b_, nb, Q_BLOCK, N_KV, REP, HEAD_DIM).transpose(1, 0, 2, 3, 4, 5)

    def block(qi):
        s = jnp.einsum('bqgrd,bkgd->bgrqk', qi, k) * scale
        p = jax.nn.softmax(s, axis=-1)
        return jnp.einsum('bgrqk,bkgd->bqgrd', p, v)

    o = lax.map(block, qb)
    o = o.transpose(1, 0, 2, 3, 4, 5).reshape(b_, t_, GROUP_W)
    return o * jax.nn.silu(gate)


def _lin_comb(e1, e2):
    a1, b1 = e1
    a2, b2 = e2
    return a1 * a2, a2 * b1 + b2


def _rglru_mixer(z, conv_w, conv_b, gate_w, gate_b, lam):
    b_, t_, _ = z.shape
    xb = z[..., :GROUP_W]
    gate = z[..., GROUP_W:]
    xp = jnp.pad(xb, ((0, 0), (CONV_LEFT, CONV_W - 1 - CONV_LEFT), (0, 0)))
    xc = conv_b + sum(conv_w[j] * xp[:, j:j + t_] for j in range(CONV_W))
    xh = xc.reshape(b_, t_, LRU_BLOCKS, LRU_BLK)
    h = jnp.zeros_like(xc)
    for d, rev in ((0, False), (1, True)):
        g = jnp.einsum('btnd,knde->kbtne', xh, gate_w[d]).reshape(2, b_, t_, GROUP_W) + gate_b[d][:, None, None, :]
        r = jax.nn.sigmoid(g[0])
        i = jax.nn.sigmoid(g[1])
        log_a = -LRU_C * r * jax.nn.softplus(-lam[d])
        a = jnp.exp(log_a)
        bterm = jnp.sqrt(-jnp.expm1(2.0 * log_a)) * (i * xc)
        _, hd = lax.associative_scan(_lin_comb, (a, bterm), axis=1, reverse=rev)
        h = h + hd
    return h * jax.nn.silu(gate)


def _window_attn_mixer(z, sink):
    b_, t_, _ = z.shape
    q = z[..., :GROUP_W].reshape(b_, t_, N_KV, REP, HEAD_DIM)
    k = z[..., GROUP_W:GROUP_W + KV_W].reshape(b_, t_, N_KV, HEAD_DIM)
    v = z[..., GROUP_W + KV_W:GROUP_W + 2 * KV_W].reshape(b_, t_, N_KV, HEAD_DIM)
    gate = z[..., GROUP_W + 2 * KV_W:]
    nb = t_ // Q_BLOCK
    pad = ((0, 0), (WINDOW, WINDOW), (0, 0), (0, 0))
    kp = jnp.pad(k, pad).reshape(b_, nb + 2, Q_BLOCK, N_KV, HEAD_DIM)
    vp = jnp.pad(v, pad).reshape(b_, nb + 2, Q_BLOCK, N_KV, HEAD_DIM)
    kw = jnp.concatenate([kp[:, :-2], kp[:, 1:-1], kp[:, 2:]], axis=2)
    vw = jnp.concatenate([vp[:, :-2], vp[:, 1:-1], vp[:, 2:]], axis=2)
    qb = q.reshape(b_, nb, Q_BLOCK, N_KV, REP, HEAD_DIM)
    s = jnp.einsum('bnqgrd,bnkgd->bngrqk', qb, kw) * (HEAD_DIM ** -0.5)
    qpos = jnp.arange(nb)[:, None] * Q_BLOCK + jnp.arange(Q_BLOCK)[None]
    kpos = jnp.arange(nb)[:, None] * Q_BLOCK - WINDOW + jnp.arange(3 * Q_BLOCK)[None]
    dist = jnp.abs(kpos[:, None, :] - qpos[:, :, None])
    valid = (dist <= WINDOW) & (kpos >= 0)[:, None, :] & (kpos < t_)[:, None, :]
    slopes = jnp.exp2(-8.0 * jnp.arange(1, N_HEADS_G + 1, dtype=jnp.float32) / N_HEADS_G).reshape(N_KV, REP)
    bias = -slopes[None, :, :, None, None] * dist[:, None, None].astype(jnp.float32)
    s = jnp.where(valid[None, :, None, None], s + bias[None], NEG)
    sink_l = sink.astype(jnp.float32).reshape(N_KV, REP)[None, None, :, :, None, None]
    m = jnp.maximum(jnp.max(s, -1, keepdims=True), sink_l)
    p = jnp.exp(s - m)
    p = p / (jnp.sum(p, -1, keepdims=True) + jnp.exp(sink_l - m))
    o = jnp.einsum('bngrqk,bnkgd->bnqgrd', p, vw).reshape(b_, t_, GROUP_W)
    return o * jax.nn.silu(gate)


def _trunk(x, p):
    for l in range(DEPTH):
        h = _rmsnorm(x, p['norm_g'][l])
        zz = h @ p['w_in'][l].astype(jnp.float32)
        zA = zz[..., :A_W]
        zB = zz[..., A_W:A_W + B_W]
        zC = zz[..., A_W + B_W:A_W + B_W + C_W]
        zD = zz[..., A_W + B_W + C_W:]
        oA = _rwkv_mixer(zA, p['rwkv_shift'][l], p['rwkv_w0'][l], p['rwkv_w_up'][l], p['rwkv_a0'][l],
                         p['rwkv_a_up'][l], p['rwkv_k_k'][l], p['rwkv_k_a'][l], p['rwkv_r_k'][l],
                         p['rwkv_ln_g'][l], p['rwkv_ln_b'][l])
        oB = _global_attn_mixer(zB, p['attn_q_norm'][l], p['attn_k_norm'][l])
        oC = _rglru_mixer(zC, p['lru_conv_w'][l], p['lru_conv_b'][l], p['lru_gate_w'][l],
                          p['lru_gate_b'][l], p['lru_lambda'][l])
        oD = _window_attn_mixer(zD, p['swa_sink'][l])
        o = jnp.concatenate([oA, oB, oC, oD], -1) @ p['w_out'][l].astype(jnp.float32)
        x = x + o.astype(x.dtype)
    return _rmsnorm(x, p['final_g']).astype(x.dtype)


def setup_inputs(seed: int = 0) -> dict:
    key = jax.random.key(seed)
    ks = jax.random.split(key, 24)
    L, G = DEPTH, GROUP_W
    nrm = lambda k, s: jax.random.normal(k, s, jnp.float32)
    a_target = jax.random.uniform(ks[20], (L, 2, G), jnp.float32, 0.9, 0.999)
    a_base = a_target ** (1.0 / LRU_C)
    lam = jnp.log(a_base) - jnp.log1p(-a_base)
    return {
        "x_prompt": nrm(ks[0], (BATCH, SEQ, D_MODEL)),
        "x_sample": nrm(ks[1], (DEC_BATCH, DEC_SEQ, D_MODEL)),
        "norm_g": 1.0 + 0.02 * nrm(ks[2], (L, D_MODEL)),
        "w_in": nrm(ks[3], (L, D_MODEL, D_IN)) * D_MODEL ** -0.5,
        "w_out": nrm(ks[4], (L, D_MIX, D_MODEL)) * D_MIX ** -0.5,
        "rwkv_shift": jax.random.uniform(ks[5], (L, 2, RWKV_SHIFT_W), jnp.float32, 0.0, 0.5),
        "rwkv_w0": jax.random.uniform(ks[6], (L, 2, G), jnp.float32, -6.0, 1.0),
        "rwkv_w_up": 0.1 * nrm(ks[7], (L, 2, RWKV_DECAY_RANK, G)),
        "rwkv_a0": 0.5 * nrm(ks[8], (L, 2, G)),
        "rwkv_a_up": 0.5 * RWKV_A_RANK ** -0.5 * nrm(ks[9], (L, 2, RWKV_A_RANK, G)),
        "rwkv_k_k": 0.85 + 0.02 * nrm(ks[10], (L, G)),
        "rwkv_k_a": 1.0 + 0.02 * nrm(ks[11], (L, G)),
        "rwkv_r_k": 0.1 * nrm(ks[12], (L, N_HEADS_G, HEAD_DIM)),
        "rwkv_ln_g": 1.0 + 0.02 * nrm(ks[13], (L, G)),
        "rwkv_ln_b": 0.02 * nrm(ks[14], (L, G)),
        "attn_q_norm": 1.0 + 0.02 * nrm(ks[15], (L, HEAD_DIM)),
        "attn_k_norm": 1.0 + 0.02 * nrm(ks[16], (L, HEAD_DIM)),
        "lru_conv_w": CONV_W ** -0.5 * nrm(ks[17], (L, CONV_W, G)),
        "lru_conv_b": 0.02 * nrm(ks[18], (L, G)),
        "lru_gate_w": LRU_BLK ** -0.5 * nrm(ks[19], (L, 2, 2, LRU_BLOCKS, LRU_BLK, LRU_BLK)),
        "lru_gate_b": 0.02 * nrm(ks[21], (L, 2, 2, G)),
        "lru_lambda": lam,
        "swa_sink": nrm(ks[22], (L, N_HEADS_G)),
        "final_g": 1.0 + 0.02 * nrm(ks[23], (D_MODEL,)),
    }


def reference(x_prompt, x_sample, norm_g, w_in, w_out, rwkv_shift, rwkv_w0, rwkv_w_up, rwkv_a0,
              rwkv_a_up, rwkv_k_k, rwkv_k_a, rwkv_r_k, rwkv_ln_g, rwkv_ln_b, attn_q_norm, attn_k_norm,
              lru_conv_w, lru_conv_b, lru_gate_w, lru_gate_b, lru_lambda, swa_sink, final_g):
    p = dict(norm_g=norm_g, w_in=w_in, w_out=w_out, rwkv_shift=rwkv_shift, rwkv_w0=rwkv_w0,
             rwkv_w_up=rwkv_w_up, rwkv_a0=rwkv_a0, rwkv_a_up=rwkv_a_up, rwkv_k_k=rwkv_k_k,
             rwkv_k_a=rwkv_k_a, rwkv_r_k=rwkv_r_k, rwkv_ln_g=rwkv_ln_g, rwkv_ln_b=rwkv_ln_b,
             attn_q_norm=attn_q_norm, attn_k_norm=attn_k_norm, lru_conv_w=lru_conv_w,
             lru_conv_b=lru_conv_b, lru_gate_w=lru_gate_w, lru_gate_b=lru_gate_b,
             lru_lambda=lru_lambda, swa_sink=swa_sink, final_g=final_g)
    y_prompt = _trunk(x_prompt, p)
    y_sample = _trunk(x_sample, p)
    return (y_prompt, y_sample)
```

```cpp
#include <hip/hip_runtime.h>
#include <hip/hip_cooperative_groups.h>
#include <cstdio>
#include <cstdint>
namespace cg = cooperative_groups;

#define DEVI __device__ __forceinline__
typedef unsigned short bf16_t;
typedef short bf16x8 __attribute__((ext_vector_type(8)));
typedef float f32x4 __attribute__((ext_vector_type(4)));

constexpr int T_ = 2048, NB_ = 40, NTOK = NB_ * T_, DM = 1024, DIN = 3200, NL = 4;
constexpr int NPROMPT = 32 * T_;
constexpr int OFF_A = 0, OFF_B = 1152, OFF_C = 1920, OFF_D = 2432;

struct Params {
    const float *x_prompt, *x_sample, *norm_g, *w_in, *w_out, *rwkv_shift, *rwkv_w0, *rwkv_w_up, *rwkv_a0, *rwkv_a_up,
        *rwkv_k_k, *rwkv_k_a, *rwkv_r_k, *rwkv_ln_g, *rwkv_ln_b, *attn_q_norm, *attn_k_norm, *lru_conv_w, *lru_conv_b,
        *lru_gate_w, *lru_gate_b, *lru_lambda, *swa_sink, *final_g;
    float* out;
    bf16_t *wt_in, *wt_out, *xb, *z, *sR, *sK, *sV, *sKK, *sA0, *sA1, *sW0, *sW1, *h0, *h1;
};

DEVI float bf2f(bf16_t h) { return __uint_as_float(((unsigned)h) << 16); }
DEVI bf16_t f2bf(float f) { unsigned u = __float_as_uint(f); u += 0x7fffu + ((u >> 16) & 1u); return (bf16_t)(u >> 16); }
DEVI unsigned pk2(float lo, float hi) { return (unsigned)f2bf(lo) | ((unsigned)f2bf(hi) << 16); }
DEVI float sigm(float x) { return 1.f / (1.f + __expf(-x)); }
DEVI float wave_sum(float v) {
#pragma unroll
    for (int o = 32; o > 0; o >>= 1) v += __shfl_xor(v, o);
    return v;
}
DEVI float rdl(float v, int j) { return __builtin_bit_cast(float, __builtin_amdgcn_readlane(__builtin_bit_cast(int, v), j)); }
DEVI const float* xrow(const Params& p, int l, int m) {
    if (l > 0) return p.out + (size_t)m * DM;
    return m < NPROMPT ? p.x_prompt + (size_t)m * DM : p.x_sample + (size_t)(m - NPROMPT) * DM;
}

DEVI void ph_convw(const Params& p, int item, char* smem) {
    float* tile = (float*)smem;
    int l = item / 1056, r = item % 1056;
    const float* src; bf16_t* dst; int N, k0, n0;
    if (r < 800) { src = p.w_in + (size_t)l * DM * DIN; dst = p.wt_in + (size_t)l * DIN * DM; N = DIN; k0 = (r / 50) * 64; n0 = (r % 50) * 64; }
    else { r -= 800; src = p.w_out + (size_t)l * DM * DM; dst = p.wt_out + (size_t)l * DM * DM; N = DM; k0 = (r / 16) * 64; n0 = (r % 16) * 64; }
    int tx = threadIdx.x & 63, ty = threadIdx.x >> 6;
    __syncthreads();
    for (int i = 0; i < 16; ++i) { int k = ty + 4 * i; tile[k * 65 + tx] = src[(size_t)(k0 + k) * N + n0 + tx]; }
    __syncthreads();
    for (int i = 0; i < 16; ++i) { int n = ty + 4 * i; dst[(size_t)(n0 + n) * DM + k0 + tx] = f2bf(tile[tx * 65 + n]); }
}

DEVI void ph_rownorm(const Params& p, int l, int item) {
    int w = threadIdx.x >> 6, lane = threadIdx.x & 63;
    int m = item * 4 + w;
    const float* x = xrow(p, l, m);
    const float* g = p.norm_g + l * DM;
    float4 v[4]; float ss = 0.f;
#pragma unroll
    for (int i = 0; i < 4; ++i) { v[i] = *(const float4*)(x + lane * 4 + 256 * i); ss += v[i].x * v[i].x + v[i].y * v[i].y + v[i].z * v[i].z + v[i].w * v[i].w; }
    ss = wave_sum(ss);
    float rs = rsqrtf(ss * (1.f / DM) + 1e-6f);
#pragma unroll
    for (int i = 0; i < 4; ++i) {
        float4 gg = *(const float4*)(g + lane * 4 + 256 * i);
        uint2 o; o.x = pk2(v[i].x * rs * gg.x, v[i].y * rs * gg.y); o.y = pk2(v[i].z * rs * gg.z, v[i].w * rs * gg.w);
        *(uint2*)(p.xb + (size_t)m * DM + lane * 4 + 256 * i) = o;
    }
}

DEVI void ph_final(const Params& p, int item) {
    int w = threadIdx.x >> 6, lane = threadIdx.x & 63;
    int m = item * 4 + w;
    float* x = p.out + (size_t)m * DM;
    float4 v[4]; float ss = 0.f;
#pragma unroll
    for (int i = 0; i < 4; ++i) { v[i] = *(const float4*)(x + lane * 4 + 256 * i); ss += v[i].x * v[i].x + v[i].y * v[i].y + v[i].z * v[i].z + v[i].w * v[i].w; }
    ss = wave_sum(ss);
    float rs = rsqrtf(ss * (1.f / DM) + 1e-6f);
#pragma unroll
    for (int i = 0; i < 4; ++i) {
        float4 gg = *(const float4*)(p.final_g + lane * 4 + 256 * i);
        float4 o; o.x = v[i].x * rs * gg.x; o.y = v[i].y * rs * gg.y; o.z = v[i].z * rs * gg.z; o.w = v[i].w * rs * gg.w;
        *(float4*)(x + lane * 4 + 256 * i) = o;
    }
}

constexpr int GBM = 128, GBN = 128, GBK = 64, GLD = 72;
constexpr int GEMM_LDS = 2 * 2 * 128 * GLD * 2;
template <int EPI>
DEVI void ph_gemm(const Params& p, int l, int item, char* smem) {
    constexpr int NT = EPI == 0 ? DIN / GBN : DM / GBN;
    const int pm = item / NT, pn = item % NT;
    const int row0 = pm * GBM, col0 = pn * GBN;
    const bf16_t* A = EPI == 0 ? p.xb : p.z;
    const int lda = EPI == 0 ? DM : DIN;
    const bf16_t* Bt = EPI == 0 ? p.wt_in + (size_t)l * DIN * DM : p.wt_out + (size_t)l * DM * DM;
    bf16_t* As = (bf16_t*)smem;
    bf16_t* Bs = As + 2 * 128 * GLD;
    const int tid = threadIdx.x, wid = tid >> 6, lane = tid & 63, wr = wid >> 1, wc = wid & 1, fr = lane & 15, fq = lane >> 4;
    f32x4 acc[4][4];
#pragma unroll
    for (int m = 0; m < 4; ++m)
#pragma unroll
        for (int n = 0; n < 4; ++n) acc[m][n] = (f32x4){0.f, 0.f, 0.f, 0.f};
    uint4 ra[4], rb[4];
    auto aoff = [&](int kt) -> int {
        if (EPI == 0) return kt * 64;
        const int blk = kt >> 2;
        const int bo = blk == 0 ? OFF_A : blk == 1 ? OFF_B : blk == 2 ? OFF_C : OFF_D;
        return bo + (kt & 3) * 64;
    };
    auto gload = [&](int kt) {
        const int ao = aoff(kt);
#pragma unroll
        for (int i = 0; i < 4; ++i) {
            const int c = tid + 256 * i, r = c >> 3, ch = c & 7;
            ra[i] = *(const uint4*)(A + (size_t)(row0 + r) * lda + ao + ch * 8);
            rb[i] = *(const uint4*)(Bt + (size_t)(col0 + r) * DM + kt * 64 + ch * 8);
        }
    };
    auto swrite = [&](int buf) {
#pragma unroll
        for (int i = 0; i < 4; ++i) {
            const int c = tid + 256 * i, r = c >> 3, ch = c & 7;
            *(uint4*)(As + (buf * 128 + r) * GLD + ch * 8) = ra[i];
            *(uint4*)(Bs + (buf * 128 + r) * GLD + ch * 8) = rb[i];
        }
    };
    constexpr int NK = DM / GBK;
    __syncthreads();
    gload(0); swrite(0);
    __syncthreads();
    for (int kt = 0; kt < NK; ++kt) {
        const int buf = kt & 1;
        if (kt + 1 < NK) gload(kt + 1);
#pragma unroll
        for (int ks = 0; ks < 2; ++ks) {
            bf16x8 af[4], bfr[4];
#pragma unroll
            for (int m = 0; m < 4; ++m) af[m] = *(const bf16x8*)(As + (buf * 128 + wr * 64 + m * 16 + fr) * GLD + ks * 32 + fq * 8);
#pragma unroll
            for (int n = 0; n < 4; ++n) bfr[n] = *(const bf16x8*)(Bs + (buf * 128 + wc * 64 + n * 16 + fr) * GLD + ks * 32 + fq * 8);
#pragma unroll
            for (int m = 0; m < 4; ++m)
#pragma unroll
                for (int n = 0; n < 4; ++n) acc[m][n] = __builtin_amdgcn_mfma_f32_16x16x32_bf16(bfr[n], af[m], acc[m][n], 0, 0, 0);
        }
        if (kt + 1 < NK) swrite(buf ^ 1);
        __syncthreads();
    }
#pragma unroll
    for (int m = 0; m < 4; ++m) {
        const int row = row0 + wr * 64 + m * 16 + fr;
#pragma unroll
        for (int n = 0; n < 4; ++n) {
            const int col = col0 + wc * 64 + n * 16 + fq * 4;
            if (EPI == 0) {
                uint2 o; o.x = pk2(acc[m][n][0], acc[m][n][1]); o.y = pk2(acc[m][n][2], acc[m][n][3]);
                *(uint2*)(p.z + (size_t)row * DIN + col) = o;
            } else {
                const float4 xr = *(const float4*)(xrow(p, l, row) + col);
                float4 o; o.x = xr.x + acc[m][n][0]; o.y = xr.y + acc[m][n][1]; o.z = xr.z + acc[m][n][2]; o.w = xr.w + acc[m][n][3];
                *(float4*)(p.out + (size_t)row * DM + col) = o;
            }
        }
    }
}

DEVI float rope1(float x, int d, int t) {
    const int part = d >> 5, e = d & 31, i = e & 15;
    const float pos = part ? (float)(t & 63) : (float)(t >> 6);
    const float inv = exp2f(-(float)i * (13.287712379549449f / 16.f));
    const float ang = pos * inv;
    const float c = cosf(ang), s = sinf(ang);
    const float pr = __shfl_xor(x, 16);
    return (e < 16) ? x * c - pr * s : pr * s + x * c;
}
DEVI void ph_prep(const Params& p, int l, int m, char* smem) {
    float* sm = (float*)smem;
    const int tid = threadIdx.x, t = m & (T_ - 1);
    bf16_t* zr = p.z + (size_t)m * DIN;
    const float* sh = p.rwkv_shift + l * 2 * 896;
    __syncthreads();
    for (int i = tid; i < 896; i += 256) {
        const float x = bf2f(zr[i]);
        const float pv = t > 0 ? bf2f(zr[i - DIN]) : 0.f;
        const float nx = t < T_ - 1 ? bf2f(zr[i + DIN]) : 0.f;
        float v = x + sh[i] * (pv - x) + sh[896 + i] * (nx - x);
        if (i >= 768 && i < 832) v = tanhf(v);
        sm[i] = v;
    }
    __syncthreads();
    const int j = tid;
    const float r = sm[j], k = sm[256 + j], v = sm[512 + j];
    const float kkv = k * p.rwkv_k_k[l * 256 + j];
    const float ss = wave_sum(kkv * kkv);
    const float kk = kkv / fmaxf(sqrtf(ss), 1e-12f);
    const size_t o = (size_t)m * 256 + j;
    p.sR[o] = f2bf(r); p.sK[o] = f2bf(k); p.sV[o] = f2bf(v); p.sKK[o] = f2bf(kk);
#pragma unroll
    for (int d = 0; d < 2; ++d) {
        float aw = p.rwkv_w0[(l * 2 + d) * 256 + j], aa = p.rwkv_a0[(l * 2 + d) * 256 + j];
        const float* wu = p.rwkv_w_up + (size_t)(l * 2 + d) * 64 * 256 + j;
        const float* au = p.rwkv_a_up + (size_t)(l * 2 + d) * 64 * 256 + j;
#pragma unroll 8
        for (int k2 = 0; k2 < 64; ++k2) { aw += sm[768 + k2] * wu[k2 * 256]; aa += sm[832 + k2] * au[k2 * 256]; }
        const float w1m = -expm1f(-0.6065306597126334f * sigm(aw));
        const float a = sigm(aa);
        (d ? p.sW1 : p.sW0)[o] = f2bf(w1m);
        (d ? p.sA1 : p.sA0)[o] = f2bf(a);
    }
    {
        const float q = bf2f(zr[OFF_B + j]);
        const float s2 = wave_sum(q * q);
        float qn = q * rsqrtf(s2 * (1.f / 64.f) + 1e-6f) * p.attn_q_norm[l * 64 + (j & 63)];
        qn = rope1(qn, j & 63, t) * 0.125f;
        zr[OFF_B + j] = f2bf(qn);
        if (j < 128) {
            const float kx = bf2f(zr[OFF_B + 256 + j]);
            const float s3 = wave_sum(kx * kx);
            float kn = kx * rsqrtf(s3 * (1.f / 64.f) + 1e-6f) * p.attn_k_norm[l * 64 + (j & 63)];
            kn = rope1(kn, j & 63, t);
            zr[OFF_B + 256 + j] = f2bf(kn);
        }
    }
}

DEVI void ph_rwkv_scan(const Params& p, int l, int item) {
    const int lane = threadIdx.x & 63, idx = item * 4 + (threadIdx.x >> 6);
    const int b = idx >> 3, h = (idx >> 1) & 3, d = idx & 1;
    const bf16_t* A = d ? p.sA1 : p.sA0;
    bf16_t* W = d ? p.sW1 : p.sW0;
    const float ka = p.rwkv_k_a[l * 256 + h * 64 + lane];
    float S[64];
#pragma unroll
    for (int j = 0; j < 64; ++j) S[j] = 0.f;
    size_t o = ((size_t)b * T_ + (d ? T_ - 1 : 0)) * 256 + h * 64 + lane;
    const long stp = d ? -256 : 256;
    float r = bf2f(p.sR[o]), k = bf2f(p.sK[o]), v = bf2f(p.sV[o]), kk = bf2f(p.sKK[o]), a = bf2f(A[o]), w = 1.f - bf2f(W[o]);
    for (int step = 0; step < T_; ++step) {
        const size_t on = step + 1 < T_ ? o + stp : o;
        const float rn = bf2f(p.sR[on]), kn = bf2f(p.sK[on]), vn = bf2f(p.sV[on]), kkn = bf2f(p.sKK[on]), an = bf2f(A[on]), wn = 1.f - bf2f(W[on]);
        const float bb = kk * a, kd = k * (1.f + (a - 1.f) * ka);
        float sk0 = 0.f, sk1 = 0.f;
#pragma unroll
        for (int j = 0; j < 64; j += 2) { sk0 += S[j] * rdl(kk, j); sk1 += S[j + 1] * rdl(kk, j + 1); }
        const float nsk = -(sk0 + sk1);
        float y0 = 0.f, y1 = 0.f;
#pragma unroll
        for (int j = 0; j < 64; j += 2) {
            S[j] = S[j] * rdl(w, j) + nsk * rdl(bb, j) + v * rdl(kd, j);
            y0 += S[j] * rdl(r, j);
            S[j + 1] = S[j + 1] * rdl(w, j + 1) + nsk * rdl(bb, j + 1) + v * rdl(kd, j + 1);
            y1 += S[j + 1] * rdl(r, j + 1);
        }
        W[o] = f2bf(y0 + y1);
        o = on; r = rn; k = kn; v = vn; kk = kkn; a = an; w = wn;
    }
}

DEVI void ph_lru_scan(const Params& p, int l, int item) {
    const int lane = threadIdx.x & 63, idx = item * 4 + (threadIdx.x >> 6);
    const int b = idx >> 3, n = (idx >> 1) & 3, d = idx & 1;
    const int ch = n * 64 + lane;
    float W0[64], W1[64];
    const float* gw0 = p.lru_gate_w + ((((size_t)(l * 2 + d) * 2 + 0) * 4 + n) * 64) * 64 + lane;
    const float* gw1 = p.lru_gate_w + ((((size_t)(l * 2 + d) * 2 + 1) * 4 + n) * 64) * 64 + lane;
#pragma unroll
    for (int dd = 0; dd < 64; ++dd) { W0[dd] = gw0[dd * 64]; W1[dd] = gw1[dd * 64]; }
    const float gb0 = p.lru_gate_b[((l * 2 + d) * 2 + 0) * 256 + ch], gb1 = p.lru_gate_b[((l * 2 + d) * 2 + 1) * 256 + ch];
    const float lam = p.lru_lambda[(l * 2 + d) * 256 + ch];
    const float sp = log1pf(__expf(-lam));
    float cw[4];
#pragma unroll
    for (int jj = 0; jj < 4; ++jj) cw[jj] = p.lru_conv_w[(l * 4 + jj) * 256 + ch];
    const float cb = p.lru_conv_b[l * 256 + ch];
    bf16_t* hb = d ? p.h1 : p.h0;
    float h = 0.f;
    for (int step = 0; step < T_; ++step) {
        const int t = d ? T_ - 1 - step : step;
        const size_t m = (size_t)b * T_ + t;
        float xc = cb;
#pragma unroll
        for (int jj = 0; jj < 4; ++jj) {
            const int tt = t + jj - 2;
            if (tt >= 0 && tt < T_) xc += cw[jj] * bf2f(p.z[(m + jj - 2) * DIN + OFF_C + ch]);
        }
        float g0 = gb0, g1 = gb1;
#pragma unroll
        for (int dd = 0; dd < 64; ++dd) { const float xs = rdl(xc, dd); g0 += xs * W0[dd]; g1 += xs * W1[dd]; }
        const float r = sigm(g0), i = sigm(g1);
        const float la = -8.f * r * sp;
        const float a = __expf(la);
        const float bt = sqrtf(-expm1f(2.f * la)) * i * xc;
        h = a * h + bt;
        hb[m * 256 + ch] = f2bf(h);
    }
}

DEVI void ph_post(const Params& p, int l, int m) {
    const int j = threadIdx.x;
    const size_t o = (size_t)m * 256 + j;
    bf16_t* zr = p.z + (size_t)m * DIN;
    {
        const float y = bf2f(p.sW0[o]) + bf2f(p.sW1[o]);
        const float mu = wave_sum(y) * (1.f / 64.f);
        const float dv = y - mu;
        const float var = wave_sum(dv * dv) * (1.f / 64.f);
        const float yn = dv * rsqrtf(var + 64e-5f) * p.rwkv_ln_g[l * 256 + j] + p.rwkv_ln_b[l * 256 + j];
        const float r = bf2f(p.sR[o]), k = bf2f(p.sK[o]), v = bf2f(p.sV[o]), af = bf2f(p.sA0[o]), ar = bf2f(p.sA1[o]);
        const float ka = p.rwkv_k_a[l * 256 + j];
        const float ksum = k * (1.f + (af - 1.f) * ka) + k * (1.f + (ar - 1.f) * ka);
        const float bon = wave_sum(r * ksum * p.rwkv_r_k[l * 256 + j]) * v;
        const float g = bf2f(zr[OFF_A + 896 + j]);
        zr[OFF_A + j] = f2bf((yn + bon) * g * sigm(g));
    }
    {
        const float h = bf2f(p.h0[o]) + bf2f(p.h1[o]);
        const float g = bf2f(zr[OFF_C + 256 + j]);
        zr[OFF_C + j] = f2bf(h * g * sigm(g));
    }
}

template <int WIN>
DEVI void ph_attn_naive(const Params& p, int l, int item) {
    const int lane = threadIdx.x & 63, idx = item * 4 + (threadIdx.x >> 6);
    const int qb = idx & 31, hq = (idx >> 5) & 3, b = idx >> 7;
    const int g = hq >> 1;
    constexpr int OFF = WIN ? OFF_D : OFF_B;
    const int t0 = qb * 64, t = t0 + lane;
    bf16_t* zq = p.z + ((size_t)b * T_ + t) * DIN + OFF + hq * 64;
    float q[64], o[64];
#pragma unroll
    for (int c = 0; c < 8; ++c) {
        const uint4 u = *(const uint4*)(zq + c * 8);
        const unsigned uu[4] = {u.x, u.y, u.z, u.w};
#pragma unroll
        for (int e = 0; e < 4; ++e) { q[c * 8 + 2 * e] = __uint_as_float(uu[e] << 16); q[c * 8 + 2 * e + 1] = __uint_as_float(uu[e] & 0xffff0000u); }
    }
#pragma unroll
    for (int dd = 0; dd < 64; ++dd) o[dd] = 0.f;
    float mx, ls;
    float slope = 0.f;
    if (WIN) { mx = p.swa_sink[l * 4 + hq]; ls = 1.f; slope = exp2f(-8.f * (float)(hq + 1) / 4.f); }
    else { mx = -1e30f; ls = 0.f; }
    const int s0 = WIN ? max(0, t0 - 128) : 0, s1 = WIN ? min(T_ - 1, t0 + 63 + 128) : T_ - 1;
    const bf16_t* kb = p.z + (size_t)b * T_ * DIN + OFF + 256 + g * 64;
    for (int s = s0; s <= s1; ++s) {
        const bf16_t* kr = kb + (size_t)s * DIN;
        float sc = 0.f;
#pragma unroll
        for (int c = 0; c < 8; ++c) {
            const uint4 u = *(const uint4*)(kr + c * 8);
            const unsigned uu[4] = {u.x, u.y, u.z, u.w};
#pragma unroll
            for (int e = 0; e < 4; ++e) { sc += q[c * 8 + 2 * e] * __uint_as_float(uu[e] << 16); sc += q[c * 8 + 2 * e + 1] * __uint_as_float(uu[e] & 0xffff0000u); }
        }
        bool valid = true;
        if (WIN) { const int dist = abs(t - s); valid = dist <= 128; sc = sc * 0.125f - slope * (float)dist; }
        const float mn = valid ? fmaxf(mx, sc) : mx;
        const float al = __expf(mx - mn);
        const float pp = valid ? __expf(sc - mn) : 0.f;
        mx = mn; ls = ls * al + pp;
#pragma unroll
        for (int c = 0; c < 8; ++c) {
            const uint4 u = *(const uint4*)(kr + 128 + c * 8);
            const unsigned uu[4] = {u.x, u.y, u.z, u.w};
#pragma unroll
            for (int e = 0; e < 4; ++e) {
                o[c * 8 + 2 * e] = o[c * 8 + 2 * e] * al + pp * __uint_as_float(uu[e] << 16);
                o[c * 8 + 2 * e + 1] = o[c * 8 + 2 * e + 1] * al + pp * __uint_as_float(uu[e] & 0xffff0000u);
            }
        }
    }
    const float il = 1.f / ls;
    const bf16_t* zg = zq - hq * 64 + 512 + hq * 64;
#pragma unroll
    for (int c = 0; c < 8; ++c) {
        const uint4 u = *(const uint4*)(zg + c * 8);
        const unsigned uu[4] = {u.x, u.y, u.z, u.w};
        unsigned ov[4];
#pragma unroll
        for (int e = 0; e < 4; ++e) {
            const float g0 = __uint_as_float(uu[e] << 16), g1 = __uint_as_float(uu[e] & 0xffff0000u);
            ov[e] = pk2(o[c * 8 + 2 * e] * il * g0 * sigm(g0), o[c * 8 + 2 * e + 1] * il * g1 * sigm(g1));
        }
        *(uint4*)(zq + c * 8) = make_uint4(ov[0], ov[1], ov[2], ov[3]);
    }
}

enum { PH_CONVW, PH_ROWNORM, PH_GEMM1, PH_PREP, PH_RWKV, PH_LRU, PH_ATTNB, PH_ATTND, PH_POST, PH_GEMM2, PH_FINAL };
template <int PH>
__global__ void __launch_bounds__(256) kph(Params p, int l, int nitems) {
    extern __shared__ __attribute__((aligned(16))) char smem[];
    for (int item = blockIdx.x; item < nitems; item += gridDim.x) {
        if (PH == PH_CONVW) ph_convw(p, item, smem);
        if (PH == PH_ROWNORM) ph_rownorm(p, l, item);
        if (PH == PH_GEMM1) ph_gemm<0>(p, l, item, smem);
        if (PH == PH_PREP) ph_prep(p, l, item, smem);
        if (PH == PH_RWKV) ph_rwkv_scan(p, l, item);
        if (PH == PH_LRU) ph_lru_scan(p, l, item);
        if (PH == PH_ATTNB) ph_attn_naive<0>(p, l, item);
        if (PH == PH_ATTND) ph_attn_naive<1>(p, l, item);
        if (PH == PH_POST) ph_post(p, l, item);
        if (PH == PH_GEMM2) ph_gemm<1>(p, l, item, smem);
        if (PH == PH_FINAL) ph_final(p, item);
    }
}

template <int PH>
static void launch(const Params& p, int l, int nitems, int lds, hipStream_t stream) {
    if (lds > 48 * 1024) (void)hipFuncSetAttribute((const void*)kph<PH>, hipFuncAttributeMaxDynamicSharedMemorySize, lds);
    int grid = nitems < 65536 ? nitems : 65536;
    hipLaunchKernelGGL(kph<PH>, dim3(grid), dim3(256), lds, stream, p, l, nitems);
}

extern "C" void kernel_launch(void* const* d_in, const int* in_sizes, int n_in, void* d_out, int out_size, void* d_ws, size_t ws_size,
                              hipStream_t stream) {
    Params p{};
    const float* const* in = (const float* const*)d_in;
    p.x_prompt = in[0]; p.x_sample = in[1]; p.norm_g = in[2]; p.w_in = in[3]; p.w_out = in[4]; p.rwkv_shift = in[5]; p.rwkv_w0 = in[6];
    p.rwkv_w_up = in[7]; p.rwkv_a0 = in[8]; p.rwkv_a_up = in[9]; p.rwkv_k_k = in[10]; p.rwkv_k_a = in[11]; p.rwkv_r_k = in[12];
    p.rwkv_ln_g = in[13]; p.rwkv_ln_b = in[14]; p.attn_q_norm = in[15]; p.attn_k_norm = in[16]; p.lru_conv_w = in[17]; p.lru_conv_b = in[18];
    p.lru_gate_w = in[19]; p.lru_gate_b = in[20]; p.lru_lambda = in[21]; p.swa_sink = in[22]; p.final_g = in[23];
    p.out = (float*)d_out;
    char* ws = (char*)d_ws;
    size_t off = 0;
    auto take = [&](size_t bytes) { char* r = ws + off; off += (bytes + 255) & ~(size_t)255; return r; };
    p.wt_in = (bf16_t*)take((size_t)NL * DIN * DM * 2);
    p.wt_out = (bf16_t*)take((size_t)NL * DM * DM * 2);
    p.xb = (bf16_t*)take((size_t)NTOK * DM * 2);
    p.h0 = p.xb; p.h1 = p.xb + (size_t)NTOK * 256;
    p.z = (bf16_t*)take((size_t)NTOK * DIN * 2);
    const size_t sa = (size_t)NTOK * 256 * 2;
    p.sR = (bf16_t*)take(sa); p.sK = (bf16_t*)take(sa); p.sV = (bf16_t*)take(sa); p.sKK = (bf16_t*)take(sa);
    p.sA0 = (bf16_t*)take(sa); p.sA1 = (bf16_t*)take(sa); p.sW0 = (bf16_t*)take(sa); p.sW1 = (bf16_t*)take(sa);
    if (off > ws_size) { fprintf(stderr, "workspace too small: need %zu have %zu\n", off, ws_size); }

    launch<PH_CONVW>(p, 0, NL * 1056, 64 * 65 * 4, stream);
    for (int l = 0; l < NL; ++l) {
        launch<PH_ROWNORM>(p, l, NTOK / 4, 0, stream);
        launch<PH_GEMM1>(p, l, (NTOK / GBM) * (DIN / GBN), GEMM_LDS, stream);
        launch<PH_PREP>(p, l, NTOK, 896 * 4, stream);
        launch<PH_RWKV>(p, l, 80, 0, stream);
        launch<PH_LRU>(p, l, 80, 0, stream);
        launch<PH_ATTNB>(p, l, 1280, 0, stream);
        launch<PH_ATTND>(p, l, 1280, 0, stream);
        launch<PH_POST>(p, l, NTOK, 0, stream);
        launch<PH_GEMM2>(p, l, (NTOK / GBM) * (DM / GBN), GEMM_LDS, stream);
    }
    launch<PH_FINAL>(p, 0, NTOK / 4, 0, stream);
}
```

```cpp
#include <hip/hip_runtime.h>
#include <hip/hip_cooperative_groups.h>
#include <cstdio>
#include <cstdint>
namespace cg = cooperative_groups;

#define DEVI __device__ __forceinline__
typedef unsigned short bf16_t;
typedef short bf16x8 __attribute__((ext_vector_type(8)));
typedef float f32x4 __attribute__((ext_vector_type(4)));

constexpr int T_ = 2048, NB_ = 40, NTOK = NB_ * T_, DM = 1024, DIN = 3200, NL = 4;
constexpr int NPROMPT = 32 * T_;
constexpr size_t SA_EL = (size_t)NTOK * 256;
constexpr int OFF_A = 0, OFF_B = 1152, OFF_C = 1920, OFF_D = 2432;

struct Params {
    const float *x_prompt, *x_sample, *norm_g, *w_in, *w_out, *rwkv_shift, *rwkv_w0, *rwkv_w_up, *rwkv_a0, *rwkv_a_up,
        *rwkv_k_k, *rwkv_k_a, *rwkv_r_k, *rwkv_ln_g, *rwkv_ln_b, *attn_q_norm, *attn_k_norm, *lru_conv_w, *lru_conv_b,
        *lru_gate_w, *lru_gate_b, *lru_lambda, *swa_sink, *final_g;
    float* out;
    char* ws;
};
constexpr size_t al256(size_t x) { return (x + 255) & ~(size_t)255; }
constexpr size_t WO_WT_IN = 0;
constexpr size_t WO_WT_OUT = WO_WT_IN + al256((size_t)NL * DIN * DM * 2);
constexpr size_t WO_XB = WO_WT_OUT + al256((size_t)NL * DM * DM * 2);
constexpr size_t WO_Z = WO_XB + al256((size_t)NTOK * DM * 2);
constexpr size_t WO_SR = WO_Z + al256((size_t)NTOK * DIN * 2);
constexpr size_t WO_SK = WO_SR + SA_EL * 2, WO_SV = WO_SK + SA_EL * 2, WO_SKK = WO_SV + SA_EL * 2, WO_SA0 = WO_SKK + SA_EL * 2, WO_SW0 = WO_SA0 + 2 * SA_EL * 2;
constexpr size_t WO_CTR = WO_SW0 + 2 * SA_EL * 2;
constexpr size_t WO_WUP = WO_CTR + 256, WO_AUP = WO_WUP + (size_t)NL * 2 * 256 * 64 * 2, WO_GW = WO_AUP + (size_t)NL * 2 * 256 * 64 * 2, WO_ROPE = WO_GW + (size_t)NL * 16 * 4096 * 2;
constexpr size_t WO_GBAR = WO_ROPE + 2048 * 4;
constexpr size_t WO_PART = WO_GBAR + 256;
constexpr size_t WS_NEED = WO_PART + (size_t)NTOK * 16 * 4;
#define WSF(name, T, off) DEVI T* ws_##name(const Params& p) { return (T*)(p.ws + (off)); }
WSF(wt_in, bf16_t, WO_WT_IN) WSF(wt_out, bf16_t, WO_WT_OUT) WSF(xb, bf16_t, WO_XB) WSF(z, bf16_t, WO_Z) WSF(sR, bf16_t, WO_SR) WSF(sK, bf16_t, WO_SK)
WSF(sV, bf16_t, WO_SV) WSF(sKK, bf16_t, WO_SKK) WSF(sA0, bf16_t, WO_SA0) WSF(sW0, bf16_t, WO_SW0) WSF(la, bf16_t, WO_XB) WSF(h0, bf16_t, WO_XB + 2 * SA_EL * 2)
WSF(ctr, int, WO_CTR) WSF(gbar, unsigned, WO_GBAR) WSF(part, float, WO_PART) WSF(wup_t, bf16_t, WO_WUP) WSF(aup_t, bf16_t, WO_AUP) WSF(gw_t, bf16_t, WO_GW) WSF(rope, float, WO_ROPE)

DEVI float bf2f(bf16_t h) { return __uint_as_float(((unsigned)h) << 16); }
DEVI bf16_t f2bf(float f) { return __builtin_bit_cast(bf16_t, (__bf16)f); }
typedef float f2 __attribute__((ext_vector_type(2)));
typedef __bf16 b2_t __attribute__((ext_vector_type(2)));
DEVI unsigned pk2(float lo, float hi) { f2 v = {lo, hi}; return __builtin_bit_cast(unsigned, __builtin_convertvector(v, b2_t)); }
typedef unsigned u32x4 __attribute__((ext_vector_type(4)));
typedef unsigned u32x2 __attribute__((ext_vector_type(2)));
DEVI float sigm(float x) { return 1.f / (1.f + __expf(-x)); }
DEVI float dpp_f(float v, int) { return v; }
template <int CTRL> DEVI float dppx(float v) { return __builtin_bit_cast(float, __builtin_amdgcn_update_dpp(0, __builtin_bit_cast(int, v), CTRL, 0xf, 0xf, true)); }
DEVI float wave_sum(float v) {
    v += dppx<0xB1>(v);
    v += dppx<0x4E>(v);
    v += dppx<0x141>(v);
    v += dppx<0x140>(v);
    v += __shfl_xor(v, 16); v += __shfl_xor(v, 32);
    return v;
}
DEVI float rdl(float v, int j) { return __builtin_bit_cast(float, __builtin_amdgcn_readlane(__builtin_bit_cast(int, v), j)); }
DEVI const float* xrow(const Params& p, int l, int m) {
    if (l > 0) return p.out + (size_t)m * DM;
    const float* xp = p.x_prompt; const float* xs = p.x_sample;
    const long delta = (xs - xp) - (long)NPROMPT * DM;
    return xp + (size_t)m * DM + (m >= NPROMPT ? delta : (long)0);
}

DEVI int tidx() { int t = threadIdx.x; asm volatile("" : "+v"(t)); return t; }
constexpr int CW_PER_L = 1088, CW_ITEMS = NL * CW_PER_L + 1;
DEVI void ph_convw(const Params& p, int item, char* smem) {
    float* tile = (float*)smem;
    if (item == NL * CW_PER_L) {
        for (int e = tidx(); e < 1024; e += 256) {
            const int pos = e >> 4, i = e & 15;
            const float inv = exp2f(-(float)i * (13.287712379549449f / 16.f));
            const float ang = (float)pos * inv;
            ws_rope(p)[2 * e] = cosf(ang); ws_rope(p)[2 * e + 1] = sinf(ang);
        }
        return;
    }
    const int l = item / CW_PER_L; int r = item % CW_PER_L;
    const float* src; bf16_t* dst; int N, K, k0, n0;
    if (r < 800) { src = p.w_in + (size_t)l * DM * DIN; dst = ws_wt_in(p) + (size_t)l * DIN * DM; N = DIN; K = DM; k0 = (r / 50) * 64; n0 = (r % 50) * 64; }
    else if (r < 1056) { r -= 800; src = p.w_out + (size_t)l * DM * DM; dst = ws_wt_out(p) + (size_t)l * DM * DM; N = DM; K = DM; k0 = (r / 16) * 64; n0 = (r % 16) * 64; }
    else if (r < 1072) { r -= 1056; const int d = (r >> 2) & 1, up = r >> 3; const size_t o = (size_t)(l * 2 + d) * 64 * 256;
        src = (up ? p.rwkv_a_up : p.rwkv_w_up) + o; dst = (up ? ws_aup_t(p) : ws_wup_t(p)) + o; N = 256; K = 64; k0 = 0; n0 = (r & 3) * 64; }
    else { r -= 1072; const size_t o = (size_t)(l * 16 + r) * 4096; src = p.lru_gate_w + o; dst = ws_gw_t(p) + o; N = 64; K = 64; k0 = 0; n0 = 0; }
    int tx = tidx() & 63, ty = tidx() >> 6;
    __syncthreads();
    for (int i = 0; i < 16; ++i) { int k = ty + 4 * i; tile[k * 65 + tx] = src[(size_t)(k0 + k) * N + n0 + tx]; }
    __syncthreads();
    for (int i = 0; i < 16; ++i) { int n = ty + 4 * i; dst[(size_t)(n0 + n) * K + k0 + tx] = f2bf(tile[tx * 65 + n]); }
}

DEVI void ph_rownorm(const Params& p, int l, int item) {
    int w = tidx() >> 6, lane = tidx() & 63;
    int m = item * 4 + w;
    const float* x = xrow(p, l, m);
    const float* g = p.norm_g + l * DM;
    float4 v[4]; float ss = 0.f;
#pragma unroll
    for (int i = 0; i < 4; ++i) { v[i] = *(const float4*)(x + lane * 4 + 256 * i); ss += v[i].x * v[i].x + v[i].y * v[i].y + v[i].z * v[i].z + v[i].w * v[i].w; }
    ss = wave_sum(ss);
    if (lane < 16) ws_part(p)[(size_t)m * 16 + lane] = lane == 0 ? ss : 0.f;
#pragma unroll
    for (int i = 0; i < 4; ++i) {
        float4 gg = *(const float4*)(g + lane * 4 + 256 * i);
        uint2 o; o.x = pk2(v[i].x * gg.x, v[i].y * gg.y); o.y = pk2(v[i].z * gg.z, v[i].w * gg.w);
        *(uint2*)(ws_xb(p) + (size_t)m * DM + lane * 4 + 256 * i) = o;
    }
}

DEVI void ph_final(const Params& p, int item) {
    int w = tidx() >> 6, lane = tidx() & 63;
    int m = item * 4 + w;
    float* x = p.out + (size_t)m * DM;
    float4 v[4]; float ss = 0.f;
#pragma unroll
    for (int i = 0; i < 4; ++i) { v[i] = *(const float4*)(x + lane * 4 + 256 * i); ss += v[i].x * v[i].x + v[i].y * v[i].y + v[i].z * v[i].z + v[i].w * v[i].w; }
    ss = wave_sum(ss);
    float rs = rsqrtf(ss * (1.f / DM) + 1e-6f);
#pragma unroll
    for (int i = 0; i < 4; ++i) {
        float4 gg = *(const float4*)(p.final_g + lane * 4 + 256 * i);
        float4 o; o.x = v[i].x * rs * gg.x; o.y = v[i].y * rs * gg.y; o.z = v[i].z * rs * gg.z; o.w = v[i].w * rs * gg.w;
        *(float4*)(x + lane * 4 + 256 * i) = o;
    }
}

constexpr int GBM = 128, GBN = 128, GBK = 64, GLD = 72;
constexpr int GEMM_LDS = 2 * 2 * 128 * GLD * 2;
template <int EPI>
DEVI void ph_gemm_all(const Params& p, int l, int bid, int G, char* smem, bool dry = false) {
    constexpr int NT = EPI == 0 ? DIN / GBN : DM / GBN;
    constexpr int NTILES = (NTOK / GBM) * NT;
    if (bid >= NTILES) return;
#define G_COORDS(item_, r0_, c0_, pn_) { const int xcd_ = (item_) & 7, jx_ = (item_) >> 3; const int rg_ = jx_ / (8 * NT), wi_ = jx_ % (8 * NT); \
        pn_ = wi_ >> 3; r0_ = (xcd_ * 80 + rg_ * 8 + (wi_ & 7)) * GBM; c0_ = pn_ * GBN; }
    const bf16_t* A = EPI == 0 ? ws_xb(p) : ws_z(p);
    const int lda = EPI == 0 ? DM : DIN;
    const bf16_t* Bt = EPI == 0 ? ws_wt_in(p) + (size_t)l * DIN * DM : ws_wt_out(p) + (size_t)l * DM * DM;
    bf16_t* As = (bf16_t*)smem;
    bf16_t* Bs = As + 2 * 128 * GLD;
    const int tid = tidx(), wid = tid >> 6, lane = tid & 63, wr = wid >> 1, wc = wid & 1, fr = lane & 15, fq = lane >> 4;
    int item = bid, row0, col0, pn, nrow0 = 0, ncol0 = 0, npn = 0;
    G_COORDS(item, row0, col0, pn)
    bool hasn = item + G < NTILES;
    if (hasn) G_COORDS(item + G, nrow0, ncol0, npn)
    f32x4 acc[4][4];
#pragma unroll
    for (int m = 0; m < 4; ++m)
#pragma unroll
        for (int n = 0; n < 4; ++n) acc[m][n] = (f32x4){0.f, 0.f, 0.f, 0.f};
    u32x4 ra0[4], rb0[4], ra1[4], rb1[4];
    auto aoff = [&](int kt) __attribute__((always_inline)) -> int {
        if (EPI == 0) return kt * 64;
        const int blk = kt >> 2;
        const int bo = blk == 0 ? OFF_A : blk == 1 ? OFF_B : blk == 2 ? OFF_C : OFF_D;
        return bo + (kt & 3) * 64;
    };
    const int lr = tid >> 3, lch = (tid & 7) * 8;
    const unsigned va0 = (unsigned)(lr * lda + lch) * 2u, vb0 = (unsigned)(lr * DM + lch) * 2u;
    const unsigned vas = (unsigned)(32 * lda) * 2u, vbs = (unsigned)(32 * DM) * 2u;
#define G_LOAD1(ra, rb, i) ra[i] = *(const u32x4*)(ab_ + (va0 + (i) * vas)); rb[i] = *(const u32x4*)(bb_ + (vb0 + (i) * vbs));
#define G_LOAD(ra, rb, r0_, c0_, kt_) { const char* ab_ = (const char*)(A + (size_t)(r0_) * lda + aoff(kt_)); const char* bb_ = (const char*)(Bt + (size_t)(c0_) * DM + (kt_) * 64); \
        G_LOAD1(ra, rb, 0) G_LOAD1(ra, rb, 1) G_LOAD1(ra, rb, 2) G_LOAD1(ra, rb, 3) }
#define S_WRITE1(ra, rb, buf_, i) *(u32x4*)(As + ((buf_) * 128 + lr + 32 * (i)) * GLD + lch) = ra[i]; *(u32x4*)(Bs + ((buf_) * 128 + lr + 32 * (i)) * GLD + lch) = rb[i];
#define S_WRITE(ra, rb, buf_) { S_WRITE1(ra, rb, buf_, 0) S_WRITE1(ra, rb, buf_, 1) S_WRITE1(ra, rb, buf_, 2) S_WRITE1(ra, rb, buf_, 3) }
#define G_COMPUTE(buf_) { \
    bf16x8 af[2][4], bfr[2][4]; \
    _Pragma("unroll") for (int ks = 0; ks < 2; ++ks) { \
        _Pragma("unroll") for (int m = 0; m < 4; ++m) af[ks][m] = *(const bf16x8*)(As + ((buf_) * 128 + wr * 64 + m * 16 + fr) * GLD + ks * 32 + fq * 8); \
        _Pragma("unroll") for (int n = 0; n < 4; ++n) bfr[ks][n] = *(const bf16x8*)(Bs + ((buf_) * 128 + wc * 64 + n * 16 + fr) * GLD + ks * 32 + fq * 8); \
    } \
    __builtin_amdgcn_s_setprio(1); \
    _Pragma("unroll") for (int ks = 0; ks < 2; ++ks) \
        _Pragma("unroll") for (int m = 0; m < 4; ++m) \
            _Pragma("unroll") for (int n = 0; n < 4; ++n) acc[m][n] = __builtin_amdgcn_mfma_f32_16x16x32_bf16(bfr[ks][n], af[ks][m], acc[m][n], 0, 0, 0); \
    __builtin_amdgcn_s_setprio(0); }
    constexpr int NK = DM / GBK;
    __syncthreads();
    G_LOAD(ra0, rb0, row0, col0, 0) G_LOAD(ra1, rb1, row0, col0, 1)
    S_WRITE(ra0, rb0, 0)
    G_LOAD(ra0, rb0, row0, col0, 2)
    __syncthreads();
#pragma unroll 1
    for (;;) {
#pragma unroll 1
        for (int kt = 0; kt < NK; kt += 2) {
            G_COMPUTE(0)
            S_WRITE(ra1, rb1, 1)
            __syncthreads();
            if (kt + 3 < NK) G_LOAD(ra1, rb1, row0, col0, kt + 3)
            else if (hasn) G_LOAD(ra1, rb1, nrow0, ncol0, kt + 3 - NK)
            G_COMPUTE(1)
            if (kt + 2 < NK || hasn) S_WRITE(ra0, rb0, 0)
            __syncthreads();
            if (kt + 4 < NK) G_LOAD(ra0, rb0, row0, col0, kt + 4)
            else if (hasn) G_LOAD(ra0, rb0, nrow0, ncol0, kt + 4 - NK)
        }
    #pragma unroll
        for (int m = 0; m < 4; ++m) {
            const int row = row0 + wr * 64 + m * 16 + fr;
            float rs = 1.f, ssq = 0.f;
            if (EPI == 0) {
                const f32x4* pp = (const f32x4*)(ws_part(p) + (size_t)row * 16);
                const f32x4 q0 = pp[0], q1 = pp[1], q2 = pp[2], q3 = pp[3];
                const float sm = ((q0[0] + q0[1]) + (q0[2] + q0[3])) + ((q1[0] + q1[1]) + (q1[2] + q1[3])) + ((q2[0] + q2[1]) + (q2[2] + q2[3])) + ((q3[0] + q3[1]) + (q3[2] + q3[3]));
                rs = rsqrtf(sm * (1.f / DM) + 1e-6f);
            }
    #pragma unroll
            for (int n = 0; n < 4; ++n) {
                const int col = col0 + wc * 64 + n * 16 + fq * 4;
                if (dry) { if (acc[m][n][0] == 1.2345e30f) ws_ctr(p)[63] = 1; }
                else if (EPI == 0) {
                    uint2 o; o.x = pk2(acc[m][n][0] * rs, acc[m][n][1] * rs); o.y = pk2(acc[m][n][2] * rs, acc[m][n][3] * rs);
                    *(uint2*)(ws_z(p) + (size_t)row * DIN + col) = o;
                } else {
                    const float4 xr = *(const float4*)(xrow(p, l, row) + col);
                    float4 o; o.x = xr.x + acc[m][n][0]; o.y = xr.y + acc[m][n][1]; o.z = xr.z + acc[m][n][2]; o.w = xr.w + acc[m][n][3];
                    *(float4*)(p.out + (size_t)row * DM + col) = o;
                    ssq += (o.x * o.x + o.y * o.y) + (o.z * o.z + o.w * o.w);
                    if (l + 1 < NL) {
                        const float4 gg = *(const float4*)(p.norm_g + (l + 1) * DM + col);
                        uint2 ob; ob.x = pk2(o.x * gg.x, o.y * gg.y); ob.y = pk2(o.z * gg.z, o.w * gg.w);
                        *(uint2*)(ws_xb(p) + (size_t)row * DM + col) = ob;
                    }
                }
            }
            if (EPI == 1 && !dry) {
                ssq += __shfl_xor(ssq, 16); ssq += __shfl_xor(ssq, 32);
                if (fq == 0) ws_part(p)[(size_t)row * 16 + pn * 2 + wc] = ssq;
            }
        }
        if (!hasn) break;
#pragma unroll
        for (int m = 0; m < 4; ++m)
#pragma unroll
            for (int n = 0; n < 4; ++n) acc[m][n] = (f32x4){0.f, 0.f, 0.f, 0.f};
        item += G; row0 = nrow0; col0 = ncol0; pn = npn;
        hasn = item + G < NTILES;
        if (hasn) G_COORDS(item + G, nrow0, ncol0, npn)
    }
#undef G_LOAD
#undef S_WRITE
#undef G_LOAD1
#undef S_WRITE1
#undef G_COMPUTE
#undef G_COORDS
}

constexpr int XLD = 264, LLD = 72;
constexpr int PREP_LDS = 64 * XLD * 2 + 2 * 64 * LLD * 2;
DEVI float ropeT(float2 cs, float x, int d) {
    const int e = d & 31;
    const float pr = __shfl_xor(x, 16);
    return (e < 16) ? x * cs.x - pr * cs.y : pr * cs.y + x * cs.x;
}
DEVI void ph_prep(const Params& p, int l, int item, char* smem, bool dry = false) {
    bf16_t* xc_s = (bf16_t*)smem;
    bf16_t* wl_s = xc_s + 64 * XLD;
    bf16_t* al_s = wl_s + 64 * LLD;
    const int tid = tidx(), w = tid >> 6, lane = tid & 63, fr = lane & 15, fq = lane >> 4;
    const int b = item >> 6, t0 = (item & 63) * 32;
    const size_t mbase = (size_t)b * T_ + t0;
    bf16_t* zt = ws_z(p) + mbase * DIN;
    __syncthreads();
    {
        const float* sh = p.rwkv_shift + l * 2 * 896;
        float s0[4], s1[4], pv[4], cu[4];
#pragma unroll
        for (int s_ = 0; s_ < 4; ++s_) {
            const int c = tid + 256 * s_;
            const bool ok = c < 896;
            s0[s_] = ok ? sh[c] : 0.f; s1[s_] = ok ? sh[896 + c] : 0.f;
            pv[s_] = (ok && t0 > 0) ? bf2f(zt[c - DIN]) : 0.f;
            cu[s_] = ok ? bf2f(zt[c]) : 0.f;
        }
        const float kkw = p.rwkv_k_k[l * 256 + tid];
        float cw[4];
#pragma unroll
        for (int jj = 0; jj < 4; ++jj) cw[jj] = p.lru_conv_w[(l * 4 + jj) * 256 + tid];
        const float cb = p.lru_conv_b[l * 256 + tid];
        float xm2 = t0 >= 2 ? bf2f(zt[OFF_C + tid - 2 * DIN]) : 0.f, xm1 = t0 >= 1 ? bf2f(zt[OFF_C + tid - DIN]) : 0.f, x0 = bf2f(zt[OFF_C + tid]);
        const float qnw = p.attn_q_norm[l * 64 + lane], knw = p.attn_k_norm[l * 64 + lane];
        const bool c3 = tid < 128;
#pragma unroll 1
        for (int g8 = 0; g8 < 4; ++g8) {
            bf16_t nA[8][4], nC[8], qB[8], kB[8];
            float2 cs8[8];
#pragma unroll
            for (int i8 = 0; i8 < 8; ++i8) {
                const int tt = g8 * 8 + i8;
                const bf16_t* zr = zt + (size_t)tt * DIN;
                const bool hasn = t0 + tt + 1 < T_;
#pragma unroll
                for (int s_ = 0; s_ < 4; ++s_) nA[i8][s_] = (hasn && (s_ < 3 || c3)) ? zr[tid + 256 * s_ + DIN] : (bf16_t)0;
                nC[i8] = hasn ? zr[OFF_C + tid + DIN] : (bf16_t)0;
                qB[i8] = zr[OFF_B + tid];
                kB[i8] = c3 ? zr[OFF_B + 256 + tid] : (bf16_t)0;
                cs8[i8] = *(const float2*)(ws_rope(p) + 2 * (((lane >> 5) ? (t0 & 63) + tt : (t0 >> 6)) * 16 + (lane & 15)));
            }
#pragma unroll
            for (int i8 = 0; i8 < 8; ++i8) {
                const int tt = g8 * 8 + i8;
                const int t = t0 + tt;
                bf16_t* zr = zt + (size_t)tt * DIN;
                float xs[4];
#pragma unroll
                for (int s_ = 0; s_ < 4; ++s_) {
                    const float nx = bf2f(nA[i8][s_]);
                    xs[s_] = cu[s_] + s0[s_] * (pv[s_] - cu[s_]) + s1[s_] * (nx - cu[s_]);
                    pv[s_] = cu[s_]; cu[s_] = nx;
                }
                const size_t o = (mbase + tt) * 256 + tid;
                const float kkv = xs[1] * kkw;
                const float ss = wave_sum(kkv * kkv);
                ws_sR(p)[o] = f2bf(xs[0]); ws_sK(p)[o] = f2bf(xs[1]); ws_sV(p)[o] = f2bf(xs[2]); ws_sKK(p)[o] = f2bf(kkv * rsqrtf(fmaxf(ss, 1e-24f)));
                if (tid < 64) wl_s[tt * LLD + tid] = f2bf(1.f - 2.f / (1.f + __expf(2.f * xs[3])));
                else if (tid < 128) al_s[tt * LLD + tid - 64] = f2bf(xs[3]);
                const float xp1 = bf2f(nC[i8]);
                xc_s[tt * XLD + tid] = f2bf(cb + cw[0] * xm2 + cw[1] * xm1 + cw[2] * x0 + cw[3] * xp1);
                xm2 = xm1; xm1 = x0; x0 = xp1;
                const float q = bf2f(qB[i8]);
                const float s2 = wave_sum(q * q);
                const float qn = ropeT(cs8[i8], q * rsqrtf(s2 * (1.f / 64.f) + 1e-6f) * qnw, lane) * (0.125f * 1.4426950408889634f);
                if (!dry) zr[OFF_B + tid] = f2bf(qn);
                if (c3) {
                    const float kx = bf2f(kB[i8]);
                    const float s3 = wave_sum(kx * kx);
                    const float kro = ropeT(cs8[i8], kx * rsqrtf(s3 * (1.f / 64.f) + 1e-6f) * knw, lane);
                    if (!dry) zr[OFF_B + 256 + tid] = f2bf(kro);
                }
            }
        }
    }
    __syncthreads();
#pragma unroll 1
    for (int dm = 0; dm < 4; ++dm) {
        const int d = dm >> 1, mat = dm & 1;
        const bf16_t* Bt = (mat ? ws_aup_t(p) : ws_wup_t(p)) + ((size_t)(l * 2 + d) * 256 + 64 * w) * 64;
        bf16x8 bfr[4][2];
#pragma unroll
        for (int nt = 0; nt < 4; ++nt)
#pragma unroll
            for (int ks = 0; ks < 2; ++ks) bfr[nt][ks] = *(const bf16x8*)(Bt + (16 * nt + fr) * 64 + 32 * ks + 8 * fq);
        const bf16_t* As = mat ? al_s : wl_s;
        const float* bias = (mat ? p.rwkv_a0 : p.rwkv_w0) + (l * 2 + d) * 256 + 64 * w + 4 * fq;
        bf16_t* dst = (mat ? ws_sA0(p) : ws_sW0(p)) + d * SA_EL + mbase * 256 + 64 * w + 4 * fq;
#pragma unroll 1
        for (int m = 0; m < 2; ++m) {
            bf16x8 af[2];
#pragma unroll
            for (int ks = 0; ks < 2; ++ks) af[ks] = *(const bf16x8*)(As + (16 * m + fr) * LLD + 32 * ks + 8 * fq);
#pragma unroll
            for (int nt = 0; nt < 4; ++nt) {
                f32x4 acc = (f32x4){0.f, 0.f, 0.f, 0.f};
#pragma unroll
                for (int ks = 0; ks < 2; ++ks) acc = __builtin_amdgcn_mfma_f32_16x16x32_bf16(bfr[nt][ks], af[ks], acc, 0, 0, 0);
                const f32x4 bv = *(const f32x4*)(bias + 16 * nt);
                float ov[4];
#pragma unroll
                for (int jj = 0; jj < 4; ++jj) {
                    const float sg = sigm(acc[jj] + bv[jj]);
                    ov[jj] = mat ? sg : 1.f - __expf(-0.6065306597126334f * sg);
                }
                u32x2 o2; o2[0] = pk2(ov[0], ov[1]); o2[1] = pk2(ov[2], ov[3]);
                *(u32x2*)(dst + (size_t)(16 * m + fr) * 256 + 16 * nt) = o2;
            }
        }
    }
#pragma unroll 1
    for (int d = 0; d < 2; ++d) {
        bf16x8 bfr[2][4][2];
#pragma unroll
        for (int k = 0; k < 2; ++k)
#pragma unroll
            for (int nt = 0; nt < 4; ++nt)
#pragma unroll
                for (int ks = 0; ks < 2; ++ks)
                    bfr[k][nt][ks] = *(const bf16x8*)(ws_gw_t(p) + ((size_t)(((l * 2 + d) * 2 + k) * 4 + w) * 64 + 16 * nt + fr) * 64 + 32 * ks + 8 * fq);
        const int e00 = 64 * w + 4 * fq;
#pragma unroll 1
        for (int m = 0; m < 2; ++m) {
            bf16x8 af[2];
#pragma unroll
            for (int ks = 0; ks < 2; ++ks) af[ks] = *(const bf16x8*)(xc_s + (16 * m + fr) * XLD + 64 * w + 32 * ks + 8 * fq);
#pragma unroll
            for (int nt = 0; nt < 4; ++nt) {
                f32x4 g0 = (f32x4){0.f, 0.f, 0.f, 0.f}, g1 = g0;
#pragma unroll
                for (int ks = 0; ks < 2; ++ks) {
                    g0 = __builtin_amdgcn_mfma_f32_16x16x32_bf16(bfr[0][nt][ks], af[ks], g0, 0, 0, 0);
                    g1 = __builtin_amdgcn_mfma_f32_16x16x32_bf16(bfr[1][nt][ks], af[ks], g1, 0, 0, 0);
                }
                const int e0 = e00 + 16 * nt;
                const f32x4 gb0 = *(const f32x4*)(p.lru_gate_b + ((l * 2 + d) * 2 + 0) * 256 + e0), gb1 = *(const f32x4*)(p.lru_gate_b + ((l * 2 + d) * 2 + 1) * 256 + e0);
                const f32x4 lam = *(const f32x4*)(p.lru_lambda + (l * 2 + d) * 256 + e0);
                const u32x2 xu = *(const u32x2*)(xc_s + (16 * m + fr) * XLD + e0);
                const float xv[4] = {__uint_as_float(xu[0] << 16), __uint_as_float(xu[0] & 0xffff0000u), __uint_as_float(xu[1] << 16), __uint_as_float(xu[1] & 0xffff0000u)};
                float a1[4], bt[4];
#pragma unroll
                for (int jj = 0; jj < 4; ++jj) {
                    const float r = sigm(g0[jj] + gb0[jj]), ig = sigm(g1[jj] + gb1[jj]);
                    const float sp = __logf(1.f + __expf(-lam[jj]));
                    const float a = __expf(-8.f * r * sp);
                    a1[jj] = 1.f - a;
                    bt[jj] = sqrtf(a1[jj] * (1.f + a)) * ig * xv[jj];
                }
                const size_t o = d * SA_EL + (mbase + 16 * m + fr) * 256 + e0;
                u32x2 oa; oa[0] = pk2(a1[0], a1[1]); oa[1] = pk2(a1[2], a1[3]);
                u32x2 ob; ob[0] = pk2(bt[0], bt[1]); ob[1] = pk2(bt[2], bt[3]);
                *(u32x2*)(ws_la(p) + o) = oa; *(u32x2*)(ws_h0(p) + o) = ob;
            }
        }
    }
}

DEVI f2 fma2(f2 a, f2 b, f2 c) { return __builtin_elementwise_fma(a, b, c); }
DEVI void ph_rwkv_scan(const Params& p, int l, int item, char* smem, bool dry = false) {
    const int wv = __builtin_amdgcn_readfirstlane(tidx() >> 6), lane = tidx() & 63;
    const int wi = item * 4 + wv;
    const int scan = wi / 3, part = wi - scan * 3;
    const int b = scan >> 3, h = (scan >> 1) & 3, d = scan & 1;
    const int c8 = lane & 7, r8 = lane >> 3;
    float* ring = (float*)smem + wv * 1280;
    const char* A = (const char*)(ws_sA0(p) + d * SA_EL);
    const char* Wm = (const char*)(ws_sW0(p) + d * SA_EL);
    const char *R = (const char*)ws_sR(p), *K = (const char*)ws_sK(p), *V = (const char*)ws_sV(p), *KK = (const char*)ws_sKK(p);
    char* Y = (char*)(ws_z(p) + 256 + 256 * d + h * 64);
#define LDB(base, bo) (*(const bf16_t*)((base) + (bo)))
    const float ka = p.rwkv_k_a[l * 256 + h * 64 + lane];
    f2 S[3][4];
#pragma unroll
    for (int pp = 0; pp < 3; ++pp)
#pragma unroll
        for (int k = 0; k < 4; ++k) S[pp][k] = (f2){0.f, 0.f};
    const unsigned t00 = (unsigned)(b * T_ + (d ? T_ - 1 : 0)) * 256u + h * 64;
    const unsigned o0 = (t00 + lane) * 2u;
    int rowp[3]; unsigned ov[3];
#pragma unroll
    for (int pp = 0; pp < 3; ++pp) { rowp[pp] = 24 * part + 8 * pp + r8; ov[pp] = (t00 + (rowp[pp] < 64 ? rowp[pp] : 63)) * 2u; }
    const int stp = d ? -512 : 512;
    const int myp = c8 < 3 ? c8 : 0;
    const int myrow = 24 * part + 8 * myp + r8;
    const bool ystore = c8 < 3 && myrow < 64 && !dry;
    const unsigned yrow_b = (unsigned)myrow * 2u;
    float vcur[3], vnx[3];
#pragma unroll
    for (int s_ = 0; s_ < 2; ++s_) {
        const unsigned o = o0 + s_ * stp;
        const float r = bf2f(LDB(R, o)), k = bf2f(LDB(K, o)), kk = bf2f(LDB(KK, o)), a = bf2f(LDB(A, o)), w = 1.f - bf2f(LDB(Wm, o));
#pragma unroll
        for (int pp = 0; pp < 3; ++pp) { const float vv = bf2f(LDB(V, ov[pp] + s_ * stp)); if (s_ == 0) vcur[pp] = vv; else vnx[pp] = vv; }
        float* sl = ring + s_ * 320;
        sl[0 * 64 + lane] = w; sl[1 * 64 + lane] = kk * a; sl[2 * 64 + lane] = k * (1.f + (a - 1.f) * ka); sl[3 * 64 + lane] = r; sl[4 * 64 + lane] = kk;
    }
    bf16_t rr[8], rk[8], rkk[8], ra[8], rw[8], rv[8][3];
#pragma unroll
    for (int i = 0; i < 8; ++i) {
        const int st = (i < 2 ? 8 + i : i) * stp;
        rr[i] = LDB(R, o0 + st); rk[i] = LDB(K, o0 + st); rkk[i] = LDB(KK, o0 + st); ra[i] = LDB(A, o0 + st); rw[i] = LDB(Wm, o0 + st);
#pragma unroll
        for (int pp = 0; pp < 3; ++pp) rv[i][pp] = LDB(V, ov[pp] + st);
    }
    __builtin_amdgcn_wave_barrier();
    f32x4 OB[2][5][2];
#define RW_LDO(set, slw, slk) { _Pragma("unroll") for (int g = 0; g < 2; ++g) { \
        OB[set][0][g] = *(const f32x4*)((slw) + 0 * 64 + 8 * c8 + 4 * g); OB[set][1][g] = *(const f32x4*)((slw) + 1 * 64 + 8 * c8 + 4 * g); \
        OB[set][2][g] = *(const f32x4*)((slw) + 2 * 64 + 8 * c8 + 4 * g); OB[set][3][g] = *(const f32x4*)((slw) + 3 * 64 + 8 * c8 + 4 * g); \
        OB[set][4][g] = *(const f32x4*)((slk) + 4 * 64 + 8 * c8 + 4 * g); } }
    RW_LDO(0, ring, ring + 320)
    float sktot[3] = {0.f, 0.f, 0.f};
    __builtin_amdgcn_s_setprio(3);
    for (int sb = 0; sb < T_; sb += 8) {
#pragma unroll
        for (int i = 0; i < 8; ++i) {
            const int step = sb + i;
            const int slot = (i + 2) & 7;
            float v2n[3];
            {
                float* sn = ring + ((i + 2) & 3) * 320;
                const float r1 = bf2f(rr[slot]), k1 = bf2f(rk[slot]), kk1 = bf2f(rkk[slot]), a1 = bf2f(ra[slot]), w1 = 1.f - bf2f(rw[slot]);
                sn[0 * 64 + lane] = w1; sn[1 * 64 + lane] = kk1 * a1; sn[2 * 64 + lane] = k1 * (1.f + (a1 - 1.f) * ka); sn[3 * 64 + lane] = r1; sn[4 * 64 + lane] = kk1;
#pragma unroll
                for (int pp = 0; pp < 3; ++pp) v2n[pp] = bf2f(rv[slot][pp]);
            }
            {
                const int s10 = (step + 10 < T_ ? step + 10 : T_ - 1) * stp;
                const unsigned oc = o0 + s10;
                rr[slot] = LDB(R, oc); rk[slot] = LDB(K, oc); rkk[slot] = LDB(KK, oc); ra[slot] = LDB(A, oc); rw[slot] = LDB(Wm, oc);
#pragma unroll
                for (int pp = 0; pp < 3; ++pp) rv[slot][pp] = LDB(V, ov[pp] + s10);
            }
            __builtin_amdgcn_wave_barrier();
            RW_LDO((i + 1) & 1, ring + ((i + 1) & 3) * 320, ring + ((i + 2) & 3) * 320)
            const unsigned tok_b = (unsigned)(b * T_ + (d ? T_ - 1 - step : step)) * (unsigned)(DIN * 2);
            float pyv[3];
#pragma unroll
            for (int pp = 0; pp < 3; ++pp) {
                const f2 nsk2 = (f2){-sktot[pp], -sktot[pp]}, v2 = (f2){vcur[pp], vcur[pp]};
                f2 y2 = (f2){0.f, 0.f}, sk2 = (f2){0.f, 0.f};
#pragma unroll
                for (int g = 0; g < 2; ++g) {
                    const f32x4 w4 = OB[i & 1][0][g], b4 = OB[i & 1][1][g], kd4 = OB[i & 1][2][g], r4 = OB[i & 1][3][g], kn4 = OB[i & 1][4][g];
                    f2 t0 = v2 * kd4.xy; t0 = fma2(nsk2, b4.xy, t0);
                    S[pp][2 * g] = fma2(S[pp][2 * g], w4.xy, t0);
                    y2 = fma2(S[pp][2 * g], r4.xy, y2); sk2 = fma2(S[pp][2 * g], kn4.xy, sk2);
                    f2 t1 = v2 * kd4.zw; t1 = fma2(nsk2, b4.zw, t1);
                    S[pp][2 * g + 1] = fma2(S[pp][2 * g + 1], w4.zw, t1);
                    y2 = fma2(S[pp][2 * g + 1], r4.zw, y2); sk2 = fma2(S[pp][2 * g + 1], kn4.zw, sk2);
                }
                float ps = sk2.x + sk2.y, py = y2.x + y2.y;
                ps += dppx<0xB1>(ps); py += dppx<0xB1>(py);
                ps += dppx<0x4E>(ps); py += dppx<0x4E>(py);
                ps += dppx<0x141>(ps); py += dppx<0x141>(py);
                sktot[pp] = ps; pyv[pp] = py;
                vcur[pp] = vnx[pp]; vnx[pp] = v2n[pp];
            }
            {
                const float ysel = c8 == 0 ? pyv[0] : c8 == 1 ? pyv[1] : pyv[2];
                if (ystore) *(bf16_t*)(Y + (tok_b + yrow_b)) = f2bf(ysel);
            }
        }
    }
    __builtin_amdgcn_s_setprio(0);
#undef RW_LDO
#undef LDB
}

DEVI void ph_lru_scan(const Params& p, int l, int item, bool dry = false) {
    const int lane = tidx() & 63, idx = item * 4 + (tidx() >> 6);
    const int b = idx >> 3, n = (idx >> 1) & 3, d = idx & 1;
    const bf16_t* A = ws_la(p) + d * SA_EL + (size_t)b * T_ * 256 + n * 64 + lane;
    bf16_t* H = ws_h0(p) + d * SA_EL + (size_t)b * T_ * 256 + n * 64 + lane;
    float h = 0.f;
    for (int s0 = 0; s0 < T_; s0 += 32) {
        bf16_t av[32], bv[32];
#pragma unroll
        for (int i = 0; i < 32; ++i) { const int t = d ? T_ - 1 - (s0 + i) : s0 + i; av[i] = A[(size_t)t * 256]; bv[i] = H[(size_t)t * 256]; }
#pragma unroll
        for (int i = 0; i < 32; ++i) {
            const int t = d ? T_ - 1 - (s0 + i) : s0 + i;
            h = (1.f - bf2f(av[i])) * h + bf2f(bv[i]);
            if (!dry) H[(size_t)t * 256] = f2bf(h);
        }
    }
}

DEVI void ph_post(const Params& p, int l, int item) {
    const int j = tidx();
    const float lg = p.rwkv_ln_g[l * 256 + j], lb = p.rwkv_ln_b[l * 256 + j], ka = p.rwkv_k_a[l * 256 + j], rk_ = p.rwkv_r_k[l * 256 + j];
    bf16_t yf[16], yr[16], r_[16], k_[16], v_[16], af[16], ar[16], ga[16], hf[16], hr[16], gc[16];
#pragma unroll
    for (int i = 0; i < 16; ++i) {
        const int m = item * 16 + i;
        const size_t o = (size_t)m * 256 + j;
        const bf16_t* zr = ws_z(p) + (size_t)m * DIN;
        yf[i] = zr[256 + j]; yr[i] = zr[512 + j]; r_[i] = ws_sR(p)[o]; k_[i] = ws_sK(p)[o]; v_[i] = ws_sV(p)[o];
        af[i] = ws_sA0(p)[o]; ar[i] = ws_sA0(p)[o + SA_EL]; ga[i] = zr[OFF_A + 896 + j];
        hf[i] = ws_h0(p)[o]; hr[i] = ws_h0(p)[o + SA_EL]; gc[i] = zr[OFF_C + 256 + j];
    }
#pragma unroll
    for (int i = 0; i < 16; ++i) {
        const int m = item * 16 + i;
        bf16_t* zr = ws_z(p) + (size_t)m * DIN;
        const float y = bf2f(yf[i]) + bf2f(yr[i]);
        const float mu = wave_sum(y) * (1.f / 64.f);
        const float dv = y - mu;
        const float var = wave_sum(dv * dv) * (1.f / 64.f);
        const float yn = dv * rsqrtf(var + 64e-5f) * lg + lb;
        const float r = bf2f(r_[i]), k = bf2f(k_[i]), v = bf2f(v_[i]), a_f = bf2f(af[i]), a_r = bf2f(ar[i]);
        const float ksum = k * (1.f + (a_f - 1.f) * ka) + k * (1.f + (a_r - 1.f) * ka);
        const float bon = wave_sum(r * ksum * rk_) * v;
        const float g = bf2f(ga[i]);
        zr[OFF_A + j] = f2bf((yn + bon) * g * sigm(g));
        const float h = bf2f(hf[i]) + bf2f(hr[i]);
        const float g2 = bf2f(gc[i]);
        zr[OFF_C + j] = f2bf(h * g2 * sigm(g2));
    }
}

template <int WIN>
DEVI void ph_attn_naive(const Params& p, int l, int item) {
    const int lane = tidx() & 63, idx = item * 4 + (tidx() >> 6);
    const int qb = idx & 31, hq = (idx >> 5) & 3, b = idx >> 7;
    const int g = hq >> 1;
    constexpr int OFF = WIN ? OFF_D : OFF_B;
    const int t0 = qb * 64, t = t0 + lane;
    bf16_t* zq = ws_z(p) + ((size_t)b * T_ + t) * DIN + OFF + hq * 64;
    float q[64], o[64];
#pragma unroll
    for (int c = 0; c < 8; ++c) {
        const uint4 u = *(const uint4*)(zq + c * 8);
        const unsigned uu[4] = {u.x, u.y, u.z, u.w};
#pragma unroll
        for (int e = 0; e < 4; ++e) { q[c * 8 + 2 * e] = __uint_as_float(uu[e] << 16); q[c * 8 + 2 * e + 1] = __uint_as_float(uu[e] & 0xffff0000u); }
    }
#pragma unroll
    for (int dd = 0; dd < 64; ++dd) o[dd] = 0.f;
    float mx, ls;
    float slope = 0.f;
    if (WIN) { mx = p.swa_sink[l * 4 + hq]; ls = 1.f; slope = exp2f(-8.f * (float)(hq + 1) / 4.f); }
    else { mx = -1e30f; ls = 0.f; }
    const int s0 = WIN ? max(0, t0 - 128) : 0, s1 = WIN ? min(T_ - 1, t0 + 63 + 128) : T_ - 1;
    const bf16_t* kb = ws_z(p) + (size_t)b * T_ * DIN + OFF + 256 + g * 64;
    for (int s = s0; s <= s1; ++s) {
        const bf16_t* kr = kb + (size_t)s * DIN;
        float sc = 0.f;
#pragma unroll
        for (int c = 0; c < 8; ++c) {
            const uint4 u = *(const uint4*)(kr + c * 8);
            const unsigned uu[4] = {u.x, u.y, u.z, u.w};
#pragma unroll
            for (int e = 0; e < 4; ++e) { sc += q[c * 8 + 2 * e] * __uint_as_float(uu[e] << 16); sc += q[c * 8 + 2 * e + 1] * __uint_as_float(uu[e] & 0xffff0000u); }
        }
        bool valid = true;
        if (WIN) { const int dist = abs(t - s); valid = dist <= 128; sc = sc * 0.125f - slope * (float)dist; }
        const float mn = valid ? fmaxf(mx, sc) : mx;
        const float al = __expf(mx - mn);
        const float pp = valid ? __expf(sc - mn) : 0.f;
        mx = mn; ls = ls * al + pp;
#pragma unroll
        for (int c = 0; c < 8; ++c) {
            const uint4 u = *(const uint4*)(kr + 128 + c * 8);
            const unsigned uu[4] = {u.x, u.y, u.z, u.w};
#pragma unroll
            for (int e = 0; e < 4; ++e) {
                o[c * 8 + 2 * e] = o[c * 8 + 2 * e] * al + pp * __uint_as_float(uu[e] << 16);
                o[c * 8 + 2 * e + 1] = o[c * 8 + 2 * e + 1] * al + pp * __uint_as_float(uu[e] & 0xffff0000u);
            }
        }
    }
    const float il = 1.f / ls;
    const bf16_t* zg = zq - hq * 64 + 512 + hq * 64;
#pragma unroll
    for (int c = 0; c < 8; ++c) {
        const uint4 u = *(const uint4*)(zg + c * 8);
        const unsigned uu[4] = {u.x, u.y, u.z, u.w};
        unsigned ov[4];
#pragma unroll
        for (int e = 0; e < 4; ++e) {
            const float g0 = __uint_as_float(uu[e] << 16), g1 = __uint_as_float(uu[e] & 0xffff0000u);
            ov[e] = pk2(o[c * 8 + 2 * e] * il * g0 * sigm(g0), o[c * 8 + 2 * e + 1] * il * g1 * sigm(g1));
        }
        *(uint4*)(zq + c * 8) = make_uint4(ov[0], ov[1], ov[2], ov[3]);
    }
}

constexpr int ALD = 72;
template <int WIN>
DEVI void ph_attn(const Params& p, int l, int item, char* smem, bool dry = false) {
    constexpr int OFF = WIN ? OFF_D : OFF_B;
    const int qb = item & 15, hq = (item >> 4) & 3, b = item >> 6, g = hq >> 1;
    const int tid = tidx(), w = tid >> 6, lane = tid & 63, fr = lane & 15, fq = lane >> 4;
    const int t0 = qb * 128, tw = t0 + 32 * w;
    bf16_t* Ks = (bf16_t*)smem;
    bf16_t* Vt = Ks + 2 * 64 * ALD;
    bf16_t* zb = ws_z(p) + (size_t)b * T_ * DIN;
    bf16x8 qf[2][2];
#pragma unroll
    for (int n = 0; n < 2; ++n)
#pragma unroll
        for (int ks = 0; ks < 2; ++ks) {
            u32x4 u = *(const u32x4*)(zb + (size_t)(tw + 16 * n + fr) * DIN + OFF + hq * 64 + 32 * ks + 8 * fq);
            if (WIN) {
                constexpr float sc = 0.125f * 1.4426950408889634f;
#pragma unroll
                for (int e = 0; e < 4; ++e) u[e] = pk2(__uint_as_float(u[e] << 16) * sc, __uint_as_float(u[e] & 0xffff0000u) * sc);
            }
            qf[n][ks] = __builtin_bit_cast(bf16x8, u);
        }
    const int kt0 = WIN ? max(0, t0 - 128) / 64 : 0, kt1 = WIN ? min(T_, t0 + 256) / 64 : T_ / 64;
    f32x4 ot[4][2];
#pragma unroll
    for (int dm = 0; dm < 4; ++dm)
#pragma unroll
        for (int n = 0; n < 2; ++n) ot[dm][n] = (f32x4){0.f, 0.f, 0.f, 0.f};
    float mrun[2], lrun[2];
    float slope2 = 0.f;
    if (WIN) {
        const float sk = p.swa_sink[l * 4 + hq] * 1.4426950408889634f;
        mrun[0] = mrun[1] = sk; lrun[0] = lrun[1] = fq == 0 ? 1.f : 0.f;
        slope2 = exp2f(-2.f * (float)(hq + 1)) * 1.4426950408889634f;
    } else { mrun[0] = mrun[1] = -1e30f; lrun[0] = lrun[1] = 0.f; }
    const bf16_t* kbase = zb + OFF + 256 + g * 64;
    const bf16_t* vbase = zb + OFF + 384 + g * 64;
    u32x4 rk[2], rv[2];
    const int kkey = tid >> 2, kc = tid & 3, vkey = tid & 63, vc = tid >> 6;
    auto gload = [&](int kt) __attribute__((always_inline)) {
        const bf16_t* kp = kbase + (size_t)(kt * 64 + kkey) * DIN + kc * 16;
        rk[0] = *(const u32x4*)kp; rk[1] = *(const u32x4*)(kp + 8);
        const bf16_t* vp = vbase + (size_t)(kt * 64 + vkey) * DIN + vc * 16;
        rv[0] = *(const u32x4*)vp; rv[1] = *(const u32x4*)(vp + 8);
    };
    auto swrite = [&](int buf) __attribute__((always_inline)) {
        bf16_t* kd = Ks + (buf * 64 + kkey) * ALD + kc * 16;
        *(u32x4*)kd = rk[0]; *(u32x4*)(kd + 8) = rk[1];
        bf16_t* vd = Vt + (buf * 64 + vc * 16) * ALD + vkey;
#pragma unroll
        for (int h = 0; h < 2; ++h)
#pragma unroll
            for (int e = 0; e < 4; ++e) {
                vd[(h * 8 + 2 * e) * ALD] = (bf16_t)(rv[h][e] & 0xffffu);
                vd[(h * 8 + 2 * e + 1) * ALD] = (bf16_t)(rv[h][e] >> 16);
            }
    };
    __syncthreads();
    gload(kt0); swrite(0);
    __syncthreads();
    for (int kt = kt0; kt < kt1; ++kt) {
        const int buf = (kt - kt0) & 1;
        if (kt + 1 < kt1) gload(kt + 1);
        f32x4 st[4][2];
#pragma unroll
        for (int m = 0; m < 4; ++m)
#pragma unroll
            for (int n = 0; n < 2; ++n) st[m][n] = (f32x4){0.f, 0.f, 0.f, 0.f};
#pragma unroll
        for (int ks = 0; ks < 2; ++ks)
#pragma unroll
            for (int m = 0; m < 4; ++m) {
                const bf16x8 kf = *(const bf16x8*)(Ks + (buf * 64 + 16 * m + fr) * ALD + 32 * ks + 8 * fq);
#pragma unroll
                for (int n = 0; n < 2; ++n) st[m][n] = __builtin_amdgcn_mfma_f32_16x16x32_bf16(kf, qf[n][ks], st[m][n], 0, 0, 0);
            }
        if (WIN) {
#pragma unroll
            for (int m = 0; m < 4; ++m)
#pragma unroll
                for (int n = 0; n < 2; ++n)
#pragma unroll
                    for (int j = 0; j < 4; ++j) {
                        const int dist = abs((tw + 16 * n + fr) - (kt * 64 + 16 * m + 4 * fq + j));
                        st[m][n][j] = dist <= 128 ? st[m][n][j] - slope2 * (float)dist : -1e30f;
                    }
        }
#pragma unroll
        for (int n = 0; n < 2; ++n) {
            float mt = st[0][n][0];
#pragma unroll
            for (int m = 0; m < 4; ++m)
#pragma unroll
                for (int j = 0; j < 4; ++j) mt = fmaxf(mt, st[m][n][j]);
            mt = fmaxf(mt, __shfl_xor(mt, 16)); mt = fmaxf(mt, __shfl_xor(mt, 32));
            const float mn = fmaxf(mrun[n], mt);
            const float alpha = __builtin_amdgcn_exp2f(mrun[n] - mn);
            mrun[n] = mn;
            float lsum = 0.f;
#pragma unroll
            for (int m = 0; m < 4; ++m)
#pragma unroll
                for (int j = 0; j < 4; ++j) { const float pv = __builtin_amdgcn_exp2f(st[m][n][j] - mn); lsum += pv; st[m][n][j] = pv; }
            lrun[n] = lrun[n] * alpha + lsum;
#pragma unroll
            for (int dm = 0; dm < 4; ++dm) ot[dm][n] = ot[dm][n] * alpha;
        }
#pragma unroll
        for (int kk = 0; kk < 2; ++kk) {
            bf16x8 pf[2];
#pragma unroll
            for (int n = 0; n < 2; ++n) {
                u32x4 u;
                u[0] = pk2(st[2 * kk][n][0], st[2 * kk][n][1]); u[1] = pk2(st[2 * kk][n][2], st[2 * kk][n][3]);
                u[2] = pk2(st[2 * kk + 1][n][0], st[2 * kk + 1][n][1]); u[3] = pk2(st[2 * kk + 1][n][2], st[2 * kk + 1][n][3]);
                pf[n] = __builtin_bit_cast(bf16x8, u);
            }
#pragma unroll
            for (int dm = 0; dm < 4; ++dm) {
                const bf16_t* vp = Vt + (buf * 64 + 16 * dm + fr) * ALD + 32 * kk + 4 * fq;
                const u32x2 v0 = *(const u32x2*)vp, v1 = *(const u32x2*)(vp + 16);
                const bf16x8 vf = __builtin_bit_cast(bf16x8, (u32x4){v0[0], v0[1], v1[0], v1[1]});
#pragma unroll
                for (int n = 0; n < 2; ++n) ot[dm][n] = __builtin_amdgcn_mfma_f32_16x16x32_bf16(vf, pf[n], ot[dm][n], 0, 0, 0);
            }
        }
        if (kt + 1 < kt1) swrite(buf ^ 1);
        __syncthreads();
    }
#pragma unroll
    for (int n = 0; n < 2; ++n) {
        float lt = lrun[n];
        lt += __shfl_xor(lt, 16); lt += __shfl_xor(lt, 32);
        const float il = 1.f / lt;
        bf16_t* zr = zb + (size_t)(tw + 16 * n + fr) * DIN + OFF + hq * 64 + 4 * fq;
#pragma unroll
        for (int dm = 0; dm < 4; ++dm) {
            const u32x2 gu = *(const u32x2*)(zr + 512 + 16 * dm);
            float gv[4] = {__uint_as_float(gu[0] << 16), __uint_as_float(gu[0] & 0xffff0000u), __uint_as_float(gu[1] << 16), __uint_as_float(gu[1] & 0xffff0000u)};
            float ov[4];
#pragma unroll
            for (int j = 0; j < 4; ++j) ov[j] = ot[dm][n][j] * il * gv[j] * sigm(gv[j]);
            u32x2 o2; o2[0] = pk2(ov[0], ov[1]); o2[1] = pk2(ov[2], ov[3]);
            if (!dry) *(u32x2*)(zr + 16 * dm) = o2;
        }
    }
}

DEVI void gbar(unsigned* ctr, unsigned target) {
    asm volatile("s_waitcnt vmcnt(0)" ::: "memory");
    __syncthreads();
    if (threadIdx.x == 0) {
        __builtin_amdgcn_fence(__ATOMIC_RELEASE, "agent");
        asm volatile("s_waitcnt vmcnt(0)" ::: "memory");
        (void)__hip_atomic_fetch_add(ctr, 1u, __ATOMIC_RELAXED, __HIP_MEMORY_SCOPE_AGENT);
        while (__hip_atomic_load(ctr, __ATOMIC_RELAXED, __HIP_MEMORY_SCOPE_AGENT) < target) __builtin_amdgcn_s_sleep(1);
        __builtin_amdgcn_fence(__ATOMIC_ACQUIRE, "agent");
        asm volatile("s_waitcnt vmcnt(0)" ::: "memory");
    }
    __syncthreads();
}

enum { PH_CONVW, PH_ROWNORM, PH_GEMM1, PH_PREP, PH_RWKV, PH_LRU, PH_ATTNB, PH_ATTND, PH_POST, PH_GEMM2, PH_FINAL };
#ifndef MK_MULTI
#define MK_MULTI 0
#endif
#ifndef PROBE_PREP
#define PROBE_PREP 0
#endif
#ifndef PROBE_MIX
#define PROBE_MIX 0
#endif
#ifndef PROBE_G2
#define PROBE_G2 0
#endif
#if MK_MULTI
template <int PH>
__global__ void __launch_bounds__(256) kph(Params p, int l, int nitems) {
    extern __shared__ __attribute__((aligned(16))) char smem[];
    for (int item = blockIdx.x; item < nitems; item += gridDim.x) {
        if (PH == PH_CONVW) ph_convw(p, item, smem);
        if (PH == PH_ROWNORM) ph_rownorm(p, l, item);
        if (PH == PH_GEMM1) { if (item == (int)blockIdx.x) ph_gemm_all<0>(p, l, blockIdx.x, gridDim.x, smem); }
        if (PH == PH_PREP) ph_prep(p, l, item, smem);
        if (PH == PH_RWKV) ph_rwkv_scan(p, l, item, smem);
        if (PH == PH_LRU) ph_lru_scan(p, l, item);
        if (PH == PH_ATTNB) ph_attn_naive<0>(p, l, item);
        if (PH == PH_ATTND) ph_attn_naive<1>(p, l, item);
        if (PH == PH_POST) ph_post(p, l, item);
        if (PH == PH_GEMM2) { if (item == (int)blockIdx.x) ph_gemm_all<1>(p, l, blockIdx.x, gridDim.x, smem); }
        if (PH == PH_FINAL) ph_final(p, item);
    }
}
template <int PH>
static void launch(const Params& p, int l, int nitems, int lds, hipStream_t stream) {
    if (lds > 48 * 1024) (void)hipFuncSetAttribute((const void*)kph<PH>, hipFuncAttributeMaxDynamicSharedMemorySize, lds);
    int grid = nitems < 65536 ? nitems : 65536;
    hipLaunchKernelGGL(kph<PH>, dim3(grid), dim3(256), lds, stream, p, l, nitems);
}
#else
constexpr int MIX_ITEMS = 80 + 2560 + 2560;
__global__ void __launch_bounds__(256, 2) mega(Params p) {
    extern __shared__ __attribute__((aligned(16))) char smem[];
    __shared__ int s_item;
    cg::grid_group grid = cg::this_grid();
    const int G = gridDim.x, bid = blockIdx.x;
    unsigned nbar = 0;
    if (bid == 0 && threadIdx.x < 64) ws_ctr(p)[threadIdx.x] = 0;
    for (int it = bid; it < CW_ITEMS; it += G) ph_convw(p, it, smem);
    grid.sync();
    for (int l = 0; l < NL; ++l) {
        if (l == 0) {
            for (int it = bid; it < NTOK / 4; it += G) ph_rownorm(p, l, it);
            gbar(ws_gbar(p), (nbar += (unsigned)G));
        }
        ph_gemm_all<0>(p, l, bid, G, smem);
        gbar(ws_gbar(p), (nbar += (unsigned)G));
#if PROBE_PREP
        for (int it = bid; it < NTOK / 32; it += G) ph_prep(p, l, it, smem, true);
#endif
        for (int it = bid; it < NTOK / 32; it += G) ph_prep(p, l, it, smem);
        gbar(ws_gbar(p), (nbar += (unsigned)G));
#if PROBE_MIX
        for (int rep = 0; rep < 2; ++rep) {
        const bool dry = rep == 0;
        int* ctrp = &ws_ctr(p)[l + 4 * rep];
#else
        {
        const bool dry = false;
        int* ctrp = &ws_ctr(p)[l];
#endif
        for (int it = bid; it < 240; it += G) ph_rwkv_scan(p, l, it, smem, dry);
        for (;;) {
            __syncthreads();
            if (threadIdx.x == 0) s_item = atomicAdd(ctrp, 1);
            __syncthreads();
            const int it = s_item;
            if (it >= MIX_ITEMS) break;
            if (it < 80) ph_lru_scan(p, l, it, dry);
            else if (it < 2640) ph_attn<0>(p, l, it - 80, smem, dry);
            else ph_attn<1>(p, l, it - 2640, smem, dry);
        }
        }
        gbar(ws_gbar(p), (nbar += (unsigned)G));
        for (int it = bid; it < NTOK / 16; it += G) ph_post(p, l, it);
        gbar(ws_gbar(p), (nbar += (unsigned)G));
#if PROBE_G2
        ph_gemm_all<1>(p, l, bid, G, smem, true);
#endif
        ph_gemm_all<1>(p, l, bid, G, smem);
        gbar(ws_gbar(p), (nbar += (unsigned)G));
    }
    for (int it = bid; it < NTOK / 4; it += G) ph_final(p, it);
}
#endif

extern "C" void kernel_launch(void* const* d_in, const int* in_sizes, int n_in, void* d_out, int out_size, void* d_ws, size_t ws_size,
                              hipStream_t stream) {
    Params p{};
    const float* const* in = (const float* const*)d_in;
    p.x_prompt = in[0]; p.x_sample = in[1]; p.norm_g = in[2]; p.w_in = in[3]; p.w_out = in[4]; p.rwkv_shift = in[5]; p.rwkv_w0 = in[6];
    p.rwkv_w_up = in[7]; p.rwkv_a0 = in[8]; p.rwkv_a_up = in[9]; p.rwkv_k_k = in[10]; p.rwkv_k_a = in[11]; p.rwkv_r_k = in[12];
    p.rwkv_ln_g = in[13]; p.rwkv_ln_b = in[14]; p.attn_q_norm = in[15]; p.attn_k_norm = in[16]; p.lru_conv_w = in[17]; p.lru_conv_b = in[18];
    p.lru_gate_w = in[19]; p.lru_gate_b = in[20]; p.lru_lambda = in[21]; p.swa_sink = in[22]; p.final_g = in[23];
    p.out = (float*)d_out;
    p.ws = (char*)d_ws;
    if (WS_NEED > ws_size) { fprintf(stderr, "workspace too small: need %zu have %zu\n", (size_t)WS_NEED, ws_size); }

#if MK_MULTI
    launch<PH_CONVW>(p, 0, CW_ITEMS, 64 * 65 * 4, stream);
    for (int l = 0; l < NL; ++l) {
        if (l == 0) launch<PH_ROWNORM>(p, l, NTOK / 4, 0, stream);
        launch<PH_GEMM1>(p, l, (NTOK / GBM) * (DIN / GBN), GEMM_LDS, stream);
        launch<PH_PREP>(p, l, NTOK / 32, PREP_LDS, stream);
        launch<PH_RWKV>(p, l, 240, 4 * 5120, stream);
        launch<PH_LRU>(p, l, 80, 0, stream);
        launch<PH_ATTNB>(p, l, 1280, 0, stream);
        launch<PH_ATTND>(p, l, 1280, 0, stream);
        launch<PH_POST>(p, l, NTOK / 16, 0, stream);
        launch<PH_GEMM2>(p, l, (NTOK / GBM) * (DM / GBN), GEMM_LDS, stream);
    }
    launch<PH_FINAL>(p, 0, NTOK / 4, 0, stream);
#else
    constexpr size_t kDynLds = GEMM_LDS;
    static int grid_blocks = 0;
    if (!grid_blocks) {
        (void)hipFuncSetAttribute((const void*)mega, hipFuncAttributeMaxDynamicSharedMemorySize, (int)kDynLds);
        int dev = 0, cus = 0, per_cu = 0;
        (void)hipGetDevice(&dev);
        (void)hipDeviceGetAttribute(&cus, hipDeviceAttributeMultiprocessorCount, dev);
        (void)hipOccupancyMaxActiveBlocksPerMultiprocessor(&per_cu, mega, 256, kDynLds);
        if (per_cu < 1) per_cu = 1;
        grid_blocks = cus * per_cu;
    }
    (void)hipMemsetAsync((char*)d_ws + WO_GBAR, 0, 256, stream);
    void* args[] = {&p};
    hipError_t e = hipLaunchCooperativeKernel((void*)mega, dim3(grid_blocks), dim3(256), args, kDynLds, stream);
    if (e != hipSuccess) fprintf(stderr, "cooperative launch failed: %s (grid %d)\n", hipGetErrorString(e), grid_blocks);
#endif
}
```

```cpp
#include <hip/hip_runtime.h>
#include <hip/hip_cooperative_groups.h>
#include <cstdio>
#include <cstdint>
namespace cg = cooperative_groups;

#define DEVI __device__ __forceinline__
typedef unsigned short bf16_t;
typedef short bf16x8 __attribute__((ext_vector_type(8)));
typedef float f32x4 __attribute__((ext_vector_type(4)));

constexpr int T_ = 2048, NB_ = 40, NTOK = NB_ * T_, DM = 1024, DIN = 3200, NL = 4;
constexpr int NPROMPT = 32 * T_;
constexpr size_t SA_EL = (size_t)NTOK * 256;
constexpr int OFF_A = 0, OFF_B = 1152, OFF_C = 1920, OFF_D = 2432;

struct Params {
    const float *x_prompt, *x_sample, *norm_g, *w_in, *w_out, *rwkv_shift, *rwkv_w0, *rwkv_w_up, *rwkv_a0, *rwkv_a_up,
        *rwkv_k_k, *rwkv_k_a, *rwkv_r_k, *rwkv_ln_g, *rwkv_ln_b, *attn_q_norm, *attn_k_norm, *lru_conv_w, *lru_conv_b,
        *lru_gate_w, *lru_gate_b, *lru_lambda, *swa_sink, *final_g;
    float* out;
    char* ws;
};
constexpr size_t al256(size_t x) { return (x + 255) & ~(size_t)255; }
constexpr size_t WO_WT_IN = 0;
constexpr size_t WO_WT_OUT = WO_WT_IN + al256((size_t)NL * DIN * DM * 2);
constexpr size_t WO_XB = WO_WT_OUT + al256((size_t)NL * DM * DM * 2);
constexpr size_t WO_Z = WO_XB + al256((size_t)NTOK * DM * 2);
constexpr size_t WO_SR = WO_Z + al256((size_t)NTOK * DIN * 2);
constexpr size_t WO_SK = WO_SR + SA_EL * 2, WO_SV = WO_SK + SA_EL * 2, WO_SKK = WO_SV + SA_EL * 2, WO_SA0 = WO_SKK + SA_EL * 2, WO_SW0 = WO_SA0 + 2 * SA_EL * 2;
constexpr size_t WO_CTR = WO_SW0 + 2 * SA_EL * 2;
constexpr size_t WO_WUP = WO_CTR + 256, WO_AUP = WO_WUP + (size_t)NL * 2 * 256 * 64 * 2, WO_GW = WO_AUP + (size_t)NL * 2 * 256 * 64 * 2, WO_ROPE = WO_GW + (size_t)NL * 16 * 4096 * 2;
constexpr size_t WO_GBAR = WO_ROPE + 2048 * 4;
constexpr size_t WO_PART = WO_GBAR + 256;
constexpr size_t WS_NEED = WO_PART + (size_t)NTOK * 16 * 4;
#define WSF(name, T, off) DEVI T* ws_##name(const Params& p) { return (T*)(p.ws + (off)); }
WSF(wt_in, bf16_t, WO_WT_IN) WSF(wt_out, bf16_t, WO_WT_OUT) WSF(xb, bf16_t, WO_XB) WSF(z, bf16_t, WO_Z) WSF(sR, bf16_t, WO_SR) WSF(sK, bf16_t, WO_SK)
WSF(sV, bf16_t, WO_SV) WSF(sKK, bf16_t, WO_SKK) WSF(sA0, bf16_t, WO_SA0) WSF(sW0, bf16_t, WO_SW0) WSF(la, bf16_t, WO_XB) WSF(h0, bf16_t, WO_XB + 2 * SA_EL * 2)
WSF(ctr, int, WO_CTR) WSF(gbar, unsigned, WO_GBAR) WSF(part, float, WO_PART) WSF(wup_t, bf16_t, WO_WUP) WSF(aup_t, bf16_t, WO_AUP) WSF(gw_t, bf16_t, WO_GW) WSF(rope, float, WO_ROPE)

DEVI float bf2f(bf16_t h) { return __uint_as_float(((unsigned)h) << 16); }
DEVI bf16_t f2bf(float f) { return __builtin_bit_cast(bf16_t, (__bf16)f); }
typedef float f2 __attribute__((ext_vector_type(2)));
typedef __bf16 b2_t __attribute__((ext_vector_type(2)));
DEVI unsigned pk2(float lo, float hi) { f2 v = {lo, hi}; return __builtin_bit_cast(unsigned, __builtin_convertvector(v, b2_t)); }
typedef unsigned u32x4 __attribute__((ext_vector_type(4)));
typedef unsigned u32x2 __attribute__((ext_vector_type(2)));
DEVI float sigm(float x) { return 1.f / (1.f + __expf(-x)); }
DEVI float dpp_f(float v, int) { return v; }
template <int CTRL> DEVI float dppx(float v) { return __builtin_bit_cast(float, __builtin_amdgcn_update_dpp(0, __builtin_bit_cast(int, v), CTRL, 0xf, 0xf, true)); }
DEVI float wave_sum(float v) {
    v += dppx<0xB1>(v);
    v += dppx<0x4E>(v);
    v += dppx<0x141>(v);
    v += dppx<0x140>(v);
    v += __shfl_xor(v, 16); v += __shfl_xor(v, 32);
    return v;
}
DEVI float rdl(float v, int j) { return __builtin_bit_cast(float, __builtin_amdgcn_readlane(__builtin_bit_cast(int, v), j)); }
DEVI const float* xrow(const Params& p, int l, int m) {
    if (l > 0) return p.out + (size_t)m * DM;
    const float* xp = p.x_prompt; const float* xs = p.x_sample;
    const long delta = (xs - xp) - (long)NPROMPT * DM;
    return xp + (size_t)m * DM + (m >= NPROMPT ? delta : (long)0);
}

DEVI int tidx() { int t = threadIdx.x; asm volatile("" : "+v"(t)); return t; }
constexpr int CW_PER_L = 1088, CW_ITEMS = NL * CW_PER_L + 1;
DEVI void ph_convw(const Params& p, int item, char* smem) {
    float* tile = (float*)smem;
    if (item == NL * CW_PER_L) {
        for (int e = tidx(); e < 1024; e += 256) {
            const int pos = e >> 4, i = e & 15;
            const float inv = exp2f(-(float)i * (13.287712379549449f / 16.f));
            const float ang = (float)pos * inv;
            ws_rope(p)[2 * e] = cosf(ang); ws_rope(p)[2 * e + 1] = sinf(ang);
        }
        return;
    }
    const int l = item / CW_PER_L; int r = item % CW_PER_L;
    const float* src; bf16_t* dst; int N, K, k0, n0;
    if (r < 800) { src = p.w_in + (size_t)l * DM * DIN; dst = ws_wt_in(p) + (size_t)l * DIN * DM; N = DIN; K = DM; k0 = (r / 50) * 64; n0 = (r % 50) * 64; }
    else if (r < 1056) { r -= 800; src = p.w_out + (size_t)l * DM * DM; dst = ws_wt_out(p) + (size_t)l * DM * DM; N = DM; K = DM; k0 = (r / 16) * 64; n0 = (r % 16) * 64; }
    else if (r < 1072) { r -= 1056; const int d = (r >> 2) & 1, up = r >> 3; const size_t o = (size_t)(l * 2 + d) * 64 * 256;
        src = (up ? p.rwkv_a_up : p.rwkv_w_up) + o; dst = (up ? ws_aup_t(p) : ws_wup_t(p)) + o; N = 256; K = 64; k0 = 0; n0 = (r & 3) * 64; }
    else { r -= 1072; const size_t o = (size_t)(l * 16 + r) * 4096; src = p.lru_gate_w + o; dst = ws_gw_t(p) + o; N = 64; K = 64; k0 = 0; n0 = 0; }
    int tx = tidx() & 63, ty = tidx() >> 6;
    __syncthreads();
    for (int i = 0; i < 16; ++i) { int k = ty + 4 * i; tile[k * 65 + tx] = src[(size_t)(k0 + k) * N + n0 + tx]; }
    __syncthreads();
    for (int i = 0; i < 16; ++i) { int n = ty + 4 * i; dst[(size_t)(n0 + n) * K + k0 + tx] = f2bf(tile[tx * 65 + n]); }
}

DEVI void ph_rownorm(const Params& p, int l, int item) {
    int w = tidx() >> 6, lane = tidx() & 63;
    int m = item * 4 + w;
    const float* x = xrow(p, l, m);
    const float* g = p.norm_g + l * DM;
    float4 v[4]; float ss = 0.f;
#pragma unroll
    for (int i = 0; i < 4; ++i) { v[i] = *(const float4*)(x + lane * 4 + 256 * i); ss += v[i].x * v[i].x + v[i].y * v[i].y + v[i].z * v[i].z + v[i].w * v[i].w; }
    ss = wave_sum(ss);
    if (lane < 16) ws_part(p)[(size_t)m * 16 + lane] = lane == 0 ? ss : 0.f;
#pragma unroll
    for (int i = 0; i < 4; ++i) {
        float4 gg = *(const float4*)(g + lane * 4 + 256 * i);
        uint2 o; o.x = pk2(v[i].x * gg.x, v[i].y * gg.y); o.y = pk2(v[i].z * gg.z, v[i].w * gg.w);
        *(uint2*)(ws_xb(p) + (size_t)m * DM + lane * 4 + 256 * i) = o;
    }
}

DEVI void ph_final(const Params& p, int item) {
    int w = tidx() >> 6, lane = tidx() & 63;
    int m = item * 4 + w;
    float* x = p.out + (size_t)m * DM;
    float4 v[4]; float ss = 0.f;
#pragma unroll
    for (int i = 0; i < 4; ++i) { v[i] = *(const float4*)(x + lane * 4 + 256 * i); ss += v[i].x * v[i].x + v[i].y * v[i].y + v[i].z * v[i].z + v[i].w * v[i].w; }
    ss = wave_sum(ss);
    float rs = rsqrtf(ss * (1.f / DM) + 1e-6f);
#pragma unroll
    for (int i = 0; i < 4; ++i) {
        float4 gg = *(const float4*)(p.final_g + lane * 4 + 256 * i);
        float4 o; o.x = v[i].x * rs * gg.x; o.y = v[i].y * rs * gg.y; o.z = v[i].z * rs * gg.z; o.w = v[i].w * rs * gg.w;
        *(float4*)(x + lane * 4 + 256 * i) = o;
    }
}

constexpr int GBM = 128, GBN = 128, GBK = 64, GLD = 72;
constexpr int GEMM_LDS = 2 * 2 * 128 * GLD * 2;
template <int EPI>
DEVI void ph_gemm_all(const Params& p, int l, int bid, int G, char* smem, bool dry = false) {
    constexpr int NT = EPI == 0 ? DIN / GBN : DM / GBN;
    constexpr int NTILES = (NTOK / GBM) * NT;
    if (bid >= NTILES) return;
#define G_COORDS(item_, r0_, c0_, pn_) { const int xcd_ = (item_) & 7, jx_ = (item_) >> 3; const int rg_ = jx_ / (8 * NT), wi_ = jx_ % (8 * NT); \
        pn_ = wi_ >> 3; r0_ = (xcd_ * 80 + rg_ * 8 + (wi_ & 7)) * GBM; c0_ = pn_ * GBN; }
    const bf16_t* A = EPI == 0 ? ws_xb(p) : ws_z(p);
    const int lda = EPI == 0 ? DM : DIN;
    const bf16_t* Bt = EPI == 0 ? ws_wt_in(p) + (size_t)l * DIN * DM : ws_wt_out(p) + (size_t)l * DM * DM;
    bf16_t* As = (bf16_t*)smem;
    bf16_t* Bs = As + 2 * 128 * GLD;
    const int tid = tidx(), wid = tid >> 6, lane = tid & 63, wr = wid >> 1, wc = wid & 1, fr = lane & 15, fq = lane >> 4;
    int item = bid, row0, col0, pn, nrow0 = 0, ncol0 = 0, npn = 0;
    G_COORDS(item, row0, col0, pn)
    bool hasn = item + G < NTILES;
    nrow0 = row0; ncol0 = col0; npn = pn;
    if (hasn) G_COORDS(item + G, nrow0, ncol0, npn)
    f32x4 acc[4][4];
#pragma unroll
    for (int m = 0; m < 4; ++m)
#pragma unroll
        for (int n = 0; n < 4; ++n) acc[m][n] = (f32x4){0.f, 0.f, 0.f, 0.f};
    u32x4 ra0[4], rb0[4], ra1[4], rb1[4];
    auto aoff = [&](int kt) __attribute__((always_inline)) -> int {
        if (EPI == 0) return kt * 64;
        const int blk = kt >> 2;
        const int bo = blk == 0 ? OFF_A : blk == 1 ? OFF_B : blk == 2 ? OFF_C : OFF_D;
        return bo + (kt & 3) * 64;
    };
    const int lr = tid >> 3, lch = (tid & 7) * 8;
    const unsigned va0 = (unsigned)(lr * lda + lch) * 2u, vb0 = (unsigned)(lr * DM + lch) * 2u;
    const unsigned vas = (unsigned)(32 * lda) * 2u, vbs = (unsigned)(32 * DM) * 2u;
#define G_LOAD1(ra, rb, i) ra[i] = *(const u32x4*)(ab_ + (va0 + (i) * vas)); rb[i] = *(const u32x4*)(bb_ + (vb0 + (i) * vbs));
#define G_LOAD(ra, rb, r0_, c0_, kt_) { const char* ab_ = (const char*)(A + (size_t)(r0_) * lda + aoff(kt_)); const char* bb_ = (const char*)(Bt + (size_t)(c0_) * DM + (kt_) * 64); \
        G_LOAD1(ra, rb, 0) G_LOAD1(ra, rb, 1) G_LOAD1(ra, rb, 2) G_LOAD1(ra, rb, 3) }
#define S_WRITE1(ra, rb, buf_, i) *(u32x4*)(As + ((buf_) * 128 + lr + 32 * (i)) * GLD + lch) = ra[i]; *(u32x4*)(Bs + ((buf_) * 128 + lr + 32 * (i)) * GLD + lch) = rb[i];
#define S_WRITE(ra, rb, buf_) { S_WRITE1(ra, rb, buf_, 0) S_WRITE1(ra, rb, buf_, 1) S_WRITE1(ra, rb, buf_, 2) S_WRITE1(ra, rb, buf_, 3) }
#define G_COMPUTE_W(buf_, ra, rb, wbuf_, dow_) { \
    bf16x8 af[2][4], bfr[2][4]; \
    _Pragma("unroll") for (int ks = 0; ks < 2; ++ks) { \
        _Pragma("unroll") for (int m = 0; m < 4; ++m) af[ks][m] = *(const bf16x8*)(As + ((buf_) * 128 + wr * 64 + m * 16 + fr) * GLD + ks * 32 + fq * 8); \
        _Pragma("unroll") for (int n = 0; n < 4; ++n) bfr[ks][n] = *(const bf16x8*)(Bs + ((buf_) * 128 + wc * 64 + n * 16 + fr) * GLD + ks * 32 + fq * 8); \
    } \
    if (dow_) S_WRITE(ra, rb, wbuf_) \
    __builtin_amdgcn_s_setprio(1); \
    _Pragma("unroll") for (int ks = 0; ks < 2; ++ks) \
        _Pragma("unroll") for (int m = 0; m < 4; ++m) \
            _Pragma("unroll") for (int n = 0; n < 4; ++n) acc[m][n] = __builtin_amdgcn_mfma_f32_16x16x32_bf16(bfr[ks][n], af[ks][m], acc[m][n], 0, 0, 0); \
    __builtin_amdgcn_s_setprio(0); }
    constexpr int NK = DM / GBK;
    __syncthreads();
    G_LOAD(ra0, rb0, row0, col0, 0) G_LOAD(ra1, rb1, row0, col0, 1)
    S_WRITE(ra0, rb0, 0)
    G_LOAD(ra0, rb0, row0, col0, 2)
    __syncthreads();
#pragma unroll 1
    for (;;) {
#pragma unroll 1
        for (int kt = 0; kt < NK; kt += 2) {
            G_COMPUTE_W(0, ra1, rb1, 1, true)
            __syncthreads();
            { const bool nx = kt + 3 >= NK; const int r_ = nx ? nrow0 : row0, c_ = nx ? ncol0 : col0, k_ = nx ? kt + 3 - NK : kt + 3; G_LOAD(ra1, rb1, r_, c_, k_) }
            G_COMPUTE_W(1, ra0, rb0, 0, true)
            __syncthreads();
            { const bool nx = kt + 4 >= NK; const int r_ = nx ? nrow0 : row0, c_ = nx ? ncol0 : col0, k_ = nx ? kt + 4 - NK : kt + 4; G_LOAD(ra0, rb0, r_, c_, k_) }
        }
    #pragma unroll
        for (int m = 0; m < 4; ++m) {
            const int row = row0 + wr * 64 + m * 16 + fr;
            float rs = 1.f, ssq = 0.f;
            if (EPI == 0) {
                const f32x4* pp = (const f32x4*)(ws_part(p) + (size_t)row * 16);
                const f32x4 q0 = pp[0], q1 = pp[1], q2 = pp[2], q3 = pp[3];
                const float sm = ((q0[0] + q0[1]) + (q0[2] + q0[3])) + ((q1[0] + q1[1]) + (q1[2] + q1[3])) + ((q2[0] + q2[1]) + (q2[2] + q2[3])) + ((q3[0] + q3[1]) + (q3[2] + q3[3]));
                rs = rsqrtf(sm * (1.f / DM) + 1e-6f);
            }
    #pragma unroll
            for (int n = 0; n < 4; ++n) {
                const int col = col0 + wc * 64 + n * 16 + fq * 4;
                if (dry) { if (acc[m][n][0] == 1.2345e30f) ws_ctr(p)[63] = 1; }
                else if (EPI == 0) {
                    uint2 o; o.x = pk2(acc[m][n][0] * rs, acc[m][n][1] * rs); o.y = pk2(acc[m][n][2] * rs, acc[m][n][3] * rs);
                    *(uint2*)(ws_z(p) + (size_t)row * DIN + col) = o;
                } else {
                    const float4 xr = *(const float4*)(xrow(p, l, row) + col);
                    float4 o; o.x = xr.x + acc[m][n][0]; o.y = xr.y + acc[m][n][1]; o.z = xr.z + acc[m][n][2]; o.w = xr.w + acc[m][n][3];
                    *(float4*)(p.out + (size_t)row * DM + col) = o;
                    ssq += (o.x * o.x + o.y * o.y) + (o.z * o.z + o.w * o.w);
                    if (l + 1 < NL) {
                        const float4 gg = *(const float4*)(p.norm_g + (l + 1) * DM + col);
                        uint2 ob; ob.x = pk2(o.x * gg.x, o.y * gg.y); ob.y = pk2(o.z * gg.z, o.w * gg.w);
                        *(uint2*)(ws_xb(p) + (size_t)row * DM + col) = ob;
                    }
                }
            }
            if (EPI == 1 && !dry) {
                ssq += __shfl_xor(ssq, 16); ssq += __shfl_xor(ssq, 32);
                if (fq == 0) ws_part(p)[(size_t)row * 16 + pn * 2 + wc] = ssq;
            }
        }
        if (!hasn) break;
#pragma unroll
        for (int m = 0; m < 4; ++m)
#pragma unroll
            for (int n = 0; n < 4; ++n) acc[m][n] = (f32x4){0.f, 0.f, 0.f, 0.f};
        item += G; row0 = nrow0; col0 = ncol0; pn = npn;
        hasn = item + G < NTILES;
        if (hasn) G_COORDS(item + G, nrow0, ncol0, npn)
    }
#undef G_LOAD
#undef S_WRITE
#undef G_LOAD1
#undef S_WRITE1
#undef G_COMPUTE_W
#undef G_COORDS
}

constexpr int XLD = 264, LLD = 72;
constexpr int PREP_LDS = 64 * XLD * 2 + 2 * 64 * LLD * 2;
DEVI float ropeT(float2 cs, float x, int d) {
    const int e = d & 31;
    const float pr = __shfl_xor(x, 16);
    return (e < 16) ? x * cs.x - pr * cs.y : pr * cs.y + x * cs.x;
}
DEVI void ph_prep(const Params& p, int l, int item, char* smem, bool dry = false) {
    bf16_t* xc_s = (bf16_t*)smem;
    bf16_t* wl_s = xc_s + 64 * XLD;
    bf16_t* al_s = wl_s + 64 * LLD;
    const int tid = tidx(), w = tid >> 6, lane = tid & 63, fr = lane & 15, fq = lane >> 4;
    const int b = item >> 6, t0 = (item & 63) * 32;
    const size_t mbase = (size_t)b * T_ + t0;
    bf16_t* zt = ws_z(p) + mbase * DIN;
    __syncthreads();
    {
        const float* sh = p.rwkv_shift + l * 2 * 896;
        float s0[4], s1[4], pv[4], cu[4];
#pragma unroll
        for (int s_ = 0; s_ < 4; ++s_) {
            const int c = tid + 256 * s_;
            const bool ok = c < 896;
            s0[s_] = ok ? sh[c] : 0.f; s1[s_] = ok ? sh[896 + c] : 0.f;
            pv[s_] = (ok && t0 > 0) ? bf2f(zt[c - DIN]) : 0.f;
            cu[s_] = ok ? bf2f(zt[c]) : 0.f;
        }
        const float kkw = p.rwkv_k_k[l * 256 + tid];
        float cw[4];
#pragma unroll
        for (int jj = 0; jj < 4; ++jj) cw[jj] = p.lru_conv_w[(l * 4 + jj) * 256 + tid];
        const float cb = p.lru_conv_b[l * 256 + tid];
        float xm2 = t0 >= 2 ? bf2f(zt[OFF_C + tid - 2 * DIN]) : 0.f, xm1 = t0 >= 1 ? bf2f(zt[OFF_C + tid - DIN]) : 0.f, x0 = bf2f(zt[OFF_C + tid]);
        const float qnw = p.attn_q_norm[l * 64 + lane], knw = p.attn_k_norm[l * 64 + lane];
        const bool c3 = tid < 128;
#pragma unroll 1
        for (int g8 = 0; g8 < 4; ++g8) {
            bf16_t nA[8][4], nC[8], qB[8], kB[8];
            float2 cs8[8];
#pragma unroll
            for (int i8 = 0; i8 < 8; ++i8) {
                const int tt = g8 * 8 + i8;
                const bf16_t* zr = zt + (size_t)tt * DIN;
                const bool hasn = t0 + tt + 1 < T_;
#pragma unroll
                for (int s_ = 0; s_ < 4; ++s_) nA[i8][s_] = (hasn && (s_ < 3 || c3)) ? zr[tid + 256 * s_ + DIN] : (bf16_t)0;
                nC[i8] = hasn ? zr[OFF_C + tid + DIN] : (bf16_t)0;
                qB[i8] = zr[OFF_B + tid];
                kB[i8] = c3 ? zr[OFF_B + 256 + tid] : (bf16_t)0;
                cs8[i8] = *(const float2*)(ws_rope(p) + 2 * (((lane >> 5) ? (t0 & 63) + tt : (t0 >> 6)) * 16 + (lane & 15)));
            }
#pragma unroll
            for (int i8 = 0; i8 < 8; ++i8) {
                const int tt = g8 * 8 + i8;
                const int t = t0 + tt;
                bf16_t* zr = zt + (size_t)tt * DIN;
                float xs[4];
#pragma unroll
                for (int s_ = 0; s_ < 4; ++s_) {
                    const float nx = bf2f(nA[i8][s_]);
                    xs[s_] = cu[s_] + s0[s_] * (pv[s_] - cu[s_]) + s1[s_] * (nx - cu[s_]);
                    pv[s_] = cu[s_]; cu[s_] = nx;
                }
                const size_t o = (mbase + tt) * 256 + tid;
                const float kkv = xs[1] * kkw;
                const float ss = wave_sum(kkv * kkv);
                ws_sR(p)[o] = f2bf(xs[0]); ws_sK(p)[o] = f2bf(xs[1]); ws_sV(p)[o] = f2bf(xs[2]); ws_sKK(p)[o] = f2bf(kkv * rsqrtf(fmaxf(ss, 1e-24f)));
                if (tid < 64) wl_s[tt * LLD + tid] = f2bf(1.f - 2.f / (1.f + __expf(2.f * xs[3])));
                else if (tid < 128) al_s[tt * LLD + tid - 64] = f2bf(xs[3]);
                const float xp1 = bf2f(nC[i8]);
                xc_s[tt * XLD + tid] = f2bf(cb + cw[0] * xm2 + cw[1] * xm1 + cw[2] * x0 + cw[3] * xp1);
                xm2 = xm1; xm1 = x0; x0 = xp1;
                const float q = bf2f(qB[i8]);
                const float s2 = wave_sum(q * q);
                const float qn = ropeT(cs8[i8], q * rsqrtf(s2 * (1.f / 64.f) + 1e-6f) * qnw, lane) * (0.125f * 1.4426950408889634f);
                if (!dry) zr[OFF_B + tid] = f2bf(qn);
                if (c3) {
                    const float kx = bf2f(kB[i8]);
                    const float s3 = wave_sum(kx * kx);
                    const float kro = ropeT(cs8[i8], kx * rsqrtf(s3 * (1.f / 64.f) + 1e-6f) * knw, lane);
                    if (!dry) zr[OFF_B + 256 + tid] = f2bf(kro);
                }
            }
        }
    }
    __syncthreads();
#pragma unroll 1
    for (int dm = 0; dm < 4; ++dm) {
        const int d = dm >> 1, mat = dm & 1;
        const bf16_t* Bt = (mat ? ws_aup_t(p) : ws_wup_t(p)) + ((size_t)(l * 2 + d) * 256 + 64 * w) * 64;
        bf16x8 bfr[4][2];
#pragma unroll
        for (int nt = 0; nt < 4; ++nt)
#pragma unroll
            for (int ks = 0; ks < 2; ++ks) bfr[nt][ks] = *(const bf16x8*)(Bt + (16 * nt + fr) * 64 + 32 * ks + 8 * fq);
        const bf16_t* As = mat ? al_s : wl_s;
        const float* bias = (mat ? p.rwkv_a0 : p.rwkv_w0) + (l * 2 + d) * 256 + 64 * w + 4 * fq;
        bf16_t* dst = (mat ? ws_sA0(p) : ws_sW0(p)) + d * SA_EL + mbase * 256 + 64 * w + 4 * fq;
#pragma unroll 1
        for (int m = 0; m < 2; ++m) {
            bf16x8 af[2];
#pragma unroll
            for (int ks = 0; ks < 2; ++ks) af[ks] = *(const bf16x8*)(As + (16 * m + fr) * LLD + 32 * ks + 8 * fq);
#pragma unroll
            for (int nt = 0; nt < 4; ++nt) {
                f32x4 acc = (f32x4){0.f, 0.f, 0.f, 0.f};
#pragma unroll
                for (int ks = 0; ks < 2; ++ks) acc = __builtin_amdgcn_mfma_f32_16x16x32_bf16(bfr[nt][ks], af[ks], acc, 0, 0, 0);
                const f32x4 bv = *(const f32x4*)(bias + 16 * nt);
                float ov[4];
#pragma unroll
                for (int jj = 0; jj < 4; ++jj) {
                    const float sg = sigm(acc[jj] + bv[jj]);
                    ov[jj] = mat ? sg : 1.f - __expf(-0.6065306597126334f * sg);
                }
                u32x2 o2; o2[0] = pk2(ov[0], ov[1]); o2[1] = pk2(ov[2], ov[3]);
                *(u32x2*)(dst + (size_t)(16 * m + fr) * 256 + 16 * nt) = o2;
            }
        }
    }
#pragma unroll 1
    for (int d = 0; d < 2; ++d) {
        bf16x8 bfr[2][4][2];
#pragma unroll
        for (int k = 0; k < 2; ++k)
#pragma unroll
            for (int nt = 0; nt < 4; ++nt)
#pragma unroll
                for (int ks = 0; ks < 2; ++ks)
                    bfr[k][nt][ks] = *(const bf16x8*)(ws_gw_t(p) + ((size_t)(((l * 2 + d) * 2 + k) * 4 + w) * 64 + 16 * nt + fr) * 64 + 32 * ks + 8 * fq);
        const int e00 = 64 * w + 4 * fq;
#pragma unroll 1
        for (int m = 0; m < 2; ++m) {
            bf16x8 af[2];
#pragma unroll
            for (int ks = 0; ks < 2; ++ks) af[ks] = *(const bf16x8*)(xc_s + (16 * m + fr) * XLD + 64 * w + 32 * ks + 8 * fq);
#pragma unroll
            for (int nt = 0; nt < 4; ++nt) {
                f32x4 g0 = (f32x4){0.f, 0.f, 0.f, 0.f}, g1 = g0;
#pragma unroll
                for (int ks = 0; ks < 2; ++ks) {
                    g0 = __builtin_amdgcn_mfma_f32_16x16x32_bf16(bfr[0][nt][ks], af[ks], g0, 0, 0, 0);
                    g1 = __builtin_amdgcn_mfma_f32_16x16x32_bf16(bfr[1][nt][ks], af[ks], g1, 0, 0, 0);
                }
                const int e0 = e00 + 16 * nt;
                const f32x4 gb0 = *(const f32x4*)(p.lru_gate_b + ((l * 2 + d) * 2 + 0) * 256 + e0), gb1 = *(const f32x4*)(p.lru_gate_b + ((l * 2 + d) * 2 + 1) * 256 + e0);
                const f32x4 lam = *(const f32x4*)(p.lru_lambda + (l * 2 + d) * 256 + e0);
                const u32x2 xu = *(const u32x2*)(xc_s + (16 * m + fr) * XLD + e0);
                const float xv[4] = {__uint_as_float(xu[0] << 16), __uint_as_float(xu[0] & 0xffff0000u), __uint_as_float(xu[1] << 16), __uint_as_float(xu[1] & 0xffff0000u)};
                float a1[4], bt[4];
#pragma unroll
                for (int jj = 0; jj < 4; ++jj) {
                    const float r = sigm(g0[jj] + gb0[jj]), ig = sigm(g1[jj] + gb1[jj]);
                    const float sp = __logf(1.f + __expf(-lam[jj]));
                    const float a = __expf(-8.f * r * sp);
                    a1[jj] = 1.f - a;
                    bt[jj] = sqrtf(a1[jj] * (1.f + a)) * ig * xv[jj];
                }
                const size_t o = d * SA_EL + (mbase + 16 * m + fr) * 256 + e0;
                u32x2 oa; oa[0] = pk2(a1[0], a1[1]); oa[1] = pk2(a1[2], a1[3]);
                u32x2 ob; ob[0] = pk2(bt[0], bt[1]); ob[1] = pk2(bt[2], bt[3]);
                *(u32x2*)(ws_la(p) + o) = oa; *(u32x2*)(ws_h0(p) + o) = ob;
            }
        }
    }
}

DEVI f2 fma2(f2 a, f2 b, f2 c) { return __builtin_elementwise_fma(a, b, c); }
DEVI void ph_rwkv_scan(const Params& p, int l, int item, char* smem, bool dry = false) {
    const int wv = __builtin_amdgcn_readfirstlane(tidx() >> 6), lane = tidx() & 63;
    const int wi = item * 4 + wv;
    const int scan = wi / 3, part = wi - scan * 3;
    const int b = scan >> 3, h = (scan >> 1) & 3, d = scan & 1;
    const int c8 = lane & 7, r8 = lane >> 3;
    float* ring = (float*)smem + wv * 1280;
    const char* A = (const char*)(ws_sA0(p) + d * SA_EL);
    const char* Wm = (const char*)(ws_sW0(p) + d * SA_EL);
    const char *R = (const char*)ws_sR(p), *K = (const char*)ws_sK(p), *V = (const char*)ws_sV(p), *KK = (const char*)ws_sKK(p);
    char* Y = (char*)(ws_z(p) + 256 + 256 * d + h * 64);
#define LDB(base, bo) (*(const bf16_t*)((base) + (bo)))
    const float ka = p.rwkv_k_a[l * 256 + h * 64 + lane];
    f2 S[3][4];
#pragma unroll
    for (int pp = 0; pp < 3; ++pp)
#pragma unroll
        for (int k = 0; k < 4; ++k) S[pp][k] = (f2){0.f, 0.f};
    const unsigned t00 = (unsigned)(b * T_ + (d ? T_ - 1 : 0)) * 256u + h * 64;
    const unsigned o0 = (t00 + lane) * 2u;
    int rowp[3]; unsigned ov[3];
#pragma unroll
    for (int pp = 0; pp < 3; ++pp) { rowp[pp] = 24 * part + 8 * pp + r8; ov[pp] = (t00 + (rowp[pp] < 64 ? rowp[pp] : 63)) * 2u; }
    const int stp = d ? -512 : 512;
    const int myp = c8 < 3 ? c8 : 0;
    const int myrow = 24 * part + 8 * myp + r8;
    const bool ystore = c8 < 3 && myrow < 64 && !dry;
    const unsigned yrow_b = (unsigned)myrow * 2u;
    float vcur[3], vnx[3];
#pragma unroll
    for (int s_ = 0; s_ < 2; ++s_) {
        const unsigned o = o0 + s_ * stp;
        const float r = bf2f(LDB(R, o)), k = bf2f(LDB(K, o)), kk = bf2f(LDB(KK, o)), a = bf2f(LDB(A, o)), w = 1.f - bf2f(LDB(Wm, o));
#pragma unroll
        for (int pp = 0; pp < 3; ++pp) { const float vv = bf2f(LDB(V, ov[pp] + s_ * stp)); if (s_ == 0) vcur[pp] = vv; else vnx[pp] = vv; }
        float* sl = ring + s_ * 320;
        sl[0 * 64 + lane] = w; sl[1 * 64 + lane] = kk * a; sl[2 * 64 + lane] = k * (1.f + (a - 1.f) * ka); sl[3 * 64 + lane] = r; sl[4 * 64 + lane] = kk;
    }
    bf16_t rr[8], rk[8], rkk[8], ra[8], rw[8], rv[8][3];
#pragma unroll
    for (int i = 0; i < 8; ++i) {
        const int st = (i < 2 ? 8 + i : i) * stp;
        rr[i] = LDB(R, o0 + st); rk[i] = LDB(K, o0 + st); rkk[i] = LDB(KK, o0 + st); ra[i] = LDB(A, o0 + st); rw[i] = LDB(Wm, o0 + st);
#pragma unroll
        for (int pp = 0; pp < 3; ++pp) rv[i][pp] = LDB(V, ov[pp] + st);
    }
    __builtin_amdgcn_wave_barrier();
    f32x4 OB[2][5][2];
#define RW_LDO(set, slw, slk) { _Pragma("unroll") for (int g = 0; g < 2; ++g) { \
        OB[set][0][g] = *(const f32x4*)((slw) + 0 * 64 + 8 * c8 + 4 * g); OB[set][1][g] = *(const f32x4*)((slw) + 1 * 64 + 8 * c8 + 4 * g); \
        OB[set][2][g] = *(const f32x4*)((slw) + 2 * 64 + 8 * c8 + 4 * g); OB[set][3][g] = *(const f32x4*)((slw) + 3 * 64 + 8 * c8 + 4 * g); \
        OB[set][4][g] = *(const f32x4*)((slk) + 4 * 64 + 8 * c8 + 4 * g); } }
    RW_LDO(0, ring, ring + 320)
    float sktot[3] = {0.f, 0.f, 0.f};
    __builtin_amdgcn_s_setprio(3);
    for (int sb = 0; sb < T_; sb += 8) {
#pragma unroll
        for (int i = 0; i < 8; ++i) {
            const int step = sb + i;
            const int slot = (i + 2) & 7;
            float v2n[3];
            {
                float* sn = ring + ((i + 2) & 3) * 320;
                const float r1 = bf2f(rr[slot]), k1 = bf2f(rk[slot]), kk1 = bf2f(rkk[slot]), a1 = bf2f(ra[slot]), w1 = 1.f - bf2f(rw[slot]);
                sn[0 * 64 + lane] = w1; sn[1 * 64 + lane] = kk1 * a1; sn[2 * 64 + lane] = k1 * (1.f + (a1 - 1.f) * ka); sn[3 * 64 + lane] = r1; sn[4 * 64 + lane] = kk1;
#pragma unroll
                for (int pp = 0; pp < 3; ++pp) v2n[pp] = bf2f(rv[slot][pp]);
            }
            {
                const int s10 = (step + 10 < T_ ? step + 10 : T_ - 1) * stp;
                const unsigned oc = o0 + s10;
                rr[slot] = LDB(R, oc); rk[slot] = LDB(K, oc); rkk[slot] = LDB(KK, oc); ra[slot] = LDB(A, oc); rw[slot] = LDB(Wm, oc);
#pragma unroll
                for (int pp = 0; pp < 3; ++pp) rv[slot][pp] = LDB(V, ov[pp] + s10);
            }
            __builtin_amdgcn_wave_barrier();
            RW_LDO((i + 1) & 1, ring + ((i + 1) & 3) * 320, ring + ((i + 2) & 3) * 320)
            const unsigned tok_b = (unsigned)(b * T_ + (d ? T_ - 1 - step : step)) * (unsigned)(DIN * 2);
            float pyv[3];
#pragma unroll
            for (int pp = 0; pp < 3; ++pp) {
                const f2 nsk2 = (f2){-sktot[pp], -sktot[pp]}, v2 = (f2){vcur[pp], vcur[pp]};
                f2 y2 = (f2){0.f, 0.f}, sk2 = (f2){0.f, 0.f};
#pragma unroll
                for (int g = 0; g < 2; ++g) {
                    const f32x4 w4 = OB[i & 1][0][g], b4 = OB[i & 1][1][g], kd4 = OB[i & 1][2][g], r4 = OB[i & 1][3][g], kn4 = OB[i & 1][4][g];
                    f2 t0 = v2 * kd4.xy; t0 = fma2(nsk2, b4.xy, t0);
                    S[pp][2 * g] = fma2(S[pp][2 * g], w4.xy, t0);
                    y2 = fma2(S[pp][2 * g], r4.xy, y2); sk2 = fma2(S[pp][2 * g], kn4.xy, sk2);
                    f2 t1 = v2 * kd4.zw; t1 = fma2(nsk2, b4.zw, t1);
                    S[pp][2 * g + 1] = fma2(S[pp][2 * g + 1], w4.zw, t1);
                    y2 = fma2(S[pp][2 * g + 1], r4.zw, y2); sk2 = fma2(S[pp][2 * g + 1], kn4.zw, sk2);
                }
                float ps = sk2.x + sk2.y, py = y2.x + y2.y;
                ps += dppx<0xB1>(ps); py += dppx<0xB1>(py);
                ps += dppx<0x4E>(ps); py += dppx<0x4E>(py);
                ps += dppx<0x141>(ps); py += dppx<0x141>(py);
                sktot[pp] = ps; pyv[pp] = py;
                vcur[pp] = vnx[pp]; vnx[pp] = v2n[pp];
            }
            {
                const float ysel = c8 == 0 ? pyv[0] : c8 == 1 ? pyv[1] : pyv[2];
                if (ystore) *(bf16_t*)(Y + (tok_b + yrow_b)) = f2bf(ysel);
            }
        }
    }
    __builtin_amdgcn_s_setprio(0);
#undef RW_LDO
#undef LDB
}

DEVI void ph_lru_scan(const Params& p, int l, int item, bool dry = false) {
    const int lane = tidx() & 63, idx = item * 4 + (tidx() >> 6);
    const int b = idx >> 3, n = (idx >> 1) & 3, d = idx & 1;
    const bf16_t* A = ws_la(p) + d * SA_EL + (size_t)b * T_ * 256 + n * 64 + lane;
    bf16_t* H = ws_h0(p) + d * SA_EL + (size_t)b * T_ * 256 + n * 64 + lane;
    float h = 0.f;
    for (int s0 = 0; s0 < T_; s0 += 32) {
        bf16_t av[32], bv[32];
#pragma unroll
        for (int i = 0; i < 32; ++i) { const int t = d ? T_ - 1 - (s0 + i) : s0 + i; av[i] = A[(size_t)t * 256]; bv[i] = H[(size_t)t * 256]; }
#pragma unroll
        for (int i = 0; i < 32; ++i) {
            const int t = d ? T_ - 1 - (s0 + i) : s0 + i;
            h = (1.f - bf2f(av[i])) * h + bf2f(bv[i]);
            if (!dry) H[(size_t)t * 256] = f2bf(h);
        }
    }
}

DEVI void ph_post(const Params& p, int l, int item) {
    const int j = tidx();
    const float lg = p.rwkv_ln_g[l * 256 + j], lb = p.rwkv_ln_b[l * 256 + j], ka = p.rwkv_k_a[l * 256 + j], rk_ = p.rwkv_r_k[l * 256 + j];
    bf16_t yf[8], yr[8], r_[8], k_[8], v_[8], af[8], ar[8], ga[8], hf[8], hr[8], gc[8];
#pragma unroll
    for (int i = 0; i < 8; ++i) {
        const int m = item * 8 + i;
        const size_t o = (size_t)m * 256 + j;
        const bf16_t* zr = ws_z(p) + (size_t)m * DIN;
        yf[i] = zr[256 + j]; yr[i] = zr[512 + j]; r_[i] = ws_sR(p)[o]; k_[i] = ws_sK(p)[o]; v_[i] = ws_sV(p)[o];
        af[i] = ws_sA0(p)[o]; ar[i] = ws_sA0(p)[o + SA_EL]; ga[i] = zr[OFF_A + 896 + j];
        hf[i] = ws_h0(p)[o]; hr[i] = ws_h0(p)[o + SA_EL]; gc[i] = zr[OFF_C + 256 + j];
    }
#pragma unroll
    for (int i = 0; i < 8; ++i) {
        const int m = item * 8 + i;
        bf16_t* zr = ws_z(p) + (size_t)m * DIN;
        const float y = bf2f(yf[i]) + bf2f(yr[i]);
        const float mu = wave_sum(y) * (1.f / 64.f);
        const float dv = y - mu;
        const float var = wave_sum(dv * dv) * (1.f / 64.f);
        const float yn = dv * rsqrtf(var + 64e-5f) * lg + lb;
        const float r = bf2f(r_[i]), k = bf2f(k_[i]), v = bf2f(v_[i]), a_f = bf2f(af[i]), a_r = bf2f(ar[i]);
        const float ksum = k * (1.f + (a_f - 1.f) * ka) + k * (1.f + (a_r - 1.f) * ka);
        const float bon = wave_sum(r * ksum * rk_) * v;
        const float g = bf2f(ga[i]);
        zr[OFF_A + j] = f2bf((yn + bon) * g * sigm(g));
        const float h = bf2f(hf[i]) + bf2f(hr[i]);
        const float g2 = bf2f(gc[i]);
        zr[OFF_C + j] = f2bf(h * g2 * sigm(g2));
    }
}

template <int WIN>
DEVI void ph_attn_naive(const Params& p, int l, int item) {
    const int lane = tidx() & 63, idx = item * 4 + (tidx() >> 6);
    const int qb = idx & 31, hq = (idx >> 5) & 3, b = idx >> 7;
    const int g = hq >> 1;
    constexpr int OFF = WIN ? OFF_D : OFF_B;
    const int t0 = qb * 64, t = t0 + lane;
    bf16_t* zq = ws_z(p) + ((size_t)b * T_ + t) * DIN + OFF + hq * 64;
    float q[64], o[64];
#pragma unroll
    for (int c = 0; c < 8; ++c) {
        const uint4 u = *(const uint4*)(zq + c * 8);
        const unsigned uu[4] = {u.x, u.y, u.z, u.w};
#pragma unroll
        for (int e = 0; e < 4; ++e) { q[c * 8 + 2 * e] = __uint_as_float(uu[e] << 16); q[c * 8 + 2 * e + 1] = __uint_as_float(uu[e] & 0xffff0000u); }
    }
#pragma unroll
    for (int dd = 0; dd < 64; ++dd) o[dd] = 0.f;
    float mx, ls;
    float slope = 0.f;
    if (WIN) { mx = p.swa_sink[l * 4 + hq]; ls = 1.f; slope = exp2f(-8.f * (float)(hq + 1) / 4.f); }
    else { mx = -1e30f; ls = 0.f; }
    const int s0 = WIN ? max(0, t0 - 128) : 0, s1 = WIN ? min(T_ - 1, t0 + 63 + 128) : T_ - 1;
    const bf16_t* kb = ws_z(p) + (size_t)b * T_ * DIN + OFF + 256 + g * 64;
    for (int s = s0; s <= s1; ++s) {
        const bf16_t* kr = kb + (size_t)s * DIN;
        float sc = 0.f;
#pragma unroll
        for (int c = 0; c < 8; ++c) {
            const uint4 u = *(const uint4*)(kr + c * 8);
            const unsigned uu[4] = {u.x, u.y, u.z, u.w};
#pragma unroll
            for (int e = 0; e < 4; ++e) { sc += q[c * 8 + 2 * e] * __uint_as_float(uu[e] << 16); sc += q[c * 8 + 2 * e + 1] * __uint_as_float(uu[e] & 0xffff0000u); }
        }
        bool valid = true;
        if (WIN) { const int dist = abs(t - s); valid = dist <= 128; sc = sc * 0.125f - slope * (float)dist; }
        const float mn = valid ? fmaxf(mx, sc) : mx;
        const float al = __expf(mx - mn);
        const float pp = valid ? __expf(sc - mn) : 0.f;
        mx = mn; ls = ls * al + pp;
#pragma unroll
        for (int c = 0; c < 8; ++c) {
            const uint4 u = *(const uint4*)(kr + 128 + c * 8);
            const unsigned uu[4] = {u.x, u.y, u.z, u.w};
#pragma unroll
            for (int e = 0; e < 4; ++e) {
                o[c * 8 + 2 * e] = o[c * 8 + 2 * e] * al + pp * __uint_as_float(uu[e] << 16);
                o[c * 8 + 2 * e + 1] = o[c * 8 + 2 * e + 1] * al + pp * __uint_as_float(uu[e] & 0xffff0000u);
            }
        }
    }
    const float il = 1.f / ls;
    const bf16_t* zg = zq - hq * 64 + 512 + hq * 64;
#pragma unroll
    for (int c = 0; c < 8; ++c) {
        const uint4 u = *(const uint4*)(zg + c * 8);
        const unsigned uu[4] = {u.x, u.y, u.z, u.w};
        unsigned ov[4];
#pragma unroll
        for (int e = 0; e < 4; ++e) {
            const float g0 = __uint_as_float(uu[e] << 16), g1 = __uint_as_float(uu[e] & 0xffff0000u);
            ov[e] = pk2(o[c * 8 + 2 * e] * il * g0 * sigm(g0), o[c * 8 + 2 * e + 1] * il * g1 * sigm(g1));
        }
        *(uint4*)(zq + c * 8) = make_uint4(ov[0], ov[1], ov[2], ov[3]);
    }
}

constexpr int ALD = 72;
template <int WIN>
DEVI void ph_attn(const Params& p, int l, int item, char* smem, bool dry = false) {
    constexpr int OFF = WIN ? OFF_D : OFF_B;
    const int qb = item & 15, hq = (item >> 4) & 3, b = item >> 6, g = hq >> 1;
    const int tid = tidx(), w = tid >> 6, lane = tid & 63, fr = lane & 15, fq = lane >> 4;
    const int t0 = qb * 128, tw = t0 + 32 * w;
    bf16_t* Ks = (bf16_t*)smem;
    bf16_t* Vt = Ks + 2 * 64 * ALD;
    bf16_t* zb = ws_z(p) + (size_t)b * T_ * DIN;
    bf16x8 qf[2][2];
#pragma unroll
    for (int n = 0; n < 2; ++n)
#pragma unroll
        for (int ks = 0; ks < 2; ++ks) {
            u32x4 u = *(const u32x4*)(zb + (size_t)(tw + 16 * n + fr) * DIN + OFF + hq * 64 + 32 * ks + 8 * fq);
            if (WIN) {
                constexpr float sc = 0.125f * 1.4426950408889634f;
#pragma unroll
                for (int e = 0; e < 4; ++e) u[e] = pk2(__uint_as_float(u[e] << 16) * sc, __uint_as_float(u[e] & 0xffff0000u) * sc);
            }
            qf[n][ks] = __builtin_bit_cast(bf16x8, u);
        }
    const int kt0 = WIN ? max(0, t0 - 128) / 64 : 0, kt1 = WIN ? min(T_, t0 + 256) / 64 : T_ / 64;
    f32x4 ot[4][2];
#pragma unroll
    for (int dm = 0; dm < 4; ++dm)
#pragma unroll
        for (int n = 0; n < 2; ++n) ot[dm][n] = (f32x4){0.f, 0.f, 0.f, 0.f};
    float mrun[2], lrun[2];
    float slope2 = 0.f;
    if (WIN) {
        const float sk = p.swa_sink[l * 4 + hq] * 1.4426950408889634f;
        mrun[0] = mrun[1] = sk; lrun[0] = lrun[1] = fq == 0 ? 1.f : 0.f;
        slope2 = exp2f(-2.f * (float)(hq + 1)) * 1.4426950408889634f;
    } else { mrun[0] = mrun[1] = -1e30f; lrun[0] = lrun[1] = 0.f; }
    const bf16_t* kbase = zb + OFF + 256 + g * 64;
    const bf16_t* vbase = zb + OFF + 384 + g * 64;
    u32x4 rk[2], rv[2];
    const int kkey = tid >> 2, kc = tid & 3, vkey = tid & 63, vc = tid >> 6;
    auto gload = [&](int kt) __attribute__((always_inline)) {
        const bf16_t* kp = kbase + (size_t)(kt * 64 + kkey) * DIN + kc * 16;
        rk[0] = *(const u32x4*)kp; rk[1] = *(const u32x4*)(kp + 8);
        const bf16_t* vp = vbase + (size_t)(kt * 64 + vkey) * DIN + vc * 16;
        rv[0] = *(const u32x4*)vp; rv[1] = *(const u32x4*)(vp + 8);
    };
    auto swrite = [&](int buf) __attribute__((always_inline)) {
        bf16_t* kd = Ks + (buf * 64 + kkey) * ALD + kc * 16;
        *(u32x4*)kd = rk[0]; *(u32x4*)(kd + 8) = rk[1];
        bf16_t* vd = Vt + (buf * 64 + vc * 16) * ALD + vkey;
#pragma unroll
        for (int h = 0; h < 2; ++h)
#pragma unroll
            for (int e = 0; e < 4; ++e) {
                vd[(h * 8 + 2 * e) * ALD] = (bf16_t)(rv[h][e] & 0xffffu);
                vd[(h * 8 + 2 * e + 1) * ALD] = (bf16_t)(rv[h][e] >> 16);
            }
    };
    __syncthreads();
    gload(kt0); swrite(0);
    __syncthreads();
    for (int kt = kt0; kt < kt1; ++kt) {
        const int buf = (kt - kt0) & 1;
        if (kt + 1 < kt1) gload(kt + 1);
        f32x4 st[4][2];
#pragma unroll
        for (int m = 0; m < 4; ++m)
#pragma unroll
            for (int n = 0; n < 2; ++n) st[m][n] = (f32x4){0.f, 0.f, 0.f, 0.f};
#pragma unroll
        for (int ks = 0; ks < 2; ++ks)
#pragma unroll
            for (int m = 0; m < 4; ++m) {
                const bf16x8 kf = *(const bf16x8*)(Ks + (buf * 64 + 16 * m + fr) * ALD + 32 * ks + 8 * fq);
#pragma unroll
                for (int n = 0; n < 2; ++n) st[m][n] = __builtin_amdgcn_mfma_f32_16x16x32_bf16(kf, qf[n][ks], st[m][n], 0, 0, 0);
            }
        if (WIN) {
#pragma unroll
            for (int m = 0; m < 4; ++m)
#pragma unroll
                for (int n = 0; n < 2; ++n)
#pragma unroll
                    for (int j = 0; j < 4; ++j) {
                        const int dist = abs((tw + 16 * n + fr) - (kt * 64 + 16 * m + 4 * fq + j));
                        st[m][n][j] = dist <= 128 ? st[m][n][j] - slope2 * (float)dist : -1e30f;
                    }
        }
#pragma unroll
        for (int n = 0; n < 2; ++n) {
            float mt = st[0][n][0];
#pragma unroll
            for (int m = 0; m < 4; ++m)
#pragma unroll
                for (int j = 0; j < 4; ++j) mt = fmaxf(mt, st[m][n][j]);
            mt = fmaxf(mt, __shfl_xor(mt, 16)); mt = fmaxf(mt, __shfl_xor(mt, 32));
            const float mn = fmaxf(mrun[n], mt);
            const float alpha = __builtin_amdgcn_exp2f(mrun[n] - mn);
            mrun[n] = mn;
            float lsum = 0.f;
#pragma unroll
            for (int m = 0; m < 4; ++m)
#pragma unroll
                for (int j = 0; j < 4; ++j) { const float pv = __builtin_amdgcn_exp2f(st[m][n][j] - mn); lsum += pv; st[m][n][j] = pv; }
            lrun[n] = lrun[n] * alpha + lsum;
#pragma unroll
            for (int dm = 0; dm < 4; ++dm) ot[dm][n] = ot[dm][n] * alpha;
        }
#pragma unroll
        for (int kk = 0; kk < 2; ++kk) {
            bf16x8 pf[2];
#pragma unroll
            for (int n = 0; n < 2; ++n) {
                u32x4 u;
                u[0] = pk2(st[2 * kk][n][0], st[2 * kk][n][1]); u[1] = pk2(st[2 * kk][n][2], st[2 * kk][n][3]);
                u[2] = pk2(st[2 * kk + 1][n][0], st[2 * kk + 1][n][1]); u[3] = pk2(st[2 * kk + 1][n][2], st[2 * kk + 1][n][3]);
                pf[n] = __builtin_bit_cast(bf16x8, u);
            }
#pragma unroll
            for (int dm = 0; dm < 4; ++dm) {
                const bf16_t* vp = Vt + (buf * 64 + 16 * dm + fr) * ALD + 32 * kk + 4 * fq;
                const u32x2 v0 = *(const u32x2*)vp, v1 = *(const u32x2*)(vp + 16);
                const bf16x8 vf = __builtin_bit_cast(bf16x8, (u32x4){v0[0], v0[1], v1[0], v1[1]});
#pragma unroll
                for (int n = 0; n < 2; ++n) ot[dm][n] = __builtin_amdgcn_mfma_f32_16x16x32_bf16(vf, pf[n], ot[dm][n], 0, 0, 0);
            }
        }
        if (kt + 1 < kt1) swrite(buf ^ 1);
        __syncthreads();
    }
#pragma unroll
    for (int n = 0; n < 2; ++n) {
        float lt = lrun[n];
        lt += __shfl_xor(lt, 16); lt += __shfl_xor(lt, 32);
        const float il = 1.f / lt;
        bf16_t* zr = zb + (size_t)(tw + 16 * n + fr) * DIN + OFF + hq * 64 + 4 * fq;
#pragma unroll
        for (int dm = 0; dm < 4; ++dm) {
            const u32x2 gu = *(const u32x2*)(zr + 512 + 16 * dm);
            float gv[4] = {__uint_as_float(gu[0] << 16), __uint_as_float(gu[0] & 0xffff0000u), __uint_as_float(gu[1] << 16), __uint_as_float(gu[1] & 0xffff0000u)};
            float ov[4];
#pragma unroll
            for (int j = 0; j < 4; ++j) ov[j] = ot[dm][n][j] * il * gv[j] * sigm(gv[j]);
            u32x2 o2; o2[0] = pk2(ov[0], ov[1]); o2[1] = pk2(ov[2], ov[3]);
            if (!dry) *(u32x2*)(zr + 16 * dm) = o2;
        }
    }
}

DEVI void gbar(unsigned* ctr, unsigned target) {
    asm volatile("s_waitcnt vmcnt(0)" ::: "memory");
    __syncthreads();
    if (threadIdx.x == 0) {
        __builtin_amdgcn_fence(__ATOMIC_RELEASE, "agent");
        asm volatile("s_waitcnt vmcnt(0)" ::: "memory");
        (void)__hip_atomic_fetch_add(ctr, 1u, __ATOMIC_RELAXED, __HIP_MEMORY_SCOPE_AGENT);
        while (__hip_atomic_load(ctr, __ATOMIC_RELAXED, __HIP_MEMORY_SCOPE_AGENT) < target) __builtin_amdgcn_s_sleep(1);
        __builtin_amdgcn_fence(__ATOMIC_ACQUIRE, "agent");
        asm volatile("s_waitcnt vmcnt(0)" ::: "memory");
    }
    __syncthreads();
}

enum { PH_CONVW, PH_ROWNORM, PH_GEMM1, PH_PREP, PH_RWKV, PH_LRU, PH_ATTNB, PH_ATTND, PH_POST, PH_GEMM2, PH_FINAL };
#ifndef MK_MULTI
#define MK_MULTI 0
#endif
#ifndef PROBE_PREP
#define PROBE_PREP 0
#endif
#ifndef PROBE_MIX
#define PROBE_MIX 0
#endif
#ifndef PROBE_G2
#define PROBE_G2 0
#endif
#if MK_MULTI
template <int PH>
__global__ void __launch_bounds__(256) kph(Params p, int l, int nitems) {
    extern __shared__ __attribute__((aligned(16))) char smem[];
    for (int item = blockIdx.x; item < nitems; item += gridDim.x) {
        if (PH == PH_CONVW) ph_convw(p, item, smem);
        if (PH == PH_ROWNORM) ph_rownorm(p, l, item);
        if (PH == PH_GEMM1) { if (item == (int)blockIdx.x) ph_gemm_all<0>(p, l, blockIdx.x, gridDim.x, smem); }
        if (PH == PH_PREP) ph_prep(p, l, item, smem);
        if (PH == PH_RWKV) ph_rwkv_scan(p, l, item, smem);
        if (PH == PH_LRU) ph_lru_scan(p, l, item);
        if (PH == PH_ATTNB) ph_attn_naive<0>(p, l, item);
        if (PH == PH_ATTND) ph_attn_naive<1>(p, l, item);
        if (PH == PH_POST) ph_post(p, l, item);
        if (PH == PH_GEMM2) { if (item == (int)blockIdx.x) ph_gemm_all<1>(p, l, blockIdx.x, gridDim.x, smem); }
        if (PH == PH_FINAL) ph_final(p, item);
    }
}
template <int PH>
static void launch(const Params& p, int l, int nitems, int lds, hipStream_t stream) {
    if (lds > 48 * 1024) (void)hipFuncSetAttribute((const void*)kph<PH>, hipFuncAttributeMaxDynamicSharedMemorySize, lds);
    int grid = nitems < 65536 ? nitems : 65536;
    hipLaunchKernelGGL(kph<PH>, dim3(grid), dim3(256), lds, stream, p, l, nitems);
}
#else
constexpr int MIX_ITEMS = 80 + 2560 + 2560;
__global__ void __launch_bounds__(256, 2) mega(Params p) {
    extern __shared__ __attribute__((aligned(16))) char smem[];
    __shared__ int s_item;
    cg::grid_group grid = cg::this_grid();
    const int G = gridDim.x, bid = blockIdx.x;
    unsigned nbar = 0;
    if (bid == 0 && threadIdx.x < 64) ws_ctr(p)[threadIdx.x] = 0;
    for (int it = bid; it < CW_ITEMS; it += G) ph_convw(p, it, smem);
    grid.sync();
    for (int l = 0; l < NL; ++l) {
        if (l == 0) {
            for (int it = bid; it < NTOK / 4; it += G) ph_rownorm(p, l, it);
            gbar(ws_gbar(p), (nbar += (unsigned)G));
        }
        ph_gemm_all<0>(p, l, bid, G, smem);
        gbar(ws_gbar(p), (nbar += (unsigned)G));
#if PROBE_PREP
        for (int it = bid; it < NTOK / 32; it += G) ph_prep(p, l, it, smem, true);
#endif
        for (int it = bid; it < NTOK / 32; it += G) ph_prep(p, l, it, smem);
        gbar(ws_gbar(p), (nbar += (unsigned)G));
#if PROBE_MIX
        for (int rep = 0; rep < 2; ++rep) {
        const bool dry = rep == 0;
        int* ctrp = &ws_ctr(p)[l + 4 * rep];
#else
        {
        const bool dry = false;
        int* ctrp = &ws_ctr(p)[l];
#endif
        for (int it = bid; it < 240; it += G) ph_rwkv_scan(p, l, it, smem, dry);
        for (;;) {
            __syncthreads();
            if (threadIdx.x == 0) s_item = atomicAdd(ctrp, 1);
            __syncthreads();
            const int it = s_item;
            if (it >= MIX_ITEMS) break;
            if (it < 80) ph_lru_scan(p, l, it, dry);
            else if (it < 2640) ph_attn<0>(p, l, it - 80, smem, dry);
            else ph_attn<1>(p, l, it - 2640, smem, dry);
        }
        }
        gbar(ws_gbar(p), (nbar += (unsigned)G));
        for (int it = bid; it < NTOK / 8; it += G) ph_post(p, l, it);
        gbar(ws_gbar(p), (nbar += (unsigned)G));
#if PROBE_G2
        ph_gemm_all<1>(p, l, bid, G, smem, true);
#endif
        ph_gemm_all<1>(p, l, bid, G, smem);
        gbar(ws_gbar(p), (nbar += (unsigned)G));
    }
    for (int it = bid; it < NTOK / 4; it += G) ph_final(p, it);
}
#endif

extern "C" void kernel_launch(void* const* d_in, const int* in_sizes, int n_in, void* d_out, int out_size, void* d_ws, size_t ws_size,
                              hipStream_t stream) {
    Params p{};
    const float* const* in = (const float* const*)d_in;
    p.x_prompt = in[0]; p.x_sample = in[1]; p.norm_g = in[2]; p.w_in = in[3]; p.w_out = in[4]; p.rwkv_shift = in[5]; p.rwkv_w0 = in[6];
    p.rwkv_w_up = in[7]; p.rwkv_a0 = in[8]; p.rwkv_a_up = in[9]; p.rwkv_k_k = in[10]; p.rwkv_k_a = in[11]; p.rwkv_r_k = in[12];
    p.rwkv_ln_g = in[13]; p.rwkv_ln_b = in[14]; p.attn_q_norm = in[15]; p.attn_k_norm = in[16]; p.lru_conv_w = in[17]; p.lru_conv_b = in[18];
    p.lru_gate_w = in[19]; p.lru_gate_b = in[20]; p.lru_lambda = in[21]; p.swa_sink = in[22]; p.final_g = in[23];
    p.out = (float*)d_out;
    p.ws = (char*)d_ws;
    if (WS_NEED > ws_size) { fprintf(stderr, "workspace too small: need %zu have %zu\n", (size_t)WS_NEED, ws_size); }

#if MK_MULTI
    launch<PH_CONVW>(p, 0, CW_ITEMS, 64 * 65 * 4, stream);
    for (int l = 0; l < NL; ++l) {
        if (l == 0) launch<PH_ROWNORM>(p, l, NTOK / 4, 0, stream);
        launch<PH_GEMM1>(p, l, (NTOK / GBM) * (DIN / GBN), GEMM_LDS, stream);
        launch<PH_PREP>(p, l, NTOK / 32, PREP_LDS, stream);
        launch<PH_RWKV>(p, l, 240, 4 * 5120, stream);
        launch<PH_LRU>(p, l, 80, 0, stream);
        launch<PH_ATTNB>(p, l, 1280, 0, stream);
        launch<PH_ATTND>(p, l, 1280, 0, stream);
        launch<PH_POST>(p, l, NTOK / 8, 0, stream);
        launch<PH_GEMM2>(p, l, (NTOK / GBM) * (DM / GBN), GEMM_LDS, stream);
    }
    launch<PH_FINAL>(p, 0, NTOK / 4, 0, stream);
#else
    constexpr size_t kDynLds = GEMM_LDS;
    static int grid_blocks = 0;
    if (!grid_blocks) {
        (void)hipFuncSetAttribute((const void*)mega, hipFuncAttributeMaxDynamicSharedMemorySize, (int)kDynLds);
        int dev = 0, cus = 0, per_cu = 0;
        (void)hipGetDevice(&dev);
        (void)hipDeviceGetAttribute(&cus, hipDeviceAttributeMultiprocessorCount, dev);
        (void)hipOccupancyMaxActiveBlocksPerMultiprocessor(&per_cu, mega, 256, kDynLds);
        if (per_cu < 1) per_cu = 1;
        grid_blocks = cus * per_cu;
    }
    (void)hipMemsetAsync((char*)d_ws + WO_GBAR, 0, 256, stream);
    void* args[] = {&p};
    hipError_t e = hipLaunchCooperativeKernel((void*)mega, dim3(grid_blocks), dim3(256), args, kDynLds, stream);
    if (e != hipSuccess) fprintf(stderr, "cooperative launch failed: %s (grid %d)\n", hipGetErrorString(e), grid_blocks);
#endif
}
```

```cpp
#include <hip/hip_runtime.h>
#include <hip/hip_cooperative_groups.h>
#include <cstdio>
#include <cstdint>
namespace cg = cooperative_groups;

#define DEVI __device__ __forceinline__
typedef unsigned short bf16_t;
typedef short bf16x8 __attribute__((ext_vector_type(8)));
typedef float f32x4 __attribute__((ext_vector_type(4)));

constexpr int T_ = 2048, NB_ = 40, NTOK = NB_ * T_, DM = 1024, DIN = 3200, NL = 4;
constexpr int NPROMPT = 32 * T_;
constexpr size_t SA_EL = (size_t)NTOK * 256;
constexpr int OFF_A = 0, OFF_B = 1152, OFF_C = 1920, OFF_D = 2432;

struct Params {
    const float *x_prompt, *x_sample, *norm_g, *w_in, *w_out, *rwkv_shift, *rwkv_w0, *rwkv_w_up, *rwkv_a0, *rwkv_a_up,
        *rwkv_k_k, *rwkv_k_a, *rwkv_r_k, *rwkv_ln_g, *rwkv_ln_b, *attn_q_norm, *attn_k_norm, *lru_conv_w, *lru_conv_b,
        *lru_gate_w, *lru_gate_b, *lru_lambda, *swa_sink, *final_g;
    float* out;
    char* ws;
};
constexpr size_t al256(size_t x) { return (x + 255) & ~(size_t)255; }
constexpr size_t WO_WT_IN = 0;
constexpr size_t WO_WT_OUT = WO_WT_IN + al256((size_t)NL * DIN * DM * 2);
constexpr size_t WO_XB = WO_WT_OUT + al256((size_t)NL * DM * DM * 2);
constexpr size_t WO_Z = WO_XB + al256((size_t)NTOK * DM * 2);
constexpr size_t WO_SR = WO_Z + al256((size_t)NTOK * DIN * 2);
constexpr size_t WO_SK = WO_SR + SA_EL * 2, WO_SV = WO_SK + SA_EL * 2, WO_SKK = WO_SV + SA_EL * 2, WO_SA0 = WO_SKK + SA_EL * 2, WO_SW0 = WO_SA0 + 2 * SA_EL * 2;
constexpr size_t WO_CTR = WO_SW0 + 2 * SA_EL * 2;
constexpr size_t WO_WUP = WO_CTR + 256, WO_AUP = WO_WUP + (size_t)NL * 2 * 256 * 64 * 2, WO_GW = WO_AUP + (size_t)NL * 2 * 256 * 64 * 2, WO_ROPE = WO_GW + (size_t)NL * 16 * 4096 * 2;
constexpr size_t WO_GBAR = WO_ROPE + 2048 * 4;
constexpr size_t WO_PART = WO_GBAR + 256;
constexpr size_t WS_NEED = WO_PART + (size_t)NTOK * 16 * 4;
#define WSF(name, T, off) DEVI T* ws_##name(const Params& p) { return (T*)(p.ws + (off)); }
WSF(wt_in, bf16_t, WO_WT_IN) WSF(wt_out, bf16_t, WO_WT_OUT) WSF(xb, bf16_t, WO_XB) WSF(z, bf16_t, WO_Z) WSF(sR, bf16_t, WO_SR) WSF(sK, bf16_t, WO_SK)
WSF(sV, bf16_t, WO_SV) WSF(sKK, bf16_t, WO_SKK) WSF(sA0, bf16_t, WO_SA0) WSF(sW0, bf16_t, WO_SW0) WSF(la, bf16_t, WO_XB) WSF(h0, bf16_t, WO_XB + 2 * SA_EL * 2)
WSF(ctr, int, WO_CTR) WSF(gbar, unsigned, WO_GBAR) WSF(part, float, WO_PART) WSF(wup_t, bf16_t, WO_WUP) WSF(aup_t, bf16_t, WO_AUP) WSF(gw_t, bf16_t, WO_GW) WSF(rope, float, WO_ROPE)

DEVI float bf2f(bf16_t h) { return __uint_as_float(((unsigned)h) << 16); }
DEVI bf16_t f2bf(float f) { return __builtin_bit_cast(bf16_t, (__bf16)f); }
typedef float f2 __attribute__((ext_vector_type(2)));
typedef __bf16 b2_t __attribute__((ext_vector_type(2)));
DEVI unsigned pk2(float lo, float hi) { f2 v = {lo, hi}; return __builtin_bit_cast(unsigned, __builtin_convertvector(v, b2_t)); }
typedef unsigned u32x4 __attribute__((ext_vector_type(4)));
typedef unsigned u32x2 __attribute__((ext_vector_type(2)));
DEVI float sigm(float x) { return 1.f / (1.f + __expf(-x)); }
DEVI float dpp_f(float v, int) { return v; }
template <int CTRL> DEVI float dppx(float v) { return __builtin_bit_cast(float, __builtin_amdgcn_update_dpp(0, __builtin_bit_cast(int, v), CTRL, 0xf, 0xf, true)); }
DEVI float wave_sum(float v) {
    v += dppx<0xB1>(v);
    v += dppx<0x4E>(v);
    v += dppx<0x141>(v);
    v += dppx<0x140>(v);
    v += __shfl_xor(v, 16); v += __shfl_xor(v, 32);
    return v;
}
DEVI float rdl(float v, int j) { return __builtin_bit_cast(float, __builtin_amdgcn_readlane(__builtin_bit_cast(int, v), j)); }
DEVI const float* xrow(const Params& p, int l, int m) {
    if (l > 0) return p.out + (size_t)m * DM;
    const float* xp = p.x_prompt; const float* xs = p.x_sample;
    const long delta = (xs - xp) - (long)NPROMPT * DM;
    return xp + (size_t)m * DM + (m >= NPROMPT ? delta : (long)0);
}

DEVI int tidx() { int t = threadIdx.x; asm volatile("" : "+v"(t)); return t; }
constexpr int CW_PER_L = 1088, CW_ITEMS = NL * CW_PER_L + 1;
DEVI void ph_convw(const Params& p, int item, char* smem) {
    float* tile = (float*)smem;
    if (item == NL * CW_PER_L) {
        for (int e = tidx(); e < 1024; e += 256) {
            const int pos = e >> 4, i = e & 15;
            const float inv = exp2f(-(float)i * (13.287712379549449f / 16.f));
            const float ang = (float)pos * inv;
            ws_rope(p)[2 * e] = cosf(ang); ws_rope(p)[2 * e + 1] = sinf(ang);
        }
        return;
    }
    const int l = item / CW_PER_L; int r = item % CW_PER_L;
    const float* src; bf16_t* dst; int N, K, k0, n0;
    if (r < 800) { src = p.w_in + (size_t)l * DM * DIN; dst = ws_wt_in(p) + (size_t)l * DIN * DM; N = DIN; K = DM; k0 = (r / 50) * 64; n0 = (r % 50) * 64; }
    else if (r < 1056) { r -= 800; src = p.w_out + (size_t)l * DM * DM; dst = ws_wt_out(p) + (size_t)l * DM * DM; N = DM; K = DM; k0 = (r / 16) * 64; n0 = (r % 16) * 64; }
    else if (r < 1072) { r -= 1056; const int d = (r >> 2) & 1, up = r >> 3; const size_t o = (size_t)(l * 2 + d) * 64 * 256;
        src = (up ? p.rwkv_a_up : p.rwkv_w_up) + o; dst = (up ? ws_aup_t(p) : ws_wup_t(p)) + o; N = 256; K = 64; k0 = 0; n0 = (r & 3) * 64; }
    else { r -= 1072; const size_t o = (size_t)(l * 16 + r) * 4096; src = p.lru_gate_w + o; dst = ws_gw_t(p) + o; N = 64; K = 64; k0 = 0; n0 = 0; }
    int tx = tidx() & 63, ty = tidx() >> 6;
    __syncthreads();
    for (int i = 0; i < 16; ++i) { int k = ty + 4 * i; tile[k * 65 + tx] = src[(size_t)(k0 + k) * N + n0 + tx]; }
    __syncthreads();
    for (int i = 0; i < 16; ++i) { int n = ty + 4 * i; dst[(size_t)(n0 + n) * K + k0 + tx] = f2bf(tile[tx * 65 + n]); }
}

DEVI void ph_rownorm(const Params& p, int l, int item) {
    int w = tidx() >> 6, lane = tidx() & 63;
    int m = item * 4 + w;
    const float* x = xrow(p, l, m);
    const float* g = p.norm_g + l * DM;
    float4 v[4]; float ss = 0.f;
#pragma unroll
    for (int i = 0; i < 4; ++i) { v[i] = *(const float4*)(x + lane * 4 + 256 * i); ss += v[i].x * v[i].x + v[i].y * v[i].y + v[i].z * v[i].z + v[i].w * v[i].w; }
    ss = wave_sum(ss);
    if (lane < 16) ws_part(p)[(size_t)m * 16 + lane] = lane == 0 ? ss : 0.f;
#pragma unroll
    for (int i = 0; i < 4; ++i) {
        float4 gg = *(const float4*)(g + lane * 4 + 256 * i);
        uint2 o; o.x = pk2(v[i].x * gg.x, v[i].y * gg.y); o.y = pk2(v[i].z * gg.z, v[i].w * gg.w);
        *(uint2*)(ws_xb(p) + (size_t)m * DM + lane * 4 + 256 * i) = o;
    }
}

DEVI void ph_final(const Params& p, int item) {
    int w = tidx() >> 6, lane = tidx() & 63;
    int m = item * 4 + w;
    float* x = p.out + (size_t)m * DM;
    float4 v[4]; float ss = 0.f;
#pragma unroll
    for (int i = 0; i < 4; ++i) { v[i] = *(const float4*)(x + lane * 4 + 256 * i); ss += v[i].x * v[i].x + v[i].y * v[i].y + v[i].z * v[i].z + v[i].w * v[i].w; }
    ss = wave_sum(ss);
    float rs = rsqrtf(ss * (1.f / DM) + 1e-6f);
#pragma unroll
    for (int i = 0; i < 4; ++i) {
        float4 gg = *(const float4*)(p.final_g + lane * 4 + 256 * i);
        float4 o; o.x = v[i].x * rs * gg.x; o.y = v[i].y * rs * gg.y; o.z = v[i].z * rs * gg.z; o.w = v[i].w * rs * gg.w;
        *(float4*)(x + lane * 4 + 256 * i) = o;
    }
}

constexpr int GBM = 128, GBN = 128, GBK = 64, GLD = 72;
constexpr int GEMM_LDS = 2 * 2 * 128 * GLD * 2;
template <int EPI>
DEVI void ph_gemm_all(const Params& p, int l, int bid, int G, char* smem, bool dry = false) {
    constexpr int NT = EPI == 0 ? DIN / GBN : DM / GBN;
    constexpr int NTILES = (NTOK / GBM) * NT;
    if (bid >= NTILES) return;
#define G_COORDS(item_, r0_, c0_, pn_) { const int xcd_ = (item_) & 7, jx_ = (item_) >> 3; const int rg_ = jx_ / (8 * NT), wi_ = jx_ % (8 * NT); \
        pn_ = wi_ >> 3; r0_ = (xcd_ * 80 + rg_ * 8 + (wi_ & 7)) * GBM; c0_ = pn_ * GBN; }
    const bf16_t* A = EPI == 0 ? ws_xb(p) : ws_z(p);
    const int lda = EPI == 0 ? DM : DIN;
    const bf16_t* Bt = EPI == 0 ? ws_wt_in(p) + (size_t)l * DIN * DM : ws_wt_out(p) + (size_t)l * DM * DM;
    bf16_t* As = (bf16_t*)smem;
    bf16_t* Bs = As + 2 * 128 * GLD;
    const int tid = tidx(), wid = tid >> 6, lane = tid & 63, wr = wid >> 1, wc = wid & 1, fr = lane & 15, fq = lane >> 4;
    int item = bid, row0, col0, pn, nrow0 = 0, ncol0 = 0, npn = 0;
    G_COORDS(item, row0, col0, pn)
    bool hasn = item + G < NTILES;
    nrow0 = row0; ncol0 = col0; npn = pn;
    if (hasn) G_COORDS(item + G, nrow0, ncol0, npn)
    f32x4 acc[4][4];
#pragma unroll
    for (int m = 0; m < 4; ++m)
#pragma unroll
        for (int n = 0; n < 4; ++n) acc[m][n] = (f32x4){0.f, 0.f, 0.f, 0.f};
    u32x4 ra0[4], rb0[4], ra1[4], rb1[4];
    auto aoff = [&](int kt) __attribute__((always_inline)) -> int {
        if (EPI == 0) return kt * 64;
        const int blk = kt >> 2;
        const int bo = blk == 0 ? OFF_A : blk == 1 ? OFF_B : blk == 2 ? OFF_C : OFF_D;
        return bo + (kt & 3) * 64;
    };
    const int lr = tid >> 3, lch = (tid & 7) * 8;
    const unsigned va0 = (unsigned)(lr * lda + lch) * 2u, vb0 = (unsigned)(lr * DM + lch) * 2u;
    const unsigned vas = (unsigned)(32 * lda) * 2u, vbs = (unsigned)(32 * DM) * 2u;
#define G_LOAD1(ra, rb, i) ra[i] = *(const u32x4*)(ab_ + (va0 + (i) * vas)); rb[i] = *(const u32x4*)(bb_ + (vb0 + (i) * vbs));
#define G_LOAD(ra, rb, r0_, c0_, kt_) { const char* ab_ = (const char*)(A + (size_t)(r0_) * lda + aoff(kt_)); const char* bb_ = (const char*)(Bt + (size_t)(c0_) * DM + (kt_) * 64); \
        G_LOAD1(ra, rb, 0) G_LOAD1(ra, rb, 1) G_LOAD1(ra, rb, 2) G_LOAD1(ra, rb, 3) }
#define S_WRITE1(ra, rb, buf_, i) *(u32x4*)(As + ((buf_) * 128 + lr + 32 * (i)) * GLD + lch) = ra[i]; *(u32x4*)(Bs + ((buf_) * 128 + lr + 32 * (i)) * GLD + lch) = rb[i];
#define S_WRITE(ra, rb, buf_) { S_WRITE1(ra, rb, buf_, 0) S_WRITE1(ra, rb, buf_, 1) S_WRITE1(ra, rb, buf_, 2) S_WRITE1(ra, rb, buf_, 3) }
#define G_COMPUTE_W(buf_, ra, rb, wbuf_, dow_) { \
    bf16x8 af[2][4], bfr[2][4]; \
    _Pragma("unroll") for (int ks = 0; ks < 2; ++ks) { \
        _Pragma("unroll") for (int m = 0; m < 4; ++m) af[ks][m] = *(const bf16x8*)(As + ((buf_) * 128 + wr * 64 + m * 16 + fr) * GLD + ks * 32 + fq * 8); \
        _Pragma("unroll") for (int n = 0; n < 4; ++n) bfr[ks][n] = *(const bf16x8*)(Bs + ((buf_) * 128 + wc * 64 + n * 16 + fr) * GLD + ks * 32 + fq * 8); \
    } \
    if (dow_) S_WRITE(ra, rb, wbuf_) \
    __builtin_amdgcn_s_setprio(1); \
    _Pragma("unroll") for (int ks = 0; ks < 2; ++ks) \
        _Pragma("unroll") for (int m = 0; m < 4; ++m) \
            _Pragma("unroll") for (int n = 0; n < 4; ++n) acc[m][n] = __builtin_amdgcn_mfma_f32_16x16x32_bf16(bfr[ks][n], af[ks][m], acc[m][n], 0, 0, 0); \
    __builtin_amdgcn_s_setprio(0); }
    constexpr int NK = DM / GBK;
    __syncthreads();
    G_LOAD(ra0, rb0, row0, col0, 0) G_LOAD(ra1, rb1, row0, col0, 1)
    S_WRITE(ra0, rb0, 0)
    G_LOAD(ra0, rb0, row0, col0, 2)
    __syncthreads();
#pragma unroll 1
    for (;;) {
#pragma unroll 1
        for (int kt = 0; kt < NK; kt += 2) {
            G_COMPUTE_W(0, ra1, rb1, 1, true)
            __syncthreads();
            { const bool nx = kt + 3 >= NK; const int r_ = nx ? nrow0 : row0, c_ = nx ? ncol0 : col0, k_ = nx ? kt + 3 - NK : kt + 3; G_LOAD(ra1, rb1, r_, c_, k_) }
            G_COMPUTE_W(1, ra0, rb0, 0, true)
            __syncthreads();
            { const bool nx = kt + 4 >= NK; const int r_ = nx ? nrow0 : row0, c_ = nx ? ncol0 : col0, k_ = nx ? kt + 4 - NK : kt + 4; G_LOAD(ra0, rb0, r_, c_, k_) }
        }
    #pragma unroll
        for (int m = 0; m < 4; ++m) {
            const int row = row0 + wr * 64 + m * 16 + fr;
            float rs = 1.f, ssq = 0.f;
            if (EPI == 0) {
                const f32x4* pp = (const f32x4*)(ws_part(p) + (size_t)row * 16);
                const f32x4 q0 = pp[0], q1 = pp[1], q2 = pp[2], q3 = pp[3];
                const float sm = ((q0[0] + q0[1]) + (q0[2] + q0[3])) + ((q1[0] + q1[1]) + (q1[2] + q1[3])) + ((q2[0] + q2[1]) + (q2[2] + q2[3])) + ((q3[0] + q3[1]) + (q3[2] + q3[3]));
                rs = rsqrtf(sm * (1.f / DM) + 1e-6f);
            }
    #pragma unroll
            for (int n = 0; n < 4; ++n) {
                const int col = col0 + wc * 64 + n * 16 + fq * 4;
                if (dry) { if (acc[m][n][0] == 1.2345e30f) ws_ctr(p)[63] = 1; }
                else if (EPI == 0) {
                    uint2 o; o.x = pk2(acc[m][n][0] * rs, acc[m][n][1] * rs); o.y = pk2(acc[m][n][2] * rs, acc[m][n][3] * rs);
                    *(uint2*)(ws_z(p) + (size_t)row * DIN + col) = o;
                } else {
                    const float4 xr = *(const float4*)(xrow(p, l, row) + col);
                    float4 o; o.x = xr.x + acc[m][n][0]; o.y = xr.y + acc[m][n][1]; o.z = xr.z + acc[m][n][2]; o.w = xr.w + acc[m][n][3];
                    *(float4*)(p.out + (size_t)row * DM + col) = o;
                    ssq += (o.x * o.x + o.y * o.y) + (o.z * o.z + o.w * o.w);
                    if (l + 1 < NL) {
                        const float4 gg = *(const float4*)(p.norm_g + (l + 1) * DM + col);
                        uint2 ob; ob.x = pk2(o.x * gg.x, o.y * gg.y); ob.y = pk2(o.z * gg.z, o.w * gg.w);
                        *(uint2*)(ws_xb(p) + (size_t)row * DM + col) = ob;
                    }
                }
            }
            if (EPI == 1 && !dry) {
                ssq += __shfl_xor(ssq, 16); ssq += __shfl_xor(ssq, 32);
                if (fq == 0) ws_part(p)[(size_t)row * 16 + pn * 2 + wc] = ssq;
            }
        }
        if (!hasn) break;
#pragma unroll
        for (int m = 0; m < 4; ++m)
#pragma unroll
            for (int n = 0; n < 4; ++n) acc[m][n] = (f32x4){0.f, 0.f, 0.f, 0.f};
        item += G; row0 = nrow0; col0 = ncol0; pn = npn;
        hasn = item + G < NTILES;
        if (hasn) G_COORDS(item + G, nrow0, ncol0, npn)
    }
#undef G_LOAD
#undef S_WRITE
#undef G_LOAD1
#undef S_WRITE1
#undef G_COMPUTE_W
#undef G_COORDS
}

constexpr int XLD = 264, LLD = 72;
constexpr int PREP_LDS = 64 * XLD * 2 + 2 * 64 * LLD * 2;
DEVI float ropeT(f2 cs, float x, int d) {
    const int e = d & 31;
    const float pr = __shfl_xor(x, 16);
    return (e < 16) ? x * cs.x - pr * cs.y : pr * cs.y + x * cs.x;
}
DEVI void ph_prep(const Params& p, int l, int item, char* smem, bool dry = false) {
    bf16_t* xc_s = (bf16_t*)smem;
    bf16_t* wl_s = xc_s + 64 * XLD;
    bf16_t* al_s = wl_s + 64 * LLD;
    const int tid = tidx(), w = tid >> 6, lane = tid & 63, fr = lane & 15, fq = lane >> 4;
    const int b = item >> 6, t0 = (item & 63) * 32;
    const size_t mbase = (size_t)b * T_ + t0;
    bf16_t* zt = ws_z(p) + mbase * DIN;
    __syncthreads();
    {
        const float* sh = p.rwkv_shift + l * 2 * 896;
        float s0[4], s1[4], pv[4], cu[4];
#pragma unroll
        for (int s_ = 0; s_ < 4; ++s_) {
            const int c = tid + 256 * s_;
            const bool ok = c < 896;
            s0[s_] = ok ? sh[c] : 0.f; s1[s_] = ok ? sh[896 + c] : 0.f;
            pv[s_] = (ok && t0 > 0) ? bf2f(zt[c - DIN]) : 0.f;
            cu[s_] = ok ? bf2f(zt[c]) : 0.f;
        }
        const float kkw = p.rwkv_k_k[l * 256 + tid];
        float cw[4];
#pragma unroll
        for (int jj = 0; jj < 4; ++jj) cw[jj] = p.lru_conv_w[(l * 4 + jj) * 256 + tid];
        const float cb = p.lru_conv_b[l * 256 + tid];
        float xm2 = t0 >= 2 ? bf2f(zt[OFF_C + tid - 2 * DIN]) : 0.f, xm1 = t0 >= 1 ? bf2f(zt[OFF_C + tid - DIN]) : 0.f, x0 = bf2f(zt[OFF_C + tid]);
        const float qnw = p.attn_q_norm[l * 64 + lane], knw = p.attn_k_norm[l * 64 + lane];
        const bool c3 = tid < 128;
        bf16_t nA[2][4][4], nC[2][4], qB[2][4], kB[2][4];
        f2 cs8[2][4];
#define PREP_LOADG(B_, G_) { \
            _Pragma("unroll") for (int i8 = 0; i8 < 4; ++i8) { \
                const int tt = (G_) * 4 + i8; \
                const bf16_t* zr = zt + (size_t)tt * DIN; \
                const bool hasn = t0 + tt + 1 < T_; \
                _Pragma("unroll") for (int s_ = 0; s_ < 4; ++s_) nA[B_][i8][s_] = (hasn && (s_ < 3 || c3)) ? zr[tid + 256 * s_ + DIN] : (bf16_t)0; \
                nC[B_][i8] = hasn ? zr[OFF_C + tid + DIN] : (bf16_t)0; \
                qB[B_][i8] = zr[OFF_B + tid]; \
                kB[B_][i8] = c3 ? zr[OFF_B + 256 + tid] : (bf16_t)0; \
                cs8[B_][i8] = *(const f2*)(ws_rope(p) + 2 * (((lane >> 5) ? (t0 & 63) + tt : (t0 >> 6)) * 16 + (lane & 15))); \
            } }
#define PREP_COMPG(B_, G_) { \
            _Pragma("unroll") for (int i8 = 0; i8 < 4; ++i8) { \
                const int tt = (G_) * 4 + i8; \
                bf16_t* zr = zt + (size_t)tt * DIN; \
                float xs[4]; \
                _Pragma("unroll") for (int s_ = 0; s_ < 4; ++s_) { \
                    const float nx = bf2f(nA[B_][i8][s_]); \
                    xs[s_] = cu[s_] + s0[s_] * (pv[s_] - cu[s_]) + s1[s_] * (nx - cu[s_]); \
                    pv[s_] = cu[s_]; cu[s_] = nx; \
                } \
                const size_t o = (mbase + tt) * 256 + tid; \
                const float kkv = xs[1] * kkw; \
                const float ss = wave_sum(kkv * kkv); \
                ws_sR(p)[o] = f2bf(xs[0]); ws_sK(p)[o] = f2bf(xs[1]); ws_sV(p)[o] = f2bf(xs[2]); ws_sKK(p)[o] = f2bf(kkv * rsqrtf(fmaxf(ss, 1e-24f))); \
                if (tid < 64) wl_s[tt * LLD + tid] = f2bf(1.f - 2.f / (1.f + __expf(2.f * xs[3]))); \
                else if (tid < 128) al_s[tt * LLD + tid - 64] = f2bf(xs[3]); \
                const float xp1 = bf2f(nC[B_][i8]); \
                xc_s[tt * XLD + tid] = f2bf(cb + cw[0] * xm2 + cw[1] * xm1 + cw[2] * x0 + cw[3] * xp1); \
                xm2 = xm1; xm1 = x0; x0 = xp1; \
                const float q = bf2f(qB[B_][i8]); \
                const float s2 = wave_sum(q * q); \
                const float qn = ropeT(cs8[B_][i8], q * rsqrtf(s2 * (1.f / 64.f) + 1e-6f) * qnw, lane) * (0.125f * 1.4426950408889634f); \
                if (!dry) zr[OFF_B + tid] = f2bf(qn); \
                if (c3) { \
                    const float kx = bf2f(kB[B_][i8]); \
                    const float s3 = wave_sum(kx * kx); \
                    const float kro = ropeT(cs8[B_][i8], kx * rsqrtf(s3 * (1.f / 64.f) + 1e-6f) * knw, lane); \
                    if (!dry) zr[OFF_B + 256 + tid] = f2bf(kro); \
                } \
            } }
        PREP_LOADG(0, 0)
#pragma unroll 1
        for (int g = 0; g < 8; g += 2) {
            PREP_LOADG(1, g + 1)
            PREP_COMPG(0, g)
            if (g + 2 < 8) PREP_LOADG(0, g + 2)
            PREP_COMPG(1, g + 1)
        }
#undef PREP_LOADG
#undef PREP_COMPG
    }
    __syncthreads();
#pragma unroll 1
    for (int dm = 0; dm < 4; ++dm) {
        const int d = dm >> 1, mat = dm & 1;
        const bf16_t* Bt = (mat ? ws_aup_t(p) : ws_wup_t(p)) + ((size_t)(l * 2 + d) * 256 + 64 * w) * 64;
        bf16x8 bfr[4][2];
#pragma unroll
        for (int nt = 0; nt < 4; ++nt)
#pragma unroll
            for (int ks = 0; ks < 2; ++ks) bfr[nt][ks] = *(const bf16x8*)(Bt + (16 * nt + fr) * 64 + 32 * ks + 8 * fq);
        const bf16_t* As = mat ? al_s : wl_s;
        const float* bias = (mat ? p.rwkv_a0 : p.rwkv_w0) + (l * 2 + d) * 256 + 64 * w + 4 * fq;
        bf16_t* dst = (mat ? ws_sA0(p) : ws_sW0(p)) + d * SA_EL + mbase * 256 + 64 * w + 4 * fq;
#pragma unroll 1
        for (int m = 0; m < 2; ++m) {
            bf16x8 af[2];
#pragma unroll
            for (int ks = 0; ks < 2; ++ks) af[ks] = *(const bf16x8*)(As + (16 * m + fr) * LLD + 32 * ks + 8 * fq);
#pragma unroll
            for (int nt = 0; nt < 4; ++nt) {
                f32x4 acc = (f32x4){0.f, 0.f, 0.f, 0.f};
#pragma unroll
                for (int ks = 0; ks < 2; ++ks) acc = __builtin_amdgcn_mfma_f32_16x16x32_bf16(bfr[nt][ks], af[ks], acc, 0, 0, 0);
                const f32x4 bv = *(const f32x4*)(bias + 16 * nt);
                float ov[4];
#pragma unroll
                for (int jj = 0; jj < 4; ++jj) {
                    const float sg = sigm(acc[jj] + bv[jj]);
                    ov[jj] = mat ? sg : 1.f - __expf(-0.6065306597126334f * sg);
                }
                u32x2 o2; o2[0] = pk2(ov[0], ov[1]); o2[1] = pk2(ov[2], ov[3]);
                *(u32x2*)(dst + (size_t)(16 * m + fr) * 256 + 16 * nt) = o2;
            }
        }
    }
#pragma unroll 1
    for (int d = 0; d < 2; ++d) {
        bf16x8 bfr[2][4][2];
#pragma unroll
        for (int k = 0; k < 2; ++k)
#pragma unroll
            for (int nt = 0; nt < 4; ++nt)
#pragma unroll
                for (int ks = 0; ks < 2; ++ks)
                    bfr[k][nt][ks] = *(const bf16x8*)(ws_gw_t(p) + ((size_t)(((l * 2 + d) * 2 + k) * 4 + w) * 64 + 16 * nt + fr) * 64 + 32 * ks + 8 * fq);
        const int e00 = 64 * w + 4 * fq;
#pragma unroll 1
        for (int m = 0; m < 2; ++m) {
            bf16x8 af[2];
#pragma unroll
            for (int ks = 0; ks < 2; ++ks) af[ks] = *(const bf16x8*)(xc_s + (16 * m + fr) * XLD + 64 * w + 32 * ks + 8 * fq);
#pragma unroll
            for (int nt = 0; nt < 4; ++nt) {
                f32x4 g0 = (f32x4){0.f, 0.f, 0.f, 0.f}, g1 = g0;
#pragma unroll
                for (int ks = 0; ks < 2; ++ks) {
                    g0 = __builtin_amdgcn_mfma_f32_16x16x32_bf16(bfr[0][nt][ks], af[ks], g0, 0, 0, 0);
                    g1 = __builtin_amdgcn_mfma_f32_16x16x32_bf16(bfr[1][nt][ks], af[ks], g1, 0, 0, 0);
                }
                const int e0 = e00 + 16 * nt;
                const f32x4 gb0 = *(const f32x4*)(p.lru_gate_b + ((l * 2 + d) * 2 + 0) * 256 + e0), gb1 = *(const f32x4*)(p.lru_gate_b + ((l * 2 + d) * 2 + 1) * 256 + e0);
                const f32x4 lam = *(const f32x4*)(p.lru_lambda + (l * 2 + d) * 256 + e0);
                const u32x2 xu = *(const u32x2*)(xc_s + (16 * m + fr) * XLD + e0);
                const float xv[4] = {__uint_as_float(xu[0] << 16), __uint_as_float(xu[0] & 0xffff0000u), __uint_as_float(xu[1] << 16), __uint_as_float(xu[1] & 0xffff0000u)};
                float a1[4], bt[4];
#pragma unroll
                for (int jj = 0; jj < 4; ++jj) {
                    const float r = sigm(g0[jj] + gb0[jj]), ig = sigm(g1[jj] + gb1[jj]);
                    const float sp = __logf(1.f + __expf(-lam[jj]));
                    const float a = __expf(-8.f * r * sp);
                    a1[jj] = 1.f - a;
                    bt[jj] = sqrtf(a1[jj] * (1.f + a)) * ig * xv[jj];
                }
                const size_t o = d * SA_EL + (mbase + 16 * m + fr) * 256 + e0;
                u32x2 oa; oa[0] = pk2(a1[0], a1[1]); oa[1] = pk2(a1[2], a1[3]);
                u32x2 ob; ob[0] = pk2(bt[0], bt[1]); ob[1] = pk2(bt[2], bt[3]);
                *(u32x2*)(ws_la(p) + o) = oa; *(u32x2*)(ws_h0(p) + o) = ob;
            }
        }
    }
}

DEVI f2 fma2(f2 a, f2 b, f2 c) { return __builtin_elementwise_fma(a, b, c); }
DEVI void ph_rwkv_scan(const Params& p, int l, int item, char* smem, bool dry = false) {
    const int wv = __builtin_amdgcn_readfirstlane(tidx() >> 6), lane = tidx() & 63;
    const int wi = item * 4 + wv;
    const int scan = wi / 3, part = wi - scan * 3;
    const int b = scan >> 3, h = (scan >> 1) & 3, d = scan & 1;
    const int c8 = lane & 7, r8 = lane >> 3;
    float* ring = (float*)smem + wv * 1280;
    const char* A = (const char*)(ws_sA0(p) + d * SA_EL);
    const char* Wm = (const char*)(ws_sW0(p) + d * SA_EL);
    const char *R = (const char*)ws_sR(p), *K = (const char*)ws_sK(p), *V = (const char*)ws_sV(p), *KK = (const char*)ws_sKK(p);
    char* Y = (char*)(ws_z(p) + 256 + 256 * d + h * 64);
#define LDB(base, bo) (*(const bf16_t*)((base) + (bo)))
    const float ka = p.rwkv_k_a[l * 256 + h * 64 + lane];
    f2 S[3][4];
#pragma unroll
    for (int pp = 0; pp < 3; ++pp)
#pragma unroll
        for (int k = 0; k < 4; ++k) S[pp][k] = (f2){0.f, 0.f};
    const unsigned t00 = (unsigned)(b * T_ + (d ? T_ - 1 : 0)) * 256u + h * 64;
    const unsigned o0 = (t00 + lane) * 2u;
    int rowp[3]; unsigned ov[3];
#pragma unroll
    for (int pp = 0; pp < 3; ++pp) { rowp[pp] = 24 * part + 8 * pp + r8; ov[pp] = (t00 + (rowp[pp] < 64 ? rowp[pp] : 63)) * 2u; }
    const int stp = d ? -512 : 512;
    const int myp = c8 < 3 ? c8 : 0;
    const int myrow = 24 * part + 8 * myp + r8;
    const bool ystore = c8 < 3 && myrow < 64 && !dry;
    const unsigned yrow_b = (unsigned)myrow * 2u;
    float vcur[3], vnx[3];
#pragma unroll
    for (int s_ = 0; s_ < 2; ++s_) {
        const unsigned o = o0 + s_ * stp;
        const float r = bf2f(LDB(R, o)), k = bf2f(LDB(K, o)), kk = bf2f(LDB(KK, o)), a = bf2f(LDB(A, o)), w = 1.f - bf2f(LDB(Wm, o));
#pragma unroll
        for (int pp = 0; pp < 3; ++pp) { const float vv = bf2f(LDB(V, ov[pp] + s_ * stp)); if (s_ == 0) vcur[pp] = vv; else vnx[pp] = vv; }
        float* sl = ring + s_ * 320;
        sl[0 * 64 + lane] = w; sl[1 * 64 + lane] = kk * a; sl[2 * 64 + lane] = k * (1.f + (a - 1.f) * ka); sl[3 * 64 + lane] = r; sl[4 * 64 + lane] = kk;
    }
    bf16_t rr[8], rk[8], rkk[8], ra[8], rw[8], rv[8][3];
#pragma unroll
    for (int i = 0; i < 8; ++i) {
        const int st = (i < 2 ? 8 + i : i) * stp;
        rr[i] = LDB(R, o0 + st); rk[i] = LDB(K, o0 + st); rkk[i] = LDB(KK, o0 + st); ra[i] = LDB(A, o0 + st); rw[i] = LDB(Wm, o0 + st);
#pragma unroll
        for (int pp = 0; pp < 3; ++pp) rv[i][pp] = LDB(V, ov[pp] + st);
    }
    __builtin_amdgcn_wave_barrier();
    f32x4 OB[2][5][2];
#define RW_LDO(set, slw, slk) { _Pragma("unroll") for (int g = 0; g < 2; ++g) { \
        OB[set][0][g] = *(const f32x4*)((slw) + 0 * 64 + 8 * c8 + 4 * g); OB[set][1][g] = *(const f32x4*)((slw) + 1 * 64 + 8 * c8 + 4 * g); \
        OB[set][2][g] = *(const f32x4*)((slw) + 2 * 64 + 8 * c8 + 4 * g); OB[set][3][g] = *(const f32x4*)((slw) + 3 * 64 + 8 * c8 + 4 * g); \
        OB[set][4][g] = *(const f32x4*)((slk) + 4 * 64 + 8 * c8 + 4 * g); } }
    RW_LDO(0, ring, ring + 320)
    float sktot[3] = {0.f, 0.f, 0.f};
    __builtin_amdgcn_s_setprio(3);
    for (int sb = 0; sb < T_; sb += 8) {
#pragma unroll
        for (int i = 0; i < 8; ++i) {
            const int step = sb + i;
            const int slot = (i + 2) & 7;
            float v2n[3];
            {
                float* sn = ring + ((i + 2) & 3) * 320;
                const float r1 = bf2f(rr[slot]), k1 = bf2f(rk[slot]), kk1 = bf2f(rkk[slot]), a1 = bf2f(ra[slot]), w1 = 1.f - bf2f(rw[slot]);
                sn[0 * 64 + lane] = w1; sn[1 * 64 + lane] = kk1 * a1; sn[2 * 64 + lane] = k1 * (1.f + (a1 - 1.f) * ka); sn[3 * 64 + lane] = r1; sn[4 * 64 + lane] = kk1;
#pragma unroll
                for (int pp = 0; pp < 3; ++pp) v2n[pp] = bf2f(rv[slot][pp]);
            }
            {
                const int s10 = (step + 10 < T_ ? step + 10 : T_ - 1) * stp;
                const unsigned oc = o0 + s10;
                rr[slot] = LDB(R, oc); rk[slot] = LDB(K, oc); rkk[slot] = LDB(KK, oc); ra[slot] = LDB(A, oc); rw[slot] = LDB(Wm, oc);
#pragma unroll
                for (int pp = 0; pp < 3; ++pp) rv[slot][pp] = LDB(V, ov[pp] + s10);
            }
            __builtin_amdgcn_wave_barrier();
            RW_LDO((i + 1) & 1, ring + ((i + 1) & 3) * 320, ring + ((i + 2) & 3) * 320)
            const unsigned tok_b = (unsigned)(b * T_ + (d ? T_ - 1 - step : step)) * (unsigned)(DIN * 2);
            float pyv[3];
#pragma unroll
            for (int pp = 0; pp < 3; ++pp) {
                const f2 nsk2 = (f2){-sktot[pp], -sktot[pp]}, v2 = (f2){vcur[pp], vcur[pp]};
                f2 y2 = (f2){0.f, 0.f}, sk2 = (f2){0.f, 0.f};
#pragma unroll
                for (int g = 0; g < 2; ++g) {
                    const f32x4 w4 = OB[i & 1][0][g], b4 = OB[i & 1][1][g], kd4 = OB[i & 1][2][g], r4 = OB[i & 1][3][g], kn4 = OB[i & 1][4][g];
                    f2 t0 = v2 * kd4.xy; t0 = fma2(nsk2, b4.xy, t0);
                    S[pp][2 * g] = fma2(S[pp][2 * g], w4.xy, t0);
                    y2 = fma2(S[pp][2 * g], r4.xy, y2); sk2 = fma2(S[pp][2 * g], kn4.xy, sk2);
                    f2 t1 = v2 * kd4.zw; t1 = fma2(nsk2, b4.zw, t1);
                    S[pp][2 * g + 1] = fma2(S[pp][2 * g + 1], w4.zw, t1);
                    y2 = fma2(S[pp][2 * g + 1], r4.zw, y2); sk2 = fma2(S[pp][2 * g + 1], kn4.zw, sk2);
                }
                float ps = sk2.x + sk2.y, py = y2.x + y2.y;
                ps += dppx<0xB1>(ps); py += dppx<0xB1>(py);
                ps += dppx<0x4E>(ps); py += dppx<0x4E>(py);
                ps += dppx<0x141>(ps); py += dppx<0x141>(py);
                sktot[pp] = ps; pyv[pp] = py;
                vcur[pp] = vnx[pp]; vnx[pp] = v2n[pp];
            }
            {
                const float ysel = c8 == 0 ? pyv[0] : c8 == 1 ? pyv[1] : pyv[2];
                if (ystore) *(bf16_t*)(Y + (tok_b + yrow_b)) = f2bf(ysel);
            }
        }
    }
    __builtin_amdgcn_s_setprio(0);
#undef RW_LDO
#undef LDB
}

DEVI void ph_lru_scan(const Params& p, int l, int item, bool dry = false) {
    const int lane = tidx() & 63, idx = item * 4 + (tidx() >> 6);
    const int b = idx >> 3, n = (idx >> 1) & 3, d = idx & 1;
    const bf16_t* A = ws_la(p) + d * SA_EL + (size_t)b * T_ * 256 + n * 64 + lane;
    bf16_t* H = ws_h0(p) + d * SA_EL + (size_t)b * T_ * 256 + n * 64 + lane;
    float h = 0.f;
    for (int s0 = 0; s0 < T_; s0 += 32) {
        bf16_t av[32], bv[32];
#pragma unroll
        for (int i = 0; i < 32; ++i) { const int t = d ? T_ - 1 - (s0 + i) : s0 + i; av[i] = A[(size_t)t * 256]; bv[i] = H[(size_t)t * 256]; }
#pragma unroll
        for (int i = 0; i < 32; ++i) {
            const int t = d ? T_ - 1 - (s0 + i) : s0 + i;
            h = (1.f - bf2f(av[i])) * h + bf2f(bv[i]);
            if (!dry) H[(size_t)t * 256] = f2bf(h);
        }
    }
}

DEVI void ph_post(const Params& p, int l, int item) {
    const int j = tidx();
    const float lg = p.rwkv_ln_g[l * 256 + j], lb = p.rwkv_ln_b[l * 256 + j], ka = p.rwkv_k_a[l * 256 + j], rk_ = p.rwkv_r_k[l * 256 + j];
    bf16_t yf[8], yr[8], r_[8], k_[8], v_[8], af[8], ar[8], ga[8], hf[8], hr[8], gc[8];
#pragma unroll
    for (int i = 0; i < 8; ++i) {
        const int m = item * 8 + i;
        const size_t o = (size_t)m * 256 + j;
        const bf16_t* zr = ws_z(p) + (size_t)m * DIN;
        yf[i] = zr[256 + j]; yr[i] = zr[512 + j]; r_[i] = ws_sR(p)[o]; k_[i] = ws_sK(p)[o]; v_[i] = ws_sV(p)[o];
        af[i] = ws_sA0(p)[o]; ar[i] = ws_sA0(p)[o + SA_EL]; ga[i] = zr[OFF_A + 896 + j];
        hf[i] = ws_h0(p)[o]; hr[i] = ws_h0(p)[o + SA_EL]; gc[i] = zr[OFF_C + 256 + j];
    }
#pragma unroll
    for (int i = 0; i < 8; ++i) {
        const int m = item * 8 + i;
        bf16_t* zr = ws_z(p) + (size_t)m * DIN;
        const float y = bf2f(yf[i]) + bf2f(yr[i]);
        const float mu = wave_sum(y) * (1.f / 64.f);
        const float dv = y - mu;
        const float var = wave_sum(dv * dv) * (1.f / 64.f);
        const float yn = dv * rsqrtf(var + 64e-5f) * lg + lb;
        const float r = bf2f(r_[i]), k = bf2f(k_[i]), v = bf2f(v_[i]), a_f = bf2f(af[i]), a_r = bf2f(ar[i]);
        const float ksum = k * (1.f + (a_f - 1.f) * ka) + k * (1.f + (a_r - 1.f) * ka);
        const float bon = wave_sum(r * ksum * rk_) * v;
        const float g = bf2f(ga[i]);
        zr[OFF_A + j] = f2bf((yn + bon) * g * sigm(g));
        const float h = bf2f(hf[i]) + bf2f(hr[i]);
        const float g2 = bf2f(gc[i]);
        zr[OFF_C + j] = f2bf(h * g2 * sigm(g2));
    }
}

template <int WIN>
DEVI void ph_attn_naive(const Params& p, int l, int item) {
    const int lane = tidx() & 63, idx = item * 4 + (tidx() >> 6);
    const int qb = idx & 31, hq = (idx >> 5) & 3, b = idx >> 7;
    const int g = hq >> 1;
    constexpr int OFF = WIN ? OFF_D : OFF_B;
    const int t0 = qb * 64, t = t0 + lane;
    bf16_t* zq = ws_z(p) + ((size_t)b * T_ + t) * DIN + OFF + hq * 64;
    float q[64], o[64];
#pragma unroll
    for (int c = 0; c < 8; ++c) {
        const uint4 u = *(const uint4*)(zq + c * 8);
        const unsigned uu[4] = {u.x, u.y, u.z, u.w};
#pragma unroll
        for (int e = 0; e < 4; ++e) { q[c * 8 + 2 * e] = __uint_as_float(uu[e] << 16); q[c * 8 + 2 * e + 1] = __uint_as_float(uu[e] & 0xffff0000u); }
    }
#pragma unroll
    for (int dd = 0; dd < 64; ++dd) o[dd] = 0.f;
    float mx, ls;
    float slope = 0.f;
    if (WIN) { mx = p.swa_sink[l * 4 + hq]; ls = 1.f; slope = exp2f(-8.f * (float)(hq + 1) / 4.f); }
    else { mx = -1e30f; ls = 0.f; }
    const int s0 = WIN ? max(0, t0 - 128) : 0, s1 = WIN ? min(T_ - 1, t0 + 63 + 128) : T_ - 1;
    const bf16_t* kb = ws_z(p) + (size_t)b * T_ * DIN + OFF + 256 + g * 64;
    for (int s = s0; s <= s1; ++s) {
        const bf16_t* kr = kb + (size_t)s * DIN;
        float sc = 0.f;
#pragma unroll
        for (int c = 0; c < 8; ++c) {
            const uint4 u = *(const uint4*)(kr + c * 8);
            const unsigned uu[4] = {u.x, u.y, u.z, u.w};
#pragma unroll
            for (int e = 0; e < 4; ++e) { sc += q[c * 8 + 2 * e] * __uint_as_float(uu[e] << 16); sc += q[c * 8 + 2 * e + 1] * __uint_as_float(uu[e] & 0xffff0000u); }
        }
        bool valid = true;
        if (WIN) { const int dist = abs(t - s); valid = dist <= 128; sc = sc * 0.125f - slope * (float)dist; }
        const float mn = valid ? fmaxf(mx, sc) : mx;
        const float al = __expf(mx - mn);
        const float pp = valid ? __expf(sc - mn) : 0.f;
        mx = mn; ls = ls * al + pp;
#pragma unroll
        for (int c = 0; c < 8; ++c) {
            const uint4 u = *(const uint4*)(kr + 128 + c * 8);
            const unsigned uu[4] = {u.x, u.y, u.z, u.w};
#pragma unroll
            for (int e = 0; e < 4; ++e) {
                o[c * 8 + 2 * e] = o[c * 8 + 2 * e] * al + pp * __uint_as_float(uu[e] << 16);
                o[c * 8 + 2 * e + 1] = o[c * 8 + 2 * e + 1] * al + pp * __uint_as_float(uu[e] & 0xffff0000u);
            }
        }
    }
    const float il = 1.f / ls;
    const bf16_t* zg = zq - hq * 64 + 512 + hq * 64;
#pragma unroll
    for (int c = 0; c < 8; ++c) {
        const uint4 u = *(const uint4*)(zg + c * 8);
        const unsigned uu[4] = {u.x, u.y, u.z, u.w};
        unsigned ov[4];
#pragma unroll
        for (int e = 0; e < 4; ++e) {
            const float g0 = __uint_as_float(uu[e] << 16), g1 = __uint_as_float(uu[e] & 0xffff0000u);
            ov[e] = pk2(o[c * 8 + 2 * e] * il * g0 * sigm(g0), o[c * 8 + 2 * e + 1] * il * g1 * sigm(g1));
        }
        *(uint4*)(zq + c * 8) = make_uint4(ov[0], ov[1], ov[2], ov[3]);
    }
}

constexpr int ALD = 72;
template <int WIN>
DEVI void ph_attn(const Params& p, int l, int item, char* smem, bool dry = false) {
    constexpr int OFF = WIN ? OFF_D : OFF_B;
    const int qb = item & 15, hq = (item >> 4) & 3, b = item >> 6, g = hq >> 1;
    const int tid = tidx(), w = tid >> 6, lane = tid & 63, fr = lane & 15, fq = lane >> 4;
    const int t0 = qb * 128, tw = t0 + 32 * w;
    bf16_t* Ks = (bf16_t*)smem;
    bf16_t* Vt = Ks + 2 * 64 * ALD;
    bf16_t* zb = ws_z(p) + (size_t)b * T_ * DIN;
    bf16x8 qf[2][2];
#pragma unroll
    for (int n = 0; n < 2; ++n)
#pragma unroll
        for (int ks = 0; ks < 2; ++ks) {
            u32x4 u = *(const u32x4*)(zb + (size_t)(tw + 16 * n + fr) * DIN + OFF + hq * 64 + 32 * ks + 8 * fq);
            if (WIN) {
                constexpr float sc = 0.125f * 1.4426950408889634f;
#pragma unroll
                for (int e = 0; e < 4; ++e) u[e] = pk2(__uint_as_float(u[e] << 16) * sc, __uint_as_float(u[e] & 0xffff0000u) * sc);
            }
            qf[n][ks] = __builtin_bit_cast(bf16x8, u);
        }
    const int kt0 = WIN ? max(0, t0 - 128) / 64 : 0, kt1 = WIN ? min(T_, t0 + 256) / 64 : T_ / 64;
    f32x4 ot[4][2];
#pragma unroll
    for (int dm = 0; dm < 4; ++dm)
#pragma unroll
        for (int n = 0; n < 2; ++n) ot[dm][n] = (f32x4){0.f, 0.f, 0.f, 0.f};
    float mrun[2], lrun[2];
    float slope2 = 0.f;
    if (WIN) {
        const float sk = p.swa_sink[l * 4 + hq] * 1.4426950408889634f;
        mrun[0] = mrun[1] = sk; lrun[0] = lrun[1] = fq == 0 ? 1.f : 0.f;
        slope2 = exp2f(-2.f * (float)(hq + 1)) * 1.4426950408889634f;
    } else { mrun[0] = mrun[1] = -1e30f; lrun[0] = lrun[1] = 0.f; }
    const bf16_t* kbase = zb + OFF + 256 + g * 64;
    const bf16_t* vbase = zb + OFF + 384 + g * 64;
    u32x4 rk[2], rv[2];
    const int kkey = tid >> 2, kc = tid & 3, vkey = tid & 63, vc = tid >> 6;
    auto gload = [&](int kt) __attribute__((always_inline)) {
        const bf16_t* kp = kbase + (size_t)(kt * 64 + kkey) * DIN + kc * 16;
        rk[0] = *(const u32x4*)kp; rk[1] = *(const u32x4*)(kp + 8);
        const bf16_t* vp = vbase + (size_t)(kt * 64 + vkey) * DIN + vc * 16;
        rv[0] = *(const u32x4*)vp; rv[1] = *(const u32x4*)(vp + 8);
    };
    auto swrite = [&](int buf) __attribute__((always_inline)) {
        bf16_t* kd = Ks + (buf * 64 + kkey) * ALD + kc * 16;
        *(u32x4*)kd = rk[0]; *(u32x4*)(kd + 8) = rk[1];
        bf16_t* vd = Vt + (buf * 64 + vc * 16) * ALD + vkey;
#pragma unroll
        for (int h = 0; h < 2; ++h)
#pragma unroll
            for (int e = 0; e < 4; ++e) {
                vd[(h * 8 + 2 * e) * ALD] = (bf16_t)(rv[h][e] & 0xffffu);
                vd[(h * 8 + 2 * e + 1) * ALD] = (bf16_t)(rv[h][e] >> 16);
            }
    };
    __syncthreads();
    gload(kt0); swrite(0);
    __syncthreads();
    for (int kt = kt0; kt < kt1; ++kt) {
        const int buf = (kt - kt0) & 1;
        if (kt + 1 < kt1) gload(kt + 1);
        f32x4 st[4][2];
#pragma unroll
        for (int m = 0; m < 4; ++m)
#pragma unroll
            for (int n = 0; n < 2; ++n) st[m][n] = (f32x4){0.f, 0.f, 0.f, 0.f};
#pragma unroll
        for (int ks = 0; ks < 2; ++ks)
#pragma unroll
            for (int m = 0; m < 4; ++m) {
                const bf16x8 kf = *(const bf16x8*)(Ks + (buf * 64 + 16 * m + fr) * ALD + 32 * ks + 8 * fq);
#pragma unroll
                for (int n = 0; n < 2; ++n) st[m][n] = __builtin_amdgcn_mfma_f32_16x16x32_bf16(kf, qf[n][ks], st[m][n], 0, 0, 0);
            }
        if (WIN) {
#pragma unroll
            for (int m = 0; m < 4; ++m)
#pragma unroll
                for (int n = 0; n < 2; ++n)
#pragma unroll
                    for (int j = 0; j < 4; ++j) {
                        const int dist = abs((tw + 16 * n + fr) - (kt * 64 + 16 * m + 4 * fq + j));
                        st[m][n][j] = dist <= 128 ? st[m][n][j] - slope2 * (float)dist : -1e30f;
                    }
        }
#pragma unroll
        for (int n = 0; n < 2; ++n) {
            float mt = st[0][n][0];
#pragma unroll
            for (int m = 0; m < 4; ++m)
#pragma unroll
                for (int j = 0; j < 4; ++j) mt = fmaxf(mt, st[m][n][j]);
            mt = fmaxf(mt, __shfl_xor(mt, 16)); mt = fmaxf(mt, __shfl_xor(mt, 32));
            const float mn = fmaxf(mrun[n], mt);
            const float alpha = __builtin_amdgcn_exp2f(mrun[n] - mn);
            mrun[n] = mn;
            float lsum = 0.f;
#pragma unroll
            for (int m = 0; m < 4; ++m)
#pragma unroll
                for (int j = 0; j < 4; ++j) { const float pv = __builtin_amdgcn_exp2f(st[m][n][j] - mn); lsum += pv; st[m][n][j] = pv; }
            lrun[n] = lrun[n] * alpha + lsum;
#pragma unroll
            for (int dm = 0; dm < 4; ++dm) ot[dm][n] = ot[dm][n] * alpha;
        }
#pragma unroll
        for (int kk = 0; kk < 2; ++kk) {
            bf16x8 pf[2];
#pragma unroll
            for (int n = 0; n < 2; ++n) {
                u32x4 u;
                u[0] = pk2(st[2 * kk][n][0], st[2 * kk][n][1]); u[1] = pk2(st[2 * kk][n][2], st[2 * kk][n][3]);
                u[2] = pk2(st[2 * kk + 1][n][0], st[2 * kk + 1][n][1]); u[3] = pk2(st[2 * kk + 1][n][2], st[2 * kk + 1][n][3]);
                pf[n] = __builtin_bit_cast(bf16x8, u);
            }
#pragma unroll
            for (int dm = 0; dm < 4; ++dm) {
                const bf16_t* vp = Vt + (buf * 64 + 16 * dm + fr) * ALD + 32 * kk + 4 * fq;
                const u32x2 v0 = *(const u32x2*)vp, v1 = *(const u32x2*)(vp + 16);
                const bf16x8 vf = __builtin_bit_cast(bf16x8, (u32x4){v0[0], v0[1], v1[0], v1[1]});
#pragma unroll
                for (int n = 0; n < 2; ++n) ot[dm][n] = __builtin_amdgcn_mfma_f32_16x16x32_bf16(vf, pf[n], ot[dm][n], 0, 0, 0);
            }
        }
        if (kt + 1 < kt1) swrite(buf ^ 1);
        __syncthreads();
    }
#pragma unroll
    for (int n = 0; n < 2; ++n) {
        float lt = lrun[n];
        lt += __shfl_xor(lt, 16); lt += __shfl_xor(lt, 32);
        const float il = 1.f / lt;
        bf16_t* zr = zb + (size_t)(tw + 16 * n + fr) * DIN + OFF + hq * 64 + 4 * fq;
#pragma unroll
        for (int dm = 0; dm < 4; ++dm) {
            const u32x2 gu = *(const u32x2*)(zr + 512 + 16 * dm);
            float gv[4] = {__uint_as_float(gu[0] << 16), __uint_as_float(gu[0] & 0xffff0000u), __uint_as_float(gu[1] << 16), __uint_as_float(gu[1] & 0xffff0000u)};
            float ov[4];
#pragma unroll
            for (int j = 0; j < 4; ++j) ov[j] = ot[dm][n][j] * il * gv[j] * sigm(gv[j]);
            u32x2 o2; o2[0] = pk2(ov[0], ov[1]); o2[1] = pk2(ov[2], ov[3]);
            if (!dry) *(u32x2*)(zr + 16 * dm) = o2;
        }
    }
}

DEVI void gbar(unsigned* ctr, unsigned target) {
    asm volatile("s_waitcnt vmcnt(0)" ::: "memory");
    __syncthreads();
    if (threadIdx.x == 0) {
        __builtin_amdgcn_fence(__ATOMIC_RELEASE, "agent");
        asm volatile("s_waitcnt vmcnt(0)" ::: "memory");
        (void)__hip_atomic_fetch_add(ctr, 1u, __ATOMIC_RELAXED, __HIP_MEMORY_SCOPE_AGENT);
        while (__hip_atomic_load(ctr, __ATOMIC_RELAXED, __HIP_MEMORY_SCOPE_AGENT) < target) __builtin_amdgcn_s_sleep(1);
        __builtin_amdgcn_fence(__ATOMIC_ACQUIRE, "agent");
        asm volatile("s_waitcnt vmcnt(0)" ::: "memory");
    }
    __syncthreads();
}

enum { PH_CONVW, PH_ROWNORM, PH_GEMM1, PH_PREP, PH_RWKV, PH_LRU, PH_ATTNB, PH_ATTND, PH_POST, PH_GEMM2, PH_FINAL };
#ifndef MK_MULTI
#define MK_MULTI 0
#endif
#ifndef PROBE_PREP
#define PROBE_PREP 0
#endif
#ifndef PROBE_MIX
#define PROBE_MIX 0
#endif
#ifndef PROBE_G2
#define PROBE_G2 0
#endif
#if MK_MULTI
template <int PH>
__global__ void __launch_bounds__(256) kph(Params p, int l, int nitems) {
    extern __shared__ __attribute__((aligned(16))) char smem[];
    for (int item = blockIdx.x; item < nitems; item += gridDim.x) {
        if (PH == PH_CONVW) ph_convw(p, item, smem);
        if (PH == PH_ROWNORM) ph_rownorm(p, l, item);
        if (PH == PH_GEMM1) { if (item == (int)blockIdx.x) ph_gemm_all<0>(p, l, blockIdx.x, gridDim.x, smem); }
        if (PH == PH_PREP) ph_prep(p, l, item, smem);
        if (PH == PH_RWKV) ph_rwkv_scan(p, l, item, smem);
        if (PH == PH_LRU) ph_lru_scan(p, l, item);
        if (PH == PH_ATTNB) ph_attn_naive<0>(p, l, item);
        if (PH == PH_ATTND) ph_attn_naive<1>(p, l, item);
        if (PH == PH_POST) ph_post(p, l, item);
        if (PH == PH_GEMM2) { if (item == (int)blockIdx.x) ph_gemm_all<1>(p, l, blockIdx.x, gridDim.x, smem); }
        if (PH == PH_FINAL) ph_final(p, item);
    }
}
template <int PH>
static void launch(const Params& p, int l, int nitems, int lds, hipStream_t stream) {
    if (lds > 48 * 1024) (void)hipFuncSetAttribute((const void*)kph<PH>, hipFuncAttributeMaxDynamicSharedMemorySize, lds);
    int grid = nitems < 65536 ? nitems : 65536;
    hipLaunchKernelGGL(kph<PH>, dim3(grid), dim3(256), lds, stream, p, l, nitems);
}
#else
constexpr int MIX_ITEMS = 80 + 2560 + 2560;
__global__ void __launch_bounds__(256, 2) mega(Params p) {
    extern __shared__ __attribute__((aligned(16))) char smem[];
    __shared__ int s_item;
    cg::grid_group grid = cg::this_grid();
    const int G = gridDim.x, bid = blockIdx.x;
    unsigned nbar = 0;
    if (bid == 0 && threadIdx.x < 64) ws_ctr(p)[threadIdx.x] = 0;
    for (int it = bid; it < CW_ITEMS; it += G) ph_convw(p, it, smem);
    grid.sync();
    for (int l = 0; l < NL; ++l) {
        if (l == 0) {
            for (int it = bid; it < NTOK / 4; it += G) ph_rownorm(p, l, it);
            gbar(ws_gbar(p), (nbar += (unsigned)G));
        }
        ph_gemm_all<0>(p, l, bid, G, smem);
        gbar(ws_gbar(p), (nbar += (unsigned)G));
#if PROBE_PREP
        for (int it = bid; it < NTOK / 32; it += G) ph_prep(p, l, it, smem, true);
#endif
        for (int it = bid; it < NTOK / 32; it += G) ph_prep(p, l, it, smem);
        gbar(ws_gbar(p), (nbar += (unsigned)G));
#if PROBE_MIX
        for (int rep = 0; rep < 2; ++rep) {
        const bool dry = rep == 0;
        int* ctrp = &ws_ctr(p)[l + 4 * rep];
#else
        {
        const bool dry = false;
        int* ctrp = &ws_ctr(p)[l];
#endif
        for (int it = bid; it < 240; it += G) ph_rwkv_scan(p, l, it, smem, dry);
        for (;;) {
            __syncthreads();
            if (threadIdx.x == 0) s_item = atomicAdd(ctrp, 1);
            __syncthreads();
            const int it = s_item;
            if (it >= MIX_ITEMS) break;
            if (it < 80) ph_lru_scan(p, l, it, dry);
            else if (it < 2640) ph_attn<0>(p, l, it - 80, smem, dry);
            else ph_attn<1>(p, l, it - 2640, smem, dry);
        }
        }
        gbar(ws_gbar(p), (nbar += (unsigned)G));
        for (int it = bid; it < NTOK / 8; it += G) ph_post(p, l, it);
        gbar(ws_gbar(p), (nbar += (unsigned)G));
#if PROBE_G2
        ph_gemm_all<1>(p, l, bid, G, smem, true);
#endif
        ph_gemm_all<1>(p, l, bid, G, smem);
        gbar(ws_gbar(p), (nbar += (unsigned)G));
    }
    for (int it = bid; it < NTOK / 4; it += G) ph_final(p, it);
}
#endif

extern "C" void kernel_launch(void* const* d_in, const int* in_sizes, int n_in, void* d_out, int out_size, void* d_ws, size_t ws_size,
                              hipStream_t stream) {
    Params p{};
    const float* const* in = (const float* const*)d_in;
    p.x_prompt = in[0]; p.x_sample = in[1]; p.norm_g = in[2]; p.w_in = in[3]; p.w_out = in[4]; p.rwkv_shift = in[5]; p.rwkv_w0 = in[6];
    p.rwkv_w_up = in[7]; p.rwkv_a0 = in[8]; p.rwkv_a_up = in[9]; p.rwkv_k_k = in[10]; p.rwkv_k_a = in[11]; p.rwkv_r_k = in[12];
    p.rwkv_ln_g = in[13]; p.rwkv_ln_b = in[14]; p.attn_q_norm = in[15]; p.attn_k_norm = in[16]; p.lru_conv_w = in[17]; p.lru_conv_b = in[18];
    p.lru_gate_w = in[19]; p.lru_gate_b = in[20]; p.lru_lambda = in[21]; p.swa_sink = in[22]; p.final_g = in[23];
    p.out = (float*)d_out;
    p.ws = (char*)d_ws;
    if (WS_NEED > ws_size) { fprintf(stderr, "workspace too small: need %zu have %zu\n", (size_t)WS_NEED, ws_size); }

#if MK_MULTI
    launch<PH_CONVW>(p, 0, CW_ITEMS, 64 * 65 * 4, stream);
    for (int l = 0; l < NL; ++l) {
        if (l == 0) launch<PH_ROWNORM>(p, l, NTOK / 4, 0, stream);
        launch<PH_GEMM1>(p, l, (NTOK / GBM) * (DIN / GBN), GEMM_LDS, stream);
        launch<PH_PREP>(p, l, NTOK / 32, PREP_LDS, stream);
        launch<PH_RWKV>(p, l, 240, 4 * 5120, stream);
        launch<PH_LRU>(p, l, 80, 0, stream);
        launch<PH_ATTNB>(p, l, 1280, 0, stream);
        launch<PH_ATTND>(p, l, 1280, 0, stream);
        launch<PH_POST>(p, l, NTOK / 8, 0, stream);
        launch<PH_GEMM2>(p, l, (NTOK / GBM) * (DM / GBN), GEMM_LDS, stream);
    }
    launch<PH_FINAL>(p, 0, NTOK / 4, 0, stream);
#else
    constexpr size_t kDynLds = GEMM_LDS;
    static int grid_blocks = 0;
    if (!grid_blocks) {
        (void)hipFuncSetAttribute((const void*)mega, hipFuncAttributeMaxDynamicSharedMemorySize, (int)kDynLds);
        int dev = 0, cus = 0, per_cu = 0;
        (void)hipGetDevice(&dev);
        (void)hipDeviceGetAttribute(&cus, hipDeviceAttributeMultiprocessorCount, dev);
        (void)hipOccupancyMaxActiveBlocksPerMultiprocessor(&per_cu, mega, 256, kDynLds);
        if (per_cu < 1) per_cu = 1;
        grid_blocks = cus * per_cu;
    }
    (void)hipMemsetAsync((char*)d_ws + WO_GBAR, 0, 256, stream);
    void* args[] = {&p};
    hipError_t e = hipLaunchCooperativeKernel((void*)mega, dim3(grid_blocks), dim3(256), args, kDynLds, stream);
    if (e != hipSuccess) fprintf(stderr, "cooperative launch failed: %s (grid %d)\n", hipGetErrorString(e), grid_blocks);
#endif
}
```

```cpp
#include <hip/hip_runtime.h>
#include <hip/hip_cooperative_groups.h>
#include <cstdio>
#include <cstdint>
namespace cg = cooperative_groups;

#define DEVI __device__ __forceinline__
typedef unsigned short bf16_t;
typedef short bf16x8 __attribute__((ext_vector_type(8)));
typedef float f32x4 __attribute__((ext_vector_type(4)));

constexpr int T_ = 2048, NB_ = 40, NTOK = NB_ * T_, DM = 1024, DIN = 3200, NL = 4;
constexpr int NPROMPT = 32 * T_;
constexpr size_t SA_EL = (size_t)NTOK * 256;
constexpr int OFF_A = 0, OFF_B = 1152, OFF_C = 1920, OFF_D = 2432;

struct Params {
    const float *x_prompt, *x_sample, *norm_g, *w_in, *w_out, *rwkv_shift, *rwkv_w0, *rwkv_w_up, *rwkv_a0, *rwkv_a_up,
        *rwkv_k_k, *rwkv_k_a, *rwkv_r_k, *rwkv_ln_g, *rwkv_ln_b, *attn_q_norm, *attn_k_norm, *lru_conv_w, *lru_conv_b,
        *lru_gate_w, *lru_gate_b, *lru_lambda, *swa_sink, *final_g;
    float* out;
    char* ws;
};
constexpr size_t al256(size_t x) { return (x + 255) & ~(size_t)255; }
constexpr size_t WO_WT_IN = 0;
constexpr size_t WO_WT_OUT = WO_WT_IN + al256((size_t)NL * DIN * DM * 2);
constexpr size_t WO_XB = WO_WT_OUT + al256((size_t)NL * DM * DM * 2);
constexpr size_t WO_Z = WO_XB + al256((size_t)NTOK * DM * 2);
constexpr size_t WO_SR = WO_Z + al256((size_t)NTOK * DIN * 2);
constexpr size_t WO_SK = WO_SR + SA_EL * 2, WO_SV = WO_SK + SA_EL * 2, WO_SKK = WO_SV + SA_EL * 2, WO_SA0 = WO_SKK + SA_EL * 2, WO_SW0 = WO_SA0 + 2 * SA_EL * 2;
constexpr size_t WO_CTR = WO_SW0 + 2 * SA_EL * 2;
constexpr size_t WO_WUP = WO_CTR + 256, WO_AUP = WO_WUP + (size_t)NL * 2 * 256 * 64 * 2, WO_GW = WO_AUP + (size_t)NL * 2 * 256 * 64 * 2, WO_ROPE = WO_GW + (size_t)NL * 16 * 4096 * 2;
constexpr size_t WO_GBAR = WO_ROPE + 2048 * 4;
constexpr size_t WO_PART = WO_GBAR + 256;
constexpr size_t WS_NEED = WO_PART + (size_t)NTOK * 16 * 4;
#define WSF(name, T, off) DEVI T* ws_##name(const Params& p) { return (T*)(p.ws + (off)); }
WSF(wt_in, bf16_t, WO_WT_IN) WSF(wt_out, bf16_t, WO_WT_OUT) WSF(xb, bf16_t, WO_XB) WSF(z, bf16_t, WO_Z) WSF(sR, bf16_t, WO_SR) WSF(sK, bf16_t, WO_SK)
WSF(sV, bf16_t, WO_SV) WSF(sKK, bf16_t, WO_SKK) WSF(sA0, bf16_t, WO_SA0) WSF(sW0, bf16_t, WO_SW0) WSF(la, bf16_t, WO_XB) WSF(h0, bf16_t, WO_XB + 2 * SA_EL * 2)
WSF(ctr, int, WO_CTR) WSF(gbar, unsigned, WO_GBAR) WSF(part, float, WO_PART) WSF(wup_t, bf16_t, WO_WUP) WSF(aup_t, bf16_t, WO_AUP) WSF(gw_t, bf16_t, WO_GW) WSF(rope, float, WO_ROPE)

DEVI float bf2f(bf16_t h) { return __uint_as_float(((unsigned)h) << 16); }
DEVI bf16_t f2bf(float f) { return __builtin_bit_cast(bf16_t, (__bf16)f); }
typedef float f2 __attribute__((ext_vector_type(2)));
typedef __bf16 b2_t __attribute__((ext_vector_type(2)));
DEVI unsigned pk2(float lo, float hi) { f2 v = {lo, hi}; return __builtin_bit_cast(unsigned, __builtin_convertvector(v, b2_t)); }
typedef unsigned u32x4 __attribute__((ext_vector_type(4)));
typedef unsigned u32x2 __attribute__((ext_vector_type(2)));
DEVI float sigm(float x) { return 1.f / (1.f + __expf(-x)); }
DEVI float dpp_f(float v, int) { return v; }
template <int CTRL> DEVI float dppx(float v) { return __builtin_bit_cast(float, __builtin_amdgcn_update_dpp(0, __builtin_bit_cast(int, v), CTRL, 0xf, 0xf, true)); }
DEVI float wave_sum(float v) {
    v += dppx<0xB1>(v);
    v += dppx<0x4E>(v);
    v += dppx<0x141>(v);
    v += dppx<0x140>(v);
    v += __shfl_xor(v, 16); v += __shfl_xor(v, 32);
    return v;
}
DEVI float rdl(float v, int j) { return __builtin_bit_cast(float, __builtin_amdgcn_readlane(__builtin_bit_cast(int, v), j)); }
DEVI const float* xrow(const Params& p, int l, int m) {
    if (l > 0) return p.out + (size_t)m * DM;
    const float* xp = p.x_prompt; const float* xs = p.x_sample;
    const long delta = (xs - xp) - (long)NPROMPT * DM;
    return xp + (size_t)m * DM + (m >= NPROMPT ? delta : (long)0);
}

DEVI int tidx() { int t = threadIdx.x; asm volatile("" : "+v"(t)); return t; }
constexpr int CW_PER_L = 1088, CW_ITEMS = NL * CW_PER_L + 1;
DEVI void ph_convw(const Params& p, int item, char* smem) {
    float* tile = (float*)smem;
    if (item == NL * CW_PER_L) {
        for (int e = tidx(); e < 1024; e += 256) {
            const int pos = e >> 4, i = e & 15;
            const float inv = exp2f(-(float)i * (13.287712379549449f / 16.f));
            const float ang = (float)pos * inv;
            ws_rope(p)[2 * e] = cosf(ang); ws_rope(p)[2 * e + 1] = sinf(ang);
        }
        return;
    }
    const int l = item / CW_PER_L; int r = item % CW_PER_L;
    const float* src; bf16_t* dst; int N, K, k0, n0;
    if (r < 800) { src = p.w_in + (size_t)l * DM * DIN; dst = ws_wt_in(p) + (size_t)l * DIN * DM; N = DIN; K = DM; k0 = (r / 50) * 64; n0 = (r % 50) * 64; }
    else if (r < 1056) { r -= 800; src = p.w_out + (size_t)l * DM * DM; dst = ws_wt_out(p) + (size_t)l * DM * DM; N = DM; K = DM; k0 = (r / 16) * 64; n0 = (r % 16) * 64; }
    else if (r < 1072) { r -= 1056; const int d = (r >> 2) & 1, up = r >> 3; const size_t o = (size_t)(l * 2 + d) * 64 * 256;
        src = (up ? p.rwkv_a_up : p.rwkv_w_up) + o; dst = (up ? ws_aup_t(p) : ws_wup_t(p)) + o; N = 256; K = 64; k0 = 0; n0 = (r & 3) * 64; }
    else { r -= 1072; const size_t o = (size_t)(l * 16 + r) * 4096; src = p.lru_gate_w + o; dst = ws_gw_t(p) + o; N = 64; K = 64; k0 = 0; n0 = 0; }
    int tx = tidx() & 63, ty = tidx() >> 6;
    __syncthreads();
    for (int i = 0; i < 16; ++i) { int k = ty + 4 * i; tile[k * 65 + tx] = src[(size_t)(k0 + k) * N + n0 + tx]; }
    __syncthreads();
    for (int i = 0; i < 16; ++i) { int n = ty + 4 * i; dst[(size_t)(n0 + n) * K + k0 + tx] = f2bf(tile[tx * 65 + n]); }
}

DEVI void ph_rownorm(const Params& p, int l, int item) {
    int w = tidx() >> 6, lane = tidx() & 63;
    int m = item * 4 + w;
    const float* x = xrow(p, l, m);
    const float* g = p.norm_g + l * DM;
    float4 v[4]; float ss = 0.f;
#pragma unroll
    for (int i = 0; i < 4; ++i) { v[i] = *(const float4*)(x + lane * 4 + 256 * i); ss += v[i].x * v[i].x + v[i].y * v[i].y + v[i].z * v[i].z + v[i].w * v[i].w; }
    ss = wave_sum(ss);
    if (lane < 16) ws_part(p)[(size_t)m * 16 + lane] = lane == 0 ? ss : 0.f;
#pragma unroll
    for (int i = 0; i < 4; ++i) {
        float4 gg = *(const float4*)(g + lane * 4 + 256 * i);
        uint2 o; o.x = pk2(v[i].x * gg.x, v[i].y * gg.y); o.y = pk2(v[i].z * gg.z, v[i].w * gg.w);
        *(uint2*)(ws_xb(p) + (size_t)m * DM + lane * 4 + 256 * i) = o;
    }
}

DEVI void ph_final(const Params& p, int item) {
    int w = tidx() >> 6, lane = tidx() & 63;
    int m = item * 4 + w;
    float* x = p.out + (size_t)m * DM;
    float4 v[4]; float ss = 0.f;
#pragma unroll
    for (int i = 0; i < 4; ++i) { v[i] = *(const float4*)(x + lane * 4 + 256 * i); ss += v[i].x * v[i].x + v[i].y * v[i].y + v[i].z * v[i].z + v[i].w * v[i].w; }
    ss = wave_sum(ss);
    float rs = rsqrtf(ss * (1.f / DM) + 1e-6f);
#pragma unroll
    for (int i = 0; i < 4; ++i) {
        float4 gg = *(const float4*)(p.final_g + lane * 4 + 256 * i);
        float4 o; o.x = v[i].x * rs * gg.x; o.y = v[i].y * rs * gg.y; o.z = v[i].z * rs * gg.z; o.w = v[i].w * rs * gg.w;
        *(float4*)(x + lane * 4 + 256 * i) = o;
    }
}

constexpr int GBM = 128, GBN = 128, GBK = 64, GLD = 72;
constexpr int GEMM_LDS = 2 * 2 * 128 * GLD * 2;
template <int EPI>
DEVI void ph_gemm_all(const Params& p, int l, int bid, int G, char* smem, bool dry = false) {
    constexpr int NT = EPI == 0 ? DIN / GBN : DM / GBN;
    constexpr int NTILES = (NTOK / GBM) * NT;
    if (bid >= NTILES) return;
#define G_COORDS(item_, r0_, c0_, pn_) { const int xcd_ = (item_) & 7, jx_ = (item_) >> 3; const int rg_ = jx_ / (8 * NT), wi_ = jx_ % (8 * NT); \
        pn_ = wi_ >> 3; r0_ = (xcd_ * 80 + rg_ * 8 + (wi_ & 7)) * GBM; c0_ = pn_ * GBN; }
    const bf16_t* A = EPI == 0 ? ws_xb(p) : ws_z(p);
    const int lda = EPI == 0 ? DM : DIN;
    const bf16_t* Bt = EPI == 0 ? ws_wt_in(p) + (size_t)l * DIN * DM : ws_wt_out(p) + (size_t)l * DM * DM;
    bf16_t* As = (bf16_t*)smem;
    bf16_t* Bs = As + 2 * 128 * GLD;
    const int tid = tidx(), wid = tid >> 6, lane = tid & 63, wr = wid >> 1, wc = wid & 1, fr = lane & 15, fq = lane >> 4;
    int item = bid, row0, col0, pn, nrow0 = 0, ncol0 = 0, npn = 0;
    G_COORDS(item, row0, col0, pn)
    bool hasn = item + G < NTILES;
    nrow0 = row0; ncol0 = col0; npn = pn;
    if (hasn) G_COORDS(item + G, nrow0, ncol0, npn)
    f32x4 acc[4][4];
#pragma unroll
    for (int m = 0; m < 4; ++m)
#pragma unroll
        for (int n = 0; n < 4; ++n) acc[m][n] = (f32x4){0.f, 0.f, 0.f, 0.f};
    u32x4 ra0[4], rb0[4], ra1[4], rb1[4];
    auto aoff = [&](int kt) __attribute__((always_inline)) -> int {
        if (EPI == 0) return kt * 64;
        const int blk = kt >> 2;
        const int bo = blk == 0 ? OFF_A : blk == 1 ? OFF_B : blk == 2 ? OFF_C : OFF_D;
        return bo + (kt & 3) * 64;
    };
    const int lr = tid >> 3, lch = (tid & 7) * 8;
    const unsigned va0 = (unsigned)(lr * lda + lch) * 2u, vb0 = (unsigned)(lr * DM + lch) * 2u;
    const unsigned vas = (unsigned)(32 * lda) * 2u, vbs = (unsigned)(32 * DM) * 2u;
#define G_LOAD1(ra, rb, i) ra[i] = *(const u32x4*)(ab_ + (va0 + (i) * vas)); rb[i] = *(const u32x4*)(bb_ + (vb0 + (i) * vbs));
#define G_LOAD(ra, rb, r0_, c0_, kt_) { const char* ab_ = (const char*)(A + (size_t)(r0_) * lda + aoff(kt_)); const char* bb_ = (const char*)(Bt + (size_t)(c0_) * DM + (kt_) * 64); \
        G_LOAD1(ra, rb, 0) G_LOAD1(ra, rb, 1) G_LOAD1(ra, rb, 2) G_LOAD1(ra, rb, 3) }
#define S_WRITE1(ra, rb, buf_, i) *(u32x4*)(As + ((buf_) * 128 + lr + 32 * (i)) * GLD + lch) = ra[i]; *(u32x4*)(Bs + ((buf_) * 128 + lr + 32 * (i)) * GLD + lch) = rb[i];
#define S_WRITE(ra, rb, buf_) { S_WRITE1(ra, rb, buf_, 0) S_WRITE1(ra, rb, buf_, 1) S_WRITE1(ra, rb, buf_, 2) S_WRITE1(ra, rb, buf_, 3) }
#define G_COMPUTE_W(buf_, ra, rb, wbuf_, dow_) { \
    bf16x8 af[2][4], bfr[2][4]; \
    _Pragma("unroll") for (int ks = 0; ks < 2; ++ks) { \
        _Pragma("unroll") for (int m = 0; m < 4; ++m) af[ks][m] = *(const bf16x8*)(As + ((buf_) * 128 + wr * 64 + m * 16 + fr) * GLD + ks * 32 + fq * 8); \
        _Pragma("unroll") for (int n = 0; n < 4; ++n) bfr[ks][n] = *(const bf16x8*)(Bs + ((buf_) * 128 + wc * 64 + n * 16 + fr) * GLD + ks * 32 + fq * 8); \
    } \
    if (dow_) S_WRITE(ra, rb, wbuf_) \
    __builtin_amdgcn_s_setprio(1); \
    _Pragma("unroll") for (int ks = 0; ks < 2; ++ks) \
        _Pragma("unroll") for (int m = 0; m < 4; ++m) \
            _Pragma("unroll") for (int n = 0; n < 4; ++n) acc[m][n] = __builtin_amdgcn_mfma_f32_16x16x32_bf16(bfr[ks][n], af[ks][m], acc[m][n], 0, 0, 0); \
    __builtin_amdgcn_s_setprio(0); }
    constexpr int NK = DM / GBK;
    __syncthreads();
    G_LOAD(ra0, rb0, row0, col0, 0) G_LOAD(ra1, rb1, row0, col0, 1)
    S_WRITE(ra0, rb0, 0)
    G_LOAD(ra0, rb0, row0, col0, 2)
    __syncthreads();
#pragma unroll 1
    for (;;) {
#pragma unroll 1
        for (int kt = 0; kt < NK; kt += 2) {
            G_COMPUTE_W(0, ra1, rb1, 1, true)
            __syncthreads();
            { const bool nx = kt + 3 >= NK; const int r_ = nx ? nrow0 : row0, c_ = nx ? ncol0 : col0, k_ = nx ? kt + 3 - NK : kt + 3; G_LOAD(ra1, rb1, r_, c_, k_) }
            G_COMPUTE_W(1, ra0, rb0, 0, true)
            __syncthreads();
            { const bool nx = kt + 4 >= NK; const int r_ = nx ? nrow0 : row0, c_ = nx ? ncol0 : col0, k_ = nx ? kt + 4 - NK : kt + 4; G_LOAD(ra0, rb0, r_, c_, k_) }
        }
    #pragma unroll
        for (int m = 0; m < 4; ++m) {
            const int row = row0 + wr * 64 + m * 16 + fr;
            float rs = 1.f, ssq = 0.f;
            if (EPI == 0) {
                const f32x4* pp = (const f32x4*)(ws_part(p) + (size_t)row * 16);
                const f32x4 q0 = pp[0], q1 = pp[1], q2 = pp[2], q3 = pp[3];
                const float sm = ((q0[0] + q0[1]) + (q0[2] + q0[3])) + ((q1[0] + q1[1]) + (q1[2] + q1[3])) + ((q2[0] + q2[1]) + (q2[2] + q2[3])) + ((q3[0] + q3[1]) + (q3[2] + q3[3]));
                rs = rsqrtf(sm * (1.f / DM) + 1e-6f);
            }
    #pragma unroll
            for (int n = 0; n < 4; ++n) {
                const int col = col0 + wc * 64 + n * 16 + fq * 4;
                if (dry) { if (acc[m][n][0] == 1.2345e30f) ws_ctr(p)[63] = 1; }
                else if (EPI == 0) {
                    uint2 o; o.x = pk2(acc[m][n][0] * rs, acc[m][n][1] * rs); o.y = pk2(acc[m][n][2] * rs, acc[m][n][3] * rs);
                    *(uint2*)(ws_z(p) + (size_t)row * DIN + col) = o;
                } else {
                    const float4 xr = *(const float4*)(xrow(p, l, row) + col);
                    float4 o; o.x = xr.x + acc[m][n][0]; o.y = xr.y + acc[m][n][1]; o.z = xr.z + acc[m][n][2]; o.w = xr.w + acc[m][n][3];
                    *(float4*)(p.out + (size_t)row * DM + col) = o;
                    ssq += (o.x * o.x + o.y * o.y) + (o.z * o.z + o.w * o.w);
                    if (l + 1 < NL) {
                        const float4 gg = *(const float4*)(p.norm_g + (l + 1) * DM + col);
                        uint2 ob; ob.x = pk2(o.x * gg.x, o.y * gg.y); ob.y = pk2(o.z * gg.z, o.w * gg.w);
                        *(uint2*)(ws_xb(p) + (size_t)row * DM + col) = ob;
                    }
                }
            }
            if (EPI == 1 && !dry) {
                ssq += __shfl_xor(ssq, 16); ssq += __shfl_xor(ssq, 32);
                if (fq == 0) ws_part(p)[(size_t)row * 16 + pn * 2 + wc] = ssq;
            }
        }
        if (!hasn) break;
#pragma unroll
        for (int m = 0; m < 4; ++m)
#pragma unroll
            for (int n = 0; n < 4; ++n) acc[m][n] = (f32x4){0.f, 0.f, 0.f, 0.f};
        item += G; row0 = nrow0; col0 = ncol0; pn = npn;
        hasn = item + G < NTILES;
        if (hasn) G_COORDS(item + G, nrow0, ncol0, npn)
    }
#undef G_LOAD
#undef S_WRITE
#undef G_LOAD1
#undef S_WRITE1
#undef G_COMPUTE_W
#undef G_COORDS
}

constexpr int XLD = 264, LLD = 72;
constexpr int PREP_LDS = 64 * XLD * 2 + 2 * 64 * LLD * 2;
DEVI float ropeT(f2 cs, float x, int d) {
    const int e = d & 31;
    const float pr = __shfl_xor(x, 16);
    return (e < 16) ? x * cs.x - pr * cs.y : pr * cs.y + x * cs.x;
}
DEVI void ph_prep(const Params& p, int l, int item, char* smem, bool dry = false) {
    bf16_t* xc_s = (bf16_t*)smem;
    bf16_t* wl_s = xc_s + 64 * XLD;
    bf16_t* al_s = wl_s + 64 * LLD;
    const int tid = tidx(), w = tid >> 6, lane = tid & 63, fr = lane & 15, fq = lane >> 4;
    const int b = item >> 6, t0 = (item & 63) * 32;
    const size_t mbase = (size_t)b * T_ + t0;
    bf16_t* zt = ws_z(p) + mbase * DIN;
    __syncthreads();
    {
        const float* sh = p.rwkv_shift + l * 2 * 896;
        float s0[4], s1[4], pv[4], cu[4];
#pragma unroll
        for (int s_ = 0; s_ < 4; ++s_) {
            const int c = tid + 256 * s_;
            const bool ok = c < 896;
            s0[s_] = ok ? sh[c] : 0.f; s1[s_] = ok ? sh[896 + c] : 0.f;
            pv[s_] = (ok && t0 > 0) ? bf2f(zt[c - DIN]) : 0.f;
            cu[s_] = ok ? bf2f(zt[c]) : 0.f;
        }
        const float kkw = p.rwkv_k_k[l * 256 + tid];
        float cw[4];
#pragma unroll
        for (int jj = 0; jj < 4; ++jj) cw[jj] = p.lru_conv_w[(l * 4 + jj) * 256 + tid];
        const float cb = p.lru_conv_b[l * 256 + tid];
        float xm2 = t0 >= 2 ? bf2f(zt[OFF_C + tid - 2 * DIN]) : 0.f, xm1 = t0 >= 1 ? bf2f(zt[OFF_C + tid - DIN]) : 0.f, x0 = bf2f(zt[OFF_C + tid]);
        const float qnw = p.attn_q_norm[l * 64 + lane], knw = p.attn_k_norm[l * 64 + lane];
        const bool c3 = tid < 128;
        bf16_t nA[2][4][4], nC[2][4], qB[2][4], kB[2][4];
        f2 cs8[2][4];
#define PREP_LOADG(B_, G_) { \
            _Pragma("unroll") for (int i8 = 0; i8 < 4; ++i8) { \
                const int tt = (G_) * 4 + i8; \
                const bf16_t* zr = zt + (size_t)tt * DIN; \
                const bool hasn = t0 + tt + 1 < T_; \
                _Pragma("unroll") for (int s_ = 0; s_ < 4; ++s_) nA[B_][i8][s_] = (hasn && (s_ < 3 || c3)) ? zr[tid + 256 * s_ + DIN] : (bf16_t)0; \
                nC[B_][i8] = hasn ? zr[OFF_C + tid + DIN] : (bf16_t)0; \
                qB[B_][i8] = zr[OFF_B + tid]; \
                kB[B_][i8] = c3 ? zr[OFF_B + 256 + tid] : (bf16_t)0; \
                cs8[B_][i8] = *(const f2*)(ws_rope(p) + 2 * (((lane >> 5) ? (t0 & 63) + tt : (t0 >> 6)) * 16 + (lane & 15))); \
            } }
#define PREP_COMPG(B_, G_) { \
            _Pragma("unroll") for (int i8 = 0; i8 < 4; ++i8) { \
                const int tt = (G_) * 4 + i8; \
                bf16_t* zr = zt + (size_t)tt * DIN; \
                float xs[4]; \
                _Pragma("unroll") for (int s_ = 0; s_ < 4; ++s_) { \
                    const float nx = bf2f(nA[B_][i8][s_]); \
                    xs[s_] = cu[s_] + s0[s_] * (pv[s_] - cu[s_]) + s1[s_] * (nx - cu[s_]); \
                    pv[s_] = cu[s_]; cu[s_] = nx; \
                } \
                const size_t o = (mbase + tt) * 256 + tid; \
                const float kkv = xs[1] * kkw; \
                const float ss = wave_sum(kkv * kkv); \
                ws_sR(p)[o] = f2bf(xs[0]); ws_sK(p)[o] = f2bf(xs[1]); ws_sV(p)[o] = f2bf(xs[2]); ws_sKK(p)[o] = f2bf(kkv * rsqrtf(fmaxf(ss, 1e-24f))); \
                if (tid < 64) wl_s[tt * LLD + tid] = f2bf(1.f - 2.f / (1.f + __expf(2.f * xs[3]))); \
                else if (tid < 128) al_s[tt * LLD + tid - 64] = f2bf(xs[3]); \
                const float xp1 = bf2f(nC[B_][i8]); \
                xc_s[tt * XLD + tid] = f2bf(cb + cw[0] * xm2 + cw[1] * xm1 + cw[2] * x0 + cw[3] * xp1); \
                xm2 = xm1; xm1 = x0; x0 = xp1; \
                const float q = bf2f(qB[B_][i8]); \
                const float s2 = wave_sum(q * q); \
                const float qn = ropeT(cs8[B_][i8], q * rsqrtf(s2 * (1.f / 64.f) + 1e-6f) * qnw, lane) * (0.125f * 1.4426950408889634f); \
                if (!dry) zr[OFF_B + tid] = f2bf(qn); \
                if (c3) { \
                    const float kx = bf2f(kB[B_][i8]); \
                    const float s3 = wave_sum(kx * kx); \
                    const float kro = ropeT(cs8[B_][i8], kx * rsqrtf(s3 * (1.f / 64.f) + 1e-6f) * knw, lane); \
                    if (!dry) zr[OFF_B + 256 + tid] = f2bf(kro); \
                } \
            } }
        PREP_LOADG(0, 0)
#pragma unroll 1
        for (int g = 0; g < 8; g += 2) {
            PREP_LOADG(1, g + 1)
            PREP_COMPG(0, g)
            if (g + 2 < 8) PREP_LOADG(0, g + 2)
            PREP_COMPG(1, g + 1)
        }
#undef PREP_LOADG
#undef PREP_COMPG
    }
    __syncthreads();
#pragma unroll 1
    for (int dm = 0; dm < 4; ++dm) {
        const int d = dm >> 1, mat = dm & 1;
        const bf16_t* Bt = (mat ? ws_aup_t(p) : ws_wup_t(p)) + ((size_t)(l * 2 + d) * 256 + 64 * w) * 64;
        bf16x8 bfr[4][2];
#pragma unroll
        for (int nt = 0; nt < 4; ++nt)
#pragma unroll
            for (int ks = 0; ks < 2; ++ks) bfr[nt][ks] = *(const bf16x8*)(Bt + (16 * nt + fr) * 64 + 32 * ks + 8 * fq);
        const bf16_t* As = mat ? al_s : wl_s;
        const float* bias = (mat ? p.rwkv_a0 : p.rwkv_w0) + (l * 2 + d) * 256 + 64 * w + 4 * fq;
        bf16_t* dst = (mat ? ws_sA0(p) : ws_sW0(p)) + d * SA_EL + mbase * 256 + 64 * w + 4 * fq;
#pragma unroll 1
        for (int m = 0; m < 2; ++m) {
            bf16x8 af[2];
#pragma unroll
            for (int ks = 0; ks < 2; ++ks) af[ks] = *(const bf16x8*)(As + (16 * m + fr) * LLD + 32 * ks + 8 * fq);
#pragma unroll
            for (int nt = 0; nt < 4; ++nt) {
                f32x4 acc = (f32x4){0.f, 0.f, 0.f, 0.f};
#pragma unroll
                for (int ks = 0; ks < 2; ++ks) acc = __builtin_amdgcn_mfma_f32_16x16x32_bf16(bfr[nt][ks], af[ks], acc, 0, 0, 0);
                const f32x4 bv = *(const f32x4*)(bias + 16 * nt);
                float ov[4];
#pragma unroll
                for (int jj = 0; jj < 4; ++jj) {
                    const float sg = sigm(acc[jj] + bv[jj]);
                    ov[jj] = mat ? sg : 1.f - __expf(-0.6065306597126334f * sg);
                }
                u32x2 o2; o2[0] = pk2(ov[0], ov[1]); o2[1] = pk2(ov[2], ov[3]);
                *(u32x2*)(dst + (size_t)(16 * m + fr) * 256 + 16 * nt) = o2;
            }
        }
    }
#pragma unroll 1
    for (int d = 0; d < 2; ++d) {
        bf16x8 bfr[2][4][2];
#pragma unroll
        for (int k = 0; k < 2; ++k)
#pragma unroll
            for (int nt = 0; nt < 4; ++nt)
#pragma unroll
                for (int ks = 0; ks < 2; ++ks)
                    bfr[k][nt][ks] = *(const bf16x8*)(ws_gw_t(p) + ((size_t)(((l * 2 + d) * 2 + k) * 4 + w) * 64 + 16 * nt + fr) * 64 + 32 * ks + 8 * fq);
        const int e00 = 64 * w + 4 * fq;
#pragma unroll 1
        for (int m = 0; m < 2; ++m) {
            bf16x8 af[2];
#pragma unroll
            for (int ks = 0; ks < 2; ++ks) af[ks] = *(const bf16x8*)(xc_s + (16 * m + fr) * XLD + 64 * w + 32 * ks + 8 * fq);
#pragma unroll
            for (int nt = 0; nt < 4; ++nt) {
                f32x4 g0 = (f32x4){0.f, 0.f, 0.f, 0.f}, g1 = g0;
#pragma unroll
                for (int ks = 0; ks < 2; ++ks) {
                    g0 = __builtin_amdgcn_mfma_f32_16x16x32_bf16(bfr[0][nt][ks], af[ks], g0, 0, 0, 0);
                    g1 = __builtin_amdgcn_mfma_f32_16x16x32_bf16(bfr[1][nt][ks], af[ks], g1, 0, 0, 0);
                }
                const int e0 = e00 + 16 * nt;
                const f32x4 gb0 = *(const f32x4*)(p.lru_gate_b + ((l * 2 + d) * 2 + 0) * 256 + e0), gb1 = *(const f32x4*)(p.lru_gate_b + ((l * 2 + d) * 2 + 1) * 256 + e0);
                const f32x4 lam = *(const f32x4*)(p.lru_lambda + (l * 2 + d) * 256 + e0);
                const u32x2 xu = *(const u32x2*)(xc_s + (16 * m + fr) * XLD + e0);
                const float xv[4] = {__uint_as_float(xu[0] << 16), __uint_as_float(xu[0] & 0xffff0000u), __uint_as_float(xu[1] << 16), __uint_as_float(xu[1] & 0xffff0000u)};
                float a1[4], bt[4];
#pragma unroll
                for (int jj = 0; jj < 4; ++jj) {
                    const float r = sigm(g0[jj] + gb0[jj]), ig = sigm(g1[jj] + gb1[jj]);
                    const float sp = __logf(1.f + __expf(-lam[jj]));
                    const float a = __expf(-8.f * r * sp);
                    a1[jj] = 1.f - a;
                    bt[jj] = sqrtf(a1[jj] * (1.f + a)) * ig * xv[jj];
                }
                const size_t o = d * SA_EL + (mbase + 16 * m + fr) * 256 + e0;
                u32x2 oa; oa[0] = pk2(a1[0], a1[1]); oa[1] = pk2(a1[2], a1[3]);
                u32x2 ob; ob[0] = pk2(bt[0], bt[1]); ob[1] = pk2(bt[2], bt[3]);
                *(u32x2*)(ws_la(p) + o) = oa; *(u32x2*)(ws_h0(p) + o) = ob;
            }
        }
    }
}

DEVI f2 fma2(f2 a, f2 b, f2 c) { return __builtin_elementwise_fma(a, b, c); }
DEVI void ph_rwkv_scan(const Params& p, int l, int item, char* smem, bool dry = false) {
    const int wv = __builtin_amdgcn_readfirstlane(tidx() >> 6), lane = tidx() & 63;
    const int wi = item * 4 + wv;
    const int scan = wi / 3, part = wi - scan * 3;
    const int b = scan >> 3, h = (scan >> 1) & 3, d = scan & 1;
    const int c8 = lane & 7, r8 = lane >> 3;
    float* ring = (float*)smem + wv * 1280;
    const char* A = (const char*)(ws_sA0(p) + d * SA_EL);
    const char* Wm = (const char*)(ws_sW0(p) + d * SA_EL);
    const char *R = (const char*)ws_sR(p), *K = (const char*)ws_sK(p), *V = (const char*)ws_sV(p), *KK = (const char*)ws_sKK(p);
    char* Y = (char*)(ws_z(p) + 256 + 256 * d + h * 64);
#define LDB(base, bo) (*(const bf16_t*)((base) + (bo)))
    const float ka = p.rwkv_k_a[l * 256 + h * 64 + lane];
    f2 S[3][4];
#pragma unroll
    for (int pp = 0; pp < 3; ++pp)
#pragma unroll
        for (int k = 0; k < 4; ++k) S[pp][k] = (f2){0.f, 0.f};
    const unsigned t00 = (unsigned)(b * T_ + (d ? T_ - 1 : 0)) * 256u + h * 64;
    const unsigned o0 = (t00 + lane) * 2u;
    int rowp[3]; unsigned ov[3];
#pragma unroll
    for (int pp = 0; pp < 3; ++pp) { rowp[pp] = 24 * part + 8 * pp + r8; ov[pp] = (t00 + (rowp[pp] < 64 ? rowp[pp] : 63)) * 2u; }
    const int stp = d ? -512 : 512;
    const int myp = c8 < 3 ? c8 : 0;
    const int myrow = 24 * part + 8 * myp + r8;
    const bool ystore = c8 < 3 && myrow < 64 && !dry;
    const unsigned yrow_b = (unsigned)myrow * 2u;
    float vcur[3], vnx[3];
#pragma unroll
    for (int s_ = 0; s_ < 2; ++s_) {
        const unsigned o = o0 + s_ * stp;
        const float r = bf2f(LDB(R, o)), k = bf2f(LDB(K, o)), kk = bf2f(LDB(KK, o)), a = bf2f(LDB(A, o)), w = 1.f - bf2f(LDB(Wm, o));
#pragma unroll
        for (int pp = 0; pp < 3; ++pp) { const float vv = bf2f(LDB(V, ov[pp] + s_ * stp)); if (s_ == 0) vcur[pp] = vv; else vnx[pp] = vv; }
        float* sl = ring + s_ * 320;
        sl[0 * 64 + lane] = w; sl[1 * 64 + lane] = kk * a; sl[2 * 64 + lane] = k * (1.f + (a - 1.f) * ka); sl[3 * 64 + lane] = r; sl[4 * 64 + lane] = kk;
    }
    bf16_t rr[8], rk[8], rkk[8], ra[8], rw[8], rv[8][3];
#pragma unroll
    for (int i = 0; i < 8; ++i) {
        const int st = (i < 2 ? 8 + i : i) * stp;
        rr[i] = LDB(R, o0 + st); rk[i] = LDB(K, o0 + st); rkk[i] = LDB(KK, o0 + st); ra[i] = LDB(A, o0 + st); rw[i] = LDB(Wm, o0 + st);
#pragma unroll
        for (int pp = 0; pp < 3; ++pp) rv[i][pp] = LDB(V, ov[pp] + st);
    }
    __builtin_amdgcn_wave_barrier();
    f32x4 OB[2][5][2];
#define RW_LDO(set, slw, slk) { _Pragma("unroll") for (int g = 0; g < 2; ++g) { \
        OB[set][0][g] = *(const f32x4*)((slw) + 0 * 64 + 8 * c8 + 4 * g); OB[set][1][g] = *(const f32x4*)((slw) + 1 * 64 + 8 * c8 + 4 * g); \
        OB[set][2][g] = *(const f32x4*)((slw) + 2 * 64 + 8 * c8 + 4 * g); OB[set][3][g] = *(const f32x4*)((slw) + 3 * 64 + 8 * c8 + 4 * g); \
        OB[set][4][g] = *(const f32x4*)((slk) + 4 * 64 + 8 * c8 + 4 * g); } }
    RW_LDO(0, ring, ring + 320)
    float sktot[3] = {0.f, 0.f, 0.f};
    __builtin_amdgcn_s_setprio(3);
    for (int sb = 0; sb < T_; sb += 8) {
#pragma unroll
        for (int i = 0; i < 8; ++i) {
            const int step = sb + i;
            const int slot = (i + 2) & 7;
            float v2n[3];
            {
                float* sn = ring + ((i + 2) & 3) * 320;
                const float r1 = bf2f(rr[slot]), k1 = bf2f(rk[slot]), kk1 = bf2f(rkk[slot]), a1 = bf2f(ra[slot]), w1 = 1.f - bf2f(rw[slot]);
                sn[0 * 64 + lane] = w1; sn[1 * 64 + lane] = kk1 * a1; sn[2 * 64 + lane] = k1 * (1.f + (a1 - 1.f) * ka); sn[3 * 64 + lane] = r1; sn[4 * 64 + lane] = kk1;
#pragma unroll
                for (int pp = 0; pp < 3; ++pp) v2n[pp] = bf2f(rv[slot][pp]);
            }
            {
                const int s10 = (step + 10 < T_ ? step + 10 : T_ - 1) * stp;
                const unsigned oc = o0 + s10;
                rr[slot] = LDB(R, oc); rk[slot] = LDB(K, oc); rkk[slot] = LDB(KK, oc); ra[slot] = LDB(A, oc); rw[slot] = LDB(Wm, oc);
#pragma unroll
                for (int pp = 0; pp < 3; ++pp) rv[slot][pp] = LDB(V, ov[pp] + s10);
            }
            __builtin_amdgcn_wave_barrier();
            RW_LDO((i + 1) & 1, ring + ((i + 1) & 3) * 320, ring + ((i + 2) & 3) * 320)
            const unsigned tok_b = (unsigned)(b * T_ + (d ? T_ - 1 - step : step)) * (unsigned)(DIN * 2);
            float pyv[3];
#pragma unroll
            for (int pp = 0; pp < 3; ++pp) {
                const f2 nsk2 = (f2){-sktot[pp], -sktot[pp]}, v2 = (f2){vcur[pp], vcur[pp]};
                f2 y2 = (f2){0.f, 0.f}, sk2 = (f2){0.f, 0.f};
#pragma unroll
                for (int g = 0; g < 2; ++g) {
                    const f32x4 w4 = OB[i & 1][0][g], b4 = OB[i & 1][1][g], kd4 = OB[i & 1][2][g], r4 = OB[i & 1][3][g], kn4 = OB[i & 1][4][g];
                    f2 t0 = v2 * kd4.xy; t0 = fma2(nsk2, b4.xy, t0);
                    S[pp][2 * g] = fma2(S[pp][2 * g], w4.xy, t0);
                    y2 = fma2(S[pp][2 * g], r4.xy, y2); sk2 = fma2(S[pp][2 * g], kn4.xy, sk2);
                    f2 t1 = v2 * kd4.zw; t1 = fma2(nsk2, b4.zw, t1);
                    S[pp][2 * g + 1] = fma2(S[pp][2 * g + 1], w4.zw, t1);
                    y2 = fma2(S[pp][2 * g + 1], r4.zw, y2); sk2 = fma2(S[pp][2 * g + 1], kn4.zw, sk2);
                }
                float ps = sk2.x + sk2.y, py = y2.x + y2.y;
                ps += dppx<0xB1>(ps); py += dppx<0xB1>(py);
                ps += dppx<0x4E>(ps); py += dppx<0x4E>(py);
                ps += dppx<0x141>(ps); py += dppx<0x141>(py);
                sktot[pp] = ps; pyv[pp] = py;
                vcur[pp] = vnx[pp]; vnx[pp] = v2n[pp];
            }
            {
                const float ysel = c8 == 0 ? pyv[0] : c8 == 1 ? pyv[1] : pyv[2];
                if (ystore) *(bf16_t*)(Y + (tok_b + yrow_b)) = f2bf(ysel);
            }
        }
    }
    __builtin_amdgcn_s_setprio(0);
#undef RW_LDO
#undef LDB
}

DEVI void ph_lru_scan(const Params& p, int l, int item, bool dry = false) {
    const int lane = tidx() & 63, idx = item * 4 + (tidx() >> 6);
    const int b = idx >> 3, n = (idx >> 1) & 3, d = idx & 1;
    const bf16_t* A = ws_la(p) + d * SA_EL + (size_t)b * T_ * 256 + n * 64 + lane;
    bf16_t* H = ws_h0(p) + d * SA_EL + (size_t)b * T_ * 256 + n * 64 + lane;
    float h = 0.f;
    for (int s0 = 0; s0 < T_; s0 += 32) {
        bf16_t av[32], bv[32];
#pragma unroll
        for (int i = 0; i < 32; ++i) { const int t = d ? T_ - 1 - (s0 + i) : s0 + i; av[i] = A[(size_t)t * 256]; bv[i] = H[(size_t)t * 256]; }
#pragma unroll
        for (int i = 0; i < 32; ++i) {
            const int t = d ? T_ - 1 - (s0 + i) : s0 + i;
            h = (1.f - bf2f(av[i])) * h + bf2f(bv[i]);
            if (!dry) H[(size_t)t * 256] = f2bf(h);
        }
    }
}

DEVI void ph_post_all(const Params& p, int l, int bid, int G) {
    const int j = tidx();
    const float lg = p.rwkv_ln_g[l * 256 + j], lb = p.rwkv_ln_b[l * 256 + j], ka = p.rwkv_k_a[l * 256 + j], rk_ = p.rwkv_r_k[l * 256 + j];
    constexpr int NIT = NTOK / 8;
    if (bid >= NIT) return;
    const int ng = (NIT - bid + G - 1) / G;
    bf16_t yf[2][8], yr[2][8], r_[2][8], k_[2][8], v_[2][8], af[2][8], ar[2][8], ga[2][8], hf[2][8], hr[2][8], gc[2][8];
#define POST_LOAD(B_, GI_) { \
        _Pragma("unroll") for (int i = 0; i < 8; ++i) { \
            const int m = (bid + (GI_) * G) * 8 + i; \
            const size_t o = (size_t)m * 256 + j; \
            const bf16_t* zr = ws_z(p) + (size_t)m * DIN; \
            yf[B_][i] = zr[256 + j]; yr[B_][i] = zr[512 + j]; r_[B_][i] = ws_sR(p)[o]; k_[B_][i] = ws_sK(p)[o]; v_[B_][i] = ws_sV(p)[o]; \
            af[B_][i] = ws_sA0(p)[o]; ar[B_][i] = ws_sA0(p)[o + SA_EL]; ga[B_][i] = zr[OFF_A + 896 + j]; \
            hf[B_][i] = ws_h0(p)[o]; hr[B_][i] = ws_h0(p)[o + SA_EL]; gc[B_][i] = zr[OFF_C + 256 + j]; \
        } }
#define POST_COMP(B_, GI_) { \
        _Pragma("unroll") for (int i = 0; i < 8; ++i) { \
            const int m = (bid + (GI_) * G) * 8 + i; \
            bf16_t* zr = ws_z(p) + (size_t)m * DIN; \
            const float y = bf2f(yf[B_][i]) + bf2f(yr[B_][i]); \
            const float mu = wave_sum(y) * (1.f / 64.f); \
            const float dv = y - mu; \
            const float var = wave_sum(dv * dv) * (1.f / 64.f); \
            const float yn = dv * rsqrtf(var + 64e-5f) * lg + lb; \
            const float r = bf2f(r_[B_][i]), k = bf2f(k_[B_][i]), v = bf2f(v_[B_][i]), a_f = bf2f(af[B_][i]), a_r = bf2f(ar[B_][i]); \
            const float ksum = k * (1.f + (a_f - 1.f) * ka) + k * (1.f + (a_r - 1.f) * ka); \
            const float bon = wave_sum(r * ksum * rk_) * v; \
            const float g = bf2f(ga[B_][i]); \
            zr[OFF_A + j] = f2bf((yn + bon) * g * sigm(g)); \
            const float h = bf2f(hf[B_][i]) + bf2f(hr[B_][i]); \
            const float g2 = bf2f(gc[B_][i]); \
            zr[OFF_C + j] = f2bf(h * g2 * sigm(g2)); \
        } }
    POST_LOAD(0, 0)
#pragma unroll 1
    for (int gi = 0; gi < ng; gi += 2) {
        if (gi + 1 < ng) POST_LOAD(1, gi + 1)
        POST_COMP(0, gi)
        if (gi + 2 < ng) POST_LOAD(0, gi + 2)
        if (gi + 1 < ng) POST_COMP(1, gi + 1)
    }
#undef POST_LOAD
#undef POST_COMP
}

template <int WIN>
DEVI void ph_attn_naive(const Params& p, int l, int item) {
    const int lane = tidx() & 63, idx = item * 4 + (tidx() >> 6);
    const int qb = idx & 31, hq = (idx >> 5) & 3, b = idx >> 7;
    const int g = hq >> 1;
    constexpr int OFF = WIN ? OFF_D : OFF_B;
    const int t0 = qb * 64, t = t0 + lane;
    bf16_t* zq = ws_z(p) + ((size_t)b * T_ + t) * DIN + OFF + hq * 64;
    float q[64], o[64];
#pragma unroll
    for (int c = 0; c < 8; ++c) {
        const uint4 u = *(const uint4*)(zq + c * 8);
        const unsigned uu[4] = {u.x, u.y, u.z, u.w};
#pragma unroll
        for (int e = 0; e < 4; ++e) { q[c * 8 + 2 * e] = __uint_as_float(uu[e] << 16); q[c * 8 + 2 * e + 1] = __uint_as_float(uu[e] & 0xffff0000u); }
    }
#pragma unroll
    for (int dd = 0; dd < 64; ++dd) o[dd] = 0.f;
    float mx, ls;
    float slope = 0.f;
    if (WIN) { mx = p.swa_sink[l * 4 + hq]; ls = 1.f; slope = exp2f(-8.f * (float)(hq + 1) / 4.f); }
    else { mx = -1e30f; ls = 0.f; }
    const int s0 = WIN ? max(0, t0 - 128) : 0, s1 = WIN ? min(T_ - 1, t0 + 63 + 128) : T_ - 1;
    const bf16_t* kb = ws_z(p) + (size_t)b * T_ * DIN + OFF + 256 + g * 64;
    for (int s = s0; s <= s1; ++s) {
        const bf16_t* kr = kb + (size_t)s * DIN;
        float sc = 0.f;
#pragma unroll
        for (int c = 0; c < 8; ++c) {
            const uint4 u = *(const uint4*)(kr + c * 8);
            const unsigned uu[4] = {u.x, u.y, u.z, u.w};
#pragma unroll
            for (int e = 0; e < 4; ++e) { sc += q[c * 8 + 2 * e] * __uint_as_float(uu[e] << 16); sc += q[c * 8 + 2 * e + 1] * __uint_as_float(uu[e] & 0xffff0000u); }
        }
        bool valid = true;
        if (WIN) { const int dist = abs(t - s); valid = dist <= 128; sc = sc * 0.125f - slope * (float)dist; }
        const float mn = valid ? fmaxf(mx, sc) : mx;
        const float al = __expf(mx - mn);
        const float pp = valid ? __expf(sc - mn) : 0.f;
        mx = mn; ls = ls * al + pp;
#pragma unroll
        for (int c = 0; c < 8; ++c) {
            const uint4 u = *(const uint4*)(kr + 128 + c * 8);
            const unsigned uu[4] = {u.x, u.y, u.z, u.w};
#pragma unroll
            for (int e = 0; e < 4; ++e) {
                o[c * 8 + 2 * e] = o[c * 8 + 2 * e] * al + pp * __uint_as_float(uu[e] << 16);
                o[c * 8 + 2 * e + 1] = o[c * 8 + 2 * e + 1] * al + pp * __uint_as_float(uu[e] & 0xffff0000u);
            }
        }
    }
    const float il = 1.f / ls;
    const bf16_t* zg = zq - hq * 64 + 512 + hq * 64;
#pragma unroll
    for (int c = 0; c < 8; ++c) {
        const uint4 u = *(const uint4*)(zg + c * 8);
        const unsigned uu[4] = {u.x, u.y, u.z, u.w};
        unsigned ov[4];
#pragma unroll
        for (int e = 0; e < 4; ++e) {
            const float g0 = __uint_as_float(uu[e] << 16), g1 = __uint_as_float(uu[e] & 0xffff0000u);
            ov[e] = pk2(o[c * 8 + 2 * e] * il * g0 * sigm(g0), o[c * 8 + 2 * e + 1] * il * g1 * sigm(g1));
        }
        *(uint4*)(zq + c * 8) = make_uint4(ov[0], ov[1], ov[2], ov[3]);
    }
}

constexpr int ALD = 72;
template <int WIN>
DEVI void ph_attn(const Params& p, int l, int item, char* smem, bool dry = false) {
    constexpr int OFF = WIN ? OFF_D : OFF_B;
    const int qb = item & 15, hq = (item >> 4) & 3, b = item >> 6, g = hq >> 1;
    const int tid = tidx(), w = tid >> 6, lane = tid & 63, fr = lane & 15, fq = lane >> 4;
    const int t0 = qb * 128, tw = t0 + 32 * w;
    bf16_t* Ks = (bf16_t*)smem;
    bf16_t* Vt = Ks + 2 * 64 * ALD;
    bf16_t* zb = ws_z(p) + (size_t)b * T_ * DIN;
    bf16x8 qf[2][2];
#pragma unroll
    for (int n = 0; n < 2; ++n)
#pragma unroll
        for (int ks = 0; ks < 2; ++ks) {
            u32x4 u = *(const u32x4*)(zb + (size_t)(tw + 16 * n + fr) * DIN + OFF + hq * 64 + 32 * ks + 8 * fq);
            if (WIN) {
                constexpr float sc = 0.125f * 1.4426950408889634f;
#pragma unroll
                for (int e = 0; e < 4; ++e) u[e] = pk2(__uint_as_float(u[e] << 16) * sc, __uint_as_float(u[e] & 0xffff0000u) * sc);
            }
            qf[n][ks] = __builtin_bit_cast(bf16x8, u);
        }
    const int kt0 = WIN ? max(0, t0 - 128) / 64 : 0, kt1 = WIN ? min(T_, t0 + 256) / 64 : T_ / 64;
    f32x4 ot[4][2];
#pragma unroll
    for (int dm = 0; dm < 4; ++dm)
#pragma unroll
        for (int n = 0; n < 2; ++n) ot[dm][n] = (f32x4){0.f, 0.f, 0.f, 0.f};
    float mrun[2], lrun[2];
    float slope2 = 0.f;
    if (WIN) {
        const float sk = p.swa_sink[l * 4 + hq] * 1.4426950408889634f;
        mrun[0] = mrun[1] = sk; lrun[0] = lrun[1] = fq == 0 ? 1.f : 0.f;
        slope2 = exp2f(-2.f * (float)(hq + 1)) * 1.4426950408889634f;
    } else { mrun[0] = mrun[1] = -1e30f; lrun[0] = lrun[1] = 0.f; }
    const bf16_t* kbase = zb + OFF + 256 + g * 64;
    const bf16_t* vbase = zb + OFF + 384 + g * 64;
    u32x4 rk[2], rv[2];
    const int kkey = tid >> 2, kc = tid & 3, vkey = tid & 63, vc = tid >> 6;
    auto gload = [&](int kt) __attribute__((always_inline)) {
        const bf16_t* kp = kbase + (size_t)(kt * 64 + kkey) * DIN + kc * 16;
        rk[0] = *(const u32x4*)kp; rk[1] = *(const u32x4*)(kp + 8);
        const bf16_t* vp = vbase + (size_t)(kt * 64 + vkey) * DIN + vc * 16;
        rv[0] = *(const u32x4*)vp; rv[1] = *(const u32x4*)(vp + 8);
    };
    auto swrite = [&](int buf) __attribute__((always_inline)) {
        bf16_t* kd = Ks + (buf * 64 + kkey) * ALD + kc * 16;
        *(u32x4*)kd = rk[0]; *(u32x4*)(kd + 8) = rk[1];
        bf16_t* vd = Vt + (buf * 64 + vc * 16) * ALD + vkey;
#pragma unroll
        for (int h = 0; h < 2; ++h)
#pragma unroll
            for (int e = 0; e < 4; ++e) {
                vd[(h * 8 + 2 * e) * ALD] = (bf16_t)(rv[h][e] & 0xffffu);
                vd[(h * 8 + 2 * e + 1) * ALD] = (bf16_t)(rv[h][e] >> 16);
            }
    };
    __syncthreads();
    gload(kt0); swrite(0);
    __syncthreads();
    for (int kt = kt0; kt < kt1; ++kt) {
        const int buf = (kt - kt0) & 1;
        if (kt + 1 < kt1) gload(kt + 1);
        f32x4 st[4][2];
#pragma unroll
        for (int m = 0; m < 4; ++m)
#pragma unroll
            for (int n = 0; n < 2; ++n) st[m][n] = (f32x4){0.f, 0.f, 0.f, 0.f};
#pragma unroll
        for (int ks = 0; ks < 2; ++ks)
#pragma unroll
            for (int m = 0; m < 4; ++m) {
                const bf16x8 kf = *(const bf16x8*)(Ks + (buf * 64 + 16 * m + fr) * ALD + 32 * ks + 8 * fq);
#pragma unroll
                for (int n = 0; n < 2; ++n) st[m][n] = __builtin_amdgcn_mfma_f32_16x16x32_bf16(kf, qf[n][ks], st[m][n], 0, 0, 0);
            }
        if (WIN) {
#pragma unroll
            for (int m = 0; m < 4; ++m)
#pragma unroll
                for (int n = 0; n < 2; ++n)
#pragma unroll
                    for (int j = 0; j < 4; ++j) {
                        const int dist = abs((tw + 16 * n + fr) - (kt * 64 + 16 * m + 4 * fq + j));
                        st[m][n][j] = dist <= 128 ? st[m][n][j] - slope2 * (float)dist : -1e30f;
                    }
        }
#pragma unroll
        for (int n = 0; n < 2; ++n) {
            float mt = st[0][n][0];
#pragma unroll
            for (int m = 0; m < 4; ++m)
#pragma unroll
                for (int j = 0; j < 4; ++j) mt = fmaxf(mt, st[m][n][j]);
            mt = fmaxf(mt, __shfl_xor(mt, 16)); mt = fmaxf(mt, __shfl_xor(mt, 32));
            const float mn = fmaxf(mrun[n], mt);
            const float alpha = __builtin_amdgcn_exp2f(mrun[n] - mn);
            mrun[n] = mn;
            float lsum = 0.f;
#pragma unroll
            for (int m = 0; m < 4; ++m)
#pragma unroll
                for (int j = 0; j < 4; ++j) { const float pv = __builtin_amdgcn_exp2f(st[m][n][j] - mn); lsum += pv; st[m][n][j] = pv; }
            lrun[n] = lrun[n] * alpha + lsum;
#pragma unroll
            for (int dm = 0; dm < 4; ++dm) ot[dm][n] = ot[dm][n] * alpha;
        }
#pragma unroll
        for (int kk = 0; kk < 2; ++kk) {
            bf16x8 pf[2];
#pragma unroll
            for (int n = 0; n < 2; ++n) {
                u32x4 u;
                u[0] = pk2(st[2 * kk][n][0], st[2 * kk][n][1]); u[1] = pk2(st[2 * kk][n][2], st[2 * kk][n][3]);
                u[2] = pk2(st[2 * kk + 1][n][0], st[2 * kk + 1][n][1]); u[3] = pk2(st[2 * kk + 1][n][2], st[2 * kk + 1][n][3]);
                pf[n] = __builtin_bit_cast(bf16x8, u);
            }
#pragma unroll
            for (int dm = 0; dm < 4; ++dm) {
                const bf16_t* vp = Vt + (buf * 64 + 16 * dm + fr) * ALD + 32 * kk + 4 * fq;
                const u32x2 v0 = *(const u32x2*)vp, v1 = *(const u32x2*)(vp + 16);
                const bf16x8 vf = __builtin_bit_cast(bf16x8, (u32x4){v0[0], v0[1], v1[0], v1[1]});
#pragma unroll
                for (int n = 0; n < 2; ++n) ot[dm][n] = __builtin_amdgcn_mfma_f32_16x16x32_bf16(vf, pf[n], ot[dm][n], 0, 0, 0);
            }
        }
        if (kt + 1 < kt1) swrite(buf ^ 1);
        __syncthreads();
    }
#pragma unroll
    for (int n = 0; n < 2; ++n) {
        float lt = lrun[n];
        lt += __shfl_xor(lt, 16); lt += __shfl_xor(lt, 32);
        const float il = 1.f / lt;
        bf16_t* zr = zb + (size_t)(tw + 16 * n + fr) * DIN + OFF + hq * 64 + 4 * fq;
#pragma unroll
        for (int dm = 0; dm < 4; ++dm) {
            const u32x2 gu = *(const u32x2*)(zr + 512 + 16 * dm);
            float gv[4] = {__uint_as_float(gu[0] << 16), __uint_as_float(gu[0] & 0xffff0000u), __uint_as_float(gu[1] << 16), __uint_as_float(gu[1] & 0xffff0000u)};
            float ov[4];
#pragma unroll
            for (int j = 0; j < 4; ++j) ov[j] = ot[dm][n][j] * il * gv[j] * sigm(gv[j]);
            u32x2 o2; o2[0] = pk2(ov[0], ov[1]); o2[1] = pk2(ov[2], ov[3]);
            if (!dry) *(u32x2*)(zr + 16 * dm) = o2;
        }
    }
}

DEVI void gbar(unsigned* ctr, unsigned target) {
    asm volatile("s_waitcnt vmcnt(0)" ::: "memory");
    __syncthreads();
    if (threadIdx.x == 0) {
        __builtin_amdgcn_fence(__ATOMIC_RELEASE, "agent");
        asm volatile("s_waitcnt vmcnt(0)" ::: "memory");
        (void)__hip_atomic_fetch_add(ctr, 1u, __ATOMIC_RELAXED, __HIP_MEMORY_SCOPE_AGENT);
        while (__hip_atomic_load(ctr, __ATOMIC_RELAXED, __HIP_MEMORY_SCOPE_AGENT) < target) __builtin_amdgcn_s_sleep(1);
        __builtin_amdgcn_fence(__ATOMIC_ACQUIRE, "agent");
        asm volatile("s_waitcnt vmcnt(0)" ::: "memory");
    }
    __syncthreads();
}

enum { PH_CONVW, PH_ROWNORM, PH_GEMM1, PH_PREP, PH_RWKV, PH_LRU, PH_ATTNB, PH_ATTND, PH_POST, PH_GEMM2, PH_FINAL };
#ifndef MK_MULTI
#define MK_MULTI 0
#endif
#ifndef PROBE_PREP
#define PROBE_PREP 0
#endif
#ifndef PROBE_MIX
#define PROBE_MIX 0
#endif
#ifndef PROBE_G2
#define PROBE_G2 0
#endif
#if MK_MULTI
template <int PH>
__global__ void __launch_bounds__(256) kph(Params p, int l, int nitems) {
    extern __shared__ __attribute__((aligned(16))) char smem[];
    for (int item = blockIdx.x; item < nitems; item += gridDim.x) {
        if (PH == PH_CONVW) ph_convw(p, item, smem);
        if (PH == PH_ROWNORM) ph_rownorm(p, l, item);
        if (PH == PH_GEMM1) { if (item == (int)blockIdx.x) ph_gemm_all<0>(p, l, blockIdx.x, gridDim.x, smem); }
        if (PH == PH_PREP) ph_prep(p, l, item, smem);
        if (PH == PH_RWKV) ph_rwkv_scan(p, l, item, smem);
        if (PH == PH_LRU) ph_lru_scan(p, l, item);
        if (PH == PH_ATTNB) ph_attn_naive<0>(p, l, item);
        if (PH == PH_ATTND) ph_attn_naive<1>(p, l, item);
        if (PH == PH_POST) { if (item == (int)blockIdx.x) ph_post_all(p, l, blockIdx.x, gridDim.x); }
        if (PH == PH_GEMM2) { if (item == (int)blockIdx.x) ph_gemm_all<1>(p, l, blockIdx.x, gridDim.x, smem); }
        if (PH == PH_FINAL) ph_final(p, item);
    }
}
template <int PH>
static void launch(const Params& p, int l, int nitems, int lds, hipStream_t stream) {
    if (lds > 48 * 1024) (void)hipFuncSetAttribute((const void*)kph<PH>, hipFuncAttributeMaxDynamicSharedMemorySize, lds);
    int grid = nitems < 65536 ? nitems : 65536;
    hipLaunchKernelGGL(kph<PH>, dim3(grid), dim3(256), lds, stream, p, l, nitems);
}
#else
constexpr int MIX_ITEMS = 80 + 2560 + 2560;
__global__ void __launch_bounds__(256, 2) mega(Params p) {
    extern __shared__ __attribute__((aligned(16))) char smem[];
    __shared__ int s_item;
    cg::grid_group grid = cg::this_grid();
    const int G = gridDim.x, bid = blockIdx.x;
    unsigned nbar = 0;
    if (bid == 0 && threadIdx.x < 64) ws_ctr(p)[threadIdx.x] = 0;
    for (int it = bid; it < CW_ITEMS; it += G) ph_convw(p, it, smem);
    grid.sync();
    for (int l = 0; l < NL; ++l) {
        if (l == 0) {
            for (int it = bid; it < NTOK / 4; it += G) ph_rownorm(p, l, it);
            gbar(ws_gbar(p), (nbar += (unsigned)G));
        }
        ph_gemm_all<0>(p, l, bid, G, smem);
        gbar(ws_gbar(p), (nbar += (unsigned)G));
#if PROBE_PREP
        for (int it = bid; it < NTOK / 32; it += G) ph_prep(p, l, it, smem, true);
#endif
        for (int it = bid; it < NTOK / 32; it += G) ph_prep(p, l, it, smem);
        gbar(ws_gbar(p), (nbar += (unsigned)G));
#if PROBE_MIX
        for (int rep = 0; rep < 2; ++rep) {
        const bool dry = rep == 0;
        int* ctrp = &ws_ctr(p)[l + 4 * rep];
#else
        {
        const bool dry = false;
        int* ctrp = &ws_ctr(p)[l];
#endif
        for (int it = bid; it < 240; it += G) ph_rwkv_scan(p, l, it, smem, dry);
        for (;;) {
            __syncthreads();
            if (threadIdx.x == 0) s_item = atomicAdd(ctrp, 1);
            __syncthreads();
            const int it = s_item;
            if (it >= MIX_ITEMS) break;
            if (it < 80) ph_lru_scan(p, l, it, dry);
            else if (it < 2640) ph_attn<0>(p, l, it - 80, smem, dry);
            else ph_attn<1>(p, l, it - 2640, smem, dry);
        }
        }
        gbar(ws_gbar(p), (nbar += (unsigned)G));
        ph_post_all(p, l, bid, G);
        gbar(ws_gbar(p), (nbar += (unsigned)G));
#if PROBE_G2
        ph_gemm_all<1>(p, l, bid, G, smem, true);
#endif
        ph_gemm_all<1>(p, l, bid, G, smem);
        gbar(ws_gbar(p), (nbar += (unsigned)G));
    }
    for (int it = bid; it < NTOK / 4; it += G) ph_final(p, it);
}
#endif

extern "C" void kernel_launch(void* const* d_in, const int* in_sizes, int n_in, void* d_out, int out_size, void* d_ws, size_t ws_size,
                              hipStream_t stream) {
    Params p{};
    const float* const* in = (const float* const*)d_in;
    p.x_prompt = in[0]; p.x_sample = in[1]; p.norm_g = in[2]; p.w_in = in[3]; p.w_out = in[4]; p.rwkv_shift = in[5]; p.rwkv_w0 = in[6];
    p.rwkv_w_up = in[7]; p.rwkv_a0 = in[8]; p.rwkv_a_up = in[9]; p.rwkv_k_k = in[10]; p.rwkv_k_a = in[11]; p.rwkv_r_k = in[12];
    p.rwkv_ln_g = in[13]; p.rwkv_ln_b = in[14]; p.attn_q_norm = in[15]; p.attn_k_norm = in[16]; p.lru_conv_w = in[17]; p.lru_conv_b = in[18];
    p.lru_gate_w = in[19]; p.lru_gate_b = in[20]; p.lru_lambda = in[21]; p.swa_sink = in[22]; p.final_g = in[23];
    p.out = (float*)d_out;
    p.ws = (char*)d_ws;
    if (WS_NEED > ws_size) { fprintf(stderr, "workspace too small: need %zu have %zu\n", (size_t)WS_NEED, ws_size); }

#if MK_MULTI
    launch<PH_CONVW>(p, 0, CW_ITEMS, 64 * 65 * 4, stream);
    for (int l = 0; l < NL; ++l) {
        if (l == 0) launch<PH_ROWNORM>(p, l, NTOK / 4, 0, stream);
        launch<PH_GEMM1>(p, l, (NTOK / GBM) * (DIN / GBN), GEMM_LDS, stream);
        launch<PH_PREP>(p, l, NTOK / 32, PREP_LDS, stream);
        launch<PH_RWKV>(p, l, 240, 4 * 5120, stream);
        launch<PH_LRU>(p, l, 80, 0, stream);
        launch<PH_ATTNB>(p, l, 1280, 0, stream);
        launch<PH_ATTND>(p, l, 1280, 0, stream);
        launch<PH_POST>(p, l, NTOK / 8, 0, stream);
        launch<PH_GEMM2>(p, l, (NTOK / GBM) * (DM / GBN), GEMM_LDS, stream);
    }
    launch<PH_FINAL>(p, 0, NTOK / 4, 0, stream);
#else
    constexpr size_t kDynLds = GEMM_LDS;
    static int grid_blocks = 0;
    if (!grid_blocks) {
        (void)hipFuncSetAttribute((const void*)mega, hipFuncAttributeMaxDynamicSharedMemorySize, (int)kDynLds);
        int dev = 0, cus = 0, per_cu = 0;
        (void)hipGetDevice(&dev);
        (void)hipDeviceGetAttribute(&cus, hipDeviceAttributeMultiprocessorCount, dev);
        (void)hipOccupancyMaxActiveBlocksPerMultiprocessor(&per_cu, mega, 256, kDynLds);
        if (per_cu < 1) per_cu = 1;
        grid_blocks = cus * per_cu;
    }
    (void)hipMemsetAsync((char*)d_ws + WO_GBAR, 0, 256, stream);
    void* args[] = {&p};
    hipError_t e = hipLaunchCooperativeKernel((void*)mega, dim3(grid_blocks), dim3(256), args, kDynLds, stream);
    if (e != hipSuccess) fprintf(stderr, "cooperative launch failed: %s (grid %d)\n", hipGetErrorString(e), grid_blocks);
#endif
}
```

```cpp
#include <hip/hip_runtime.h>
#include <hip/hip_cooperative_groups.h>
#include <cstdio>
#include <cstdint>
namespace cg = cooperative_groups;

#define DEVI __device__ __forceinline__
typedef unsigned short bf16_t;
typedef short bf16x8 __attribute__((ext_vector_type(8)));
typedef float f32x4 __attribute__((ext_vector_type(4)));

constexpr int T_ = 2048, NB_ = 40, NTOK = NB_ * T_, DM = 1024, DIN = 3200, NL = 4;
constexpr int NPROMPT = 32 * T_;
constexpr size_t SA_EL = (size_t)NTOK * 256;
constexpr int OFF_A = 0, OFF_B = 1152, OFF_C = 1920, OFF_D = 2432;

struct Params {
    const float *x_prompt, *x_sample, *norm_g, *w_in, *w_out, *rwkv_shift, *rwkv_w0, *rwkv_w_up, *rwkv_a0, *rwkv_a_up,
        *rwkv_k_k, *rwkv_k_a, *rwkv_r_k, *rwkv_ln_g, *rwkv_ln_b, *attn_q_norm, *attn_k_norm, *lru_conv_w, *lru_conv_b,
        *lru_gate_w, *lru_gate_b, *lru_lambda, *swa_sink, *final_g;
    float* out;
    char* ws;
};
constexpr size_t al256(size_t x) { return (x + 255) & ~(size_t)255; }
constexpr size_t WO_WT_IN = 0;
constexpr size_t WO_WT_OUT = WO_WT_IN + al256((size_t)NL * DIN * DM * 2);
constexpr size_t WO_XB = WO_WT_OUT + al256((size_t)NL * DM * DM * 2);
constexpr size_t WO_Z = WO_XB + al256((size_t)NTOK * DM * 2);
constexpr size_t WO_SR = WO_Z + al256((size_t)NTOK * DIN * 2);
constexpr size_t WO_SK = WO_SR + SA_EL * 2, WO_SV = WO_SK + SA_EL * 2, WO_SKK = WO_SV + SA_EL * 2, WO_SA0 = WO_SKK + SA_EL * 2, WO_SW0 = WO_SA0 + 2 * SA_EL * 2;
constexpr size_t WO_CTR = WO_SW0 + 2 * SA_EL * 2;
constexpr size_t WO_WUP = WO_CTR + 256, WO_AUP = WO_WUP + (size_t)NL * 2 * 256 * 64 * 2, WO_GW = WO_AUP + (size_t)NL * 2 * 256 * 64 * 2, WO_ROPE = WO_GW + (size_t)NL * 16 * 4096 * 2;
constexpr size_t WO_GBAR = WO_ROPE + 2048 * 4;
constexpr size_t WO_PART = WO_GBAR + 256;
constexpr size_t WS_NEED = WO_PART + (size_t)NTOK * 16 * 4;
#define WSF(name, T, off) DEVI T* ws_##name(const Params& p) { return (T*)(p.ws + (off)); }
WSF(wt_in, bf16_t, WO_WT_IN) WSF(wt_out, bf16_t, WO_WT_OUT) WSF(xb, bf16_t, WO_XB) WSF(z, bf16_t, WO_Z) WSF(sR, bf16_t, WO_SR) WSF(sK, bf16_t, WO_SK)
WSF(sV, bf16_t, WO_SV) WSF(sKK, bf16_t, WO_SKK) WSF(sA0, bf16_t, WO_SA0) WSF(sW0, bf16_t, WO_SW0) WSF(la, bf16_t, WO_XB) WSF(h0, bf16_t, WO_XB + 2 * SA_EL * 2)
WSF(ctr, int, WO_CTR) WSF(gbar, unsigned, WO_GBAR) WSF(part, float, WO_PART) WSF(wup_t, bf16_t, WO_WUP) WSF(aup_t, bf16_t, WO_AUP) WSF(gw_t, bf16_t, WO_GW) WSF(rope, float, WO_ROPE)

DEVI float bf2f(bf16_t h) { return __uint_as_float(((unsigned)h) << 16); }
DEVI bf16_t f2bf(float f) { return __builtin_bit_cast(bf16_t, (__bf16)f); }
typedef float f2 __attribute__((ext_vector_type(2)));
typedef __bf16 b2_t __attribute__((ext_vector_type(2)));
DEVI unsigned pk2(float lo, float hi) { f2 v = {lo, hi}; return __builtin_bit_cast(unsigned, __builtin_convertvector(v, b2_t)); }
typedef unsigned u32x4 __attribute__((ext_vector_type(4)));
typedef unsigned u32x2 __attribute__((ext_vector_type(2)));
DEVI float sigm(float x) { return 1.f / (1.f + __expf(-x)); }
DEVI float dpp_f(float v, int) { return v; }
template <int CTRL> DEVI float dppx(float v) { return __builtin_bit_cast(float, __builtin_amdgcn_update_dpp(0, __builtin_bit_cast(int, v), CTRL, 0xf, 0xf, true)); }
DEVI float wave_sum(float v) {
    v += dppx<0xB1>(v);
    v += dppx<0x4E>(v);
    v += dppx<0x141>(v);
    v += dppx<0x140>(v);
    v += __shfl_xor(v, 16); v += __shfl_xor(v, 32);
    return v;
}
DEVI float rdl(float v, int j) { return __builtin_bit_cast(float, __builtin_amdgcn_readlane(__builtin_bit_cast(int, v), j)); }
DEVI const float* xrow(const Params& p, int l, int m) {
    if (l > 0) return p.out + (size_t)m * DM;
    const float* xp = p.x_prompt; const float* xs = p.x_sample;
    const long delta = (xs - xp) - (long)NPROMPT * DM;
    return xp + (size_t)m * DM + (m >= NPROMPT ? delta : (long)0);
}

DEVI int tidx() { int t = threadIdx.x; asm volatile("" : "+v"(t)); return t; }
constexpr int CW_PER_L = 1088, CW_ITEMS = NL * CW_PER_L + 1;
DEVI void ph_convw(const Params& p, int item, char* smem) {
    float* tile = (float*)smem;
    if (item == NL * CW_PER_L) {
        for (int e = tidx(); e < 1024; e += 256) {
            const int pos = e >> 4, i = e & 15;
            const float inv = exp2f(-(float)i * (13.287712379549449f / 16.f));
            const float ang = (float)pos * inv;
            ws_rope(p)[2 * e] = cosf(ang); ws_rope(p)[2 * e + 1] = sinf(ang);
        }
        return;
    }
    const int l = item / CW_PER_L; int r = item % CW_PER_L;
    const float* src; bf16_t* dst; int N, K, k0, n0;
    if (r < 800) { src = p.w_in + (size_t)l * DM * DIN; dst = ws_wt_in(p) + (size_t)l * DIN * DM; N = DIN; K = DM; k0 = (r / 50) * 64; n0 = (r % 50) * 64; }
    else if (r < 1056) { r -= 800; src = p.w_out + (size_t)l * DM * DM; dst = ws_wt_out(p) + (size_t)l * DM * DM; N = DM; K = DM; k0 = (r / 16) * 64; n0 = (r % 16) * 64; }
    else if (r < 1072) { r -= 1056; const int d = (r >> 2) & 1, up = r >> 3; const size_t o = (size_t)(l * 2 + d) * 64 * 256;
        src = (up ? p.rwkv_a_up : p.rwkv_w_up) + o; dst = (up ? ws_aup_t(p) : ws_wup_t(p)) + o; N = 256; K = 64; k0 = 0; n0 = (r & 3) * 64; }
    else { r -= 1072; const size_t o = (size_t)(l * 16 + r) * 4096; src = p.lru_gate_w + o; dst = ws_gw_t(p) + o; N = 64; K = 64; k0 = 0; n0 = 0; }
    int tx = tidx() & 63, ty = tidx() >> 6;
    __syncthreads();
    for (int i = 0; i < 16; ++i) { int k = ty + 4 * i; tile[k * 65 + tx] = src[(size_t)(k0 + k) * N + n0 + tx]; }
    __syncthreads();
    for (int i = 0; i < 16; ++i) { int n = ty + 4 * i; dst[(size_t)(n0 + n) * K + k0 + tx] = f2bf(tile[tx * 65 + n]); }
}

DEVI void ph_rownorm(const Params& p, int l, int item) {
    int w = tidx() >> 6, lane = tidx() & 63;
    int m = item * 4 + w;
    const float* x = xrow(p, l, m);
    const float* g = p.norm_g + l * DM;
    float4 v[4]; float ss = 0.f;
#pragma unroll
    for (int i = 0; i < 4; ++i) { v[i] = *(const float4*)(x + lane * 4 + 256 * i); ss += v[i].x * v[i].x + v[i].y * v[i].y + v[i].z * v[i].z + v[i].w * v[i].w; }
    ss = wave_sum(ss);
    if (lane < 16) ws_part(p)[(size_t)m * 16 + lane] = lane == 0 ? ss : 0.f;
#pragma unroll
    for (int i = 0; i < 4; ++i) {
        float4 gg = *(const float4*)(g + lane * 4 + 256 * i);
        uint2 o; o.x = pk2(v[i].x * gg.x, v[i].y * gg.y); o.y = pk2(v[i].z * gg.z, v[i].w * gg.w);
        *(uint2*)(ws_xb(p) + (size_t)m * DM + lane * 4 + 256 * i) = o;
    }
}

DEVI void ph_final(const Params& p, int item) {
    int w = tidx() >> 6, lane = tidx() & 63;
    int m = item * 4 + w;
    float* x = p.out + (size_t)m * DM;
    float4 v[4]; float ss = 0.f;
#pragma unroll
    for (int i = 0; i < 4; ++i) { v[i] = *(const float4*)(x + lane * 4 + 256 * i); ss += v[i].x * v[i].x + v[i].y * v[i].y + v[i].z * v[i].z + v[i].w * v[i].w; }
    ss = wave_sum(ss);
    float rs = rsqrtf(ss * (1.f / DM) + 1e-6f);
#pragma unroll
    for (int i = 0; i < 4; ++i) {
        float4 gg = *(const float4*)(p.final_g + lane * 4 + 256 * i);
        float4 o; o.x = v[i].x * rs * gg.x; o.y = v[i].y * rs * gg.y; o.z = v[i].z * rs * gg.z; o.w = v[i].w * rs * gg.w;
        *(float4*)(x + lane * 4 + 256 * i) = o;
    }
}

constexpr int GBM = 128, GBN = 128, GBK = 64, GLD = 72;
constexpr int GEMM_LDS = 2 * 2 * 128 * GLD * 2;
template <int EPI>
DEVI void ph_gemm_all(const Params& p, int l, int bid, int G, char* smem, bool dry = false) {
    constexpr int NT = EPI == 0 ? DIN / GBN : DM / GBN;
    constexpr int NTILES = (NTOK / GBM) * NT;
    if (bid >= NTILES) return;
#define G_COORDS(item_, r0_, c0_, pn_) { const int xcd_ = (item_) & 7, jx_ = (item_) >> 3; const int rg_ = jx_ / (8 * NT), wi_ = jx_ % (8 * NT); \
        pn_ = wi_ >> 3; r0_ = (xcd_ * 80 + rg_ * 8 + (wi_ & 7)) * GBM; c0_ = pn_ * GBN; }
    const bf16_t* A = EPI == 0 ? ws_xb(p) : ws_z(p);
    const int lda = EPI == 0 ? DM : DIN;
    const bf16_t* Bt = EPI == 0 ? ws_wt_in(p) + (size_t)l * DIN * DM : ws_wt_out(p) + (size_t)l * DM * DM;
    bf16_t* As = (bf16_t*)smem;
    bf16_t* Bs = As + 2 * 128 * GLD;
    const int tid = tidx(), wid = tid >> 6, lane = tid & 63, wr = wid >> 1, wc = wid & 1, fr = lane & 15, fq = lane >> 4;
    int item = bid, row0, col0, pn, nrow0 = 0, ncol0 = 0, npn = 0;
    G_COORDS(item, row0, col0, pn)
    bool hasn = item + G < NTILES;
    nrow0 = row0; ncol0 = col0; npn = pn;
    if (hasn) G_COORDS(item + G, nrow0, ncol0, npn)
    f32x4 acc[4][4];
#pragma unroll
    for (int m = 0; m < 4; ++m)
#pragma unroll
        for (int n = 0; n < 4; ++n) acc[m][n] = (f32x4){0.f, 0.f, 0.f, 0.f};
    u32x4 ra0[4], rb0[4], ra1[4], rb1[4];
    auto aoff = [&](int kt) __attribute__((always_inline)) -> int {
        if (EPI == 0) return kt * 64;
        const int blk = kt >> 2;
        const int bo = blk == 0 ? OFF_A : blk == 1 ? OFF_B : blk == 2 ? OFF_C : OFF_D;
        return bo + (kt & 3) * 64;
    };
    const int lr = tid >> 3, lch = (tid & 7) * 8;
    const unsigned va0 = (unsigned)(lr * lda + lch) * 2u, vb0 = (unsigned)(lr * DM + lch) * 2u;
    const unsigned vas = (unsigned)(32 * lda) * 2u, vbs = (unsigned)(32 * DM) * 2u;
#define G_LOAD1(ra, rb, i) ra[i] = *(const u32x4*)(ab_ + (va0 + (i) * vas)); rb[i] = *(const u32x4*)(bb_ + (vb0 + (i) * vbs));
#define G_LOAD(ra, rb, r0_, c0_, kt_) { const char* ab_ = (const char*)(A + (size_t)(r0_) * lda + aoff(kt_)); const char* bb_ = (const char*)(Bt + (size_t)(c0_) * DM + (kt_) * 64); \
        G_LOAD1(ra, rb, 0) G_LOAD1(ra, rb, 1) G_LOAD1(ra, rb, 2) G_LOAD1(ra, rb, 3) }
#define S_WRITE1(ra, rb, buf_, i) *(u32x4*)(As + ((buf_) * 128 + lr + 32 * (i)) * GLD + lch) = ra[i]; *(u32x4*)(Bs + ((buf_) * 128 + lr + 32 * (i)) * GLD + lch) = rb[i];
#define S_WRITE(ra, rb, buf_) { S_WRITE1(ra, rb, buf_, 0) S_WRITE1(ra, rb, buf_, 1) S_WRITE1(ra, rb, buf_, 2) S_WRITE1(ra, rb, buf_, 3) }
#define G_COMPUTE_W(buf_, ra, rb, wbuf_, dow_) { \
    bf16x8 af[2][4], bfr[2][4]; \
    _Pragma("unroll") for (int ks = 0; ks < 2; ++ks) { \
        _Pragma("unroll") for (int m = 0; m < 4; ++m) af[ks][m] = *(const bf16x8*)(As + ((buf_) * 128 + wr * 64 + m * 16 + fr) * GLD + ks * 32 + fq * 8); \
        _Pragma("unroll") for (int n = 0; n < 4; ++n) bfr[ks][n] = *(const bf16x8*)(Bs + ((buf_) * 128 + wc * 64 + n * 16 + fr) * GLD + ks * 32 + fq * 8); \
    } \
    if (dow_) S_WRITE(ra, rb, wbuf_) \
    __builtin_amdgcn_s_setprio(1); \
    _Pragma("unroll") for (int ks = 0; ks < 2; ++ks) \
        _Pragma("unroll") for (int m = 0; m < 4; ++m) \
            _Pragma("unroll") for (int n = 0; n < 4; ++n) acc[m][n] = __builtin_amdgcn_mfma_f32_16x16x32_bf16(bfr[ks][n], af[ks][m], acc[m][n], 0, 0, 0); \
    __builtin_amdgcn_s_setprio(0); }
    constexpr int NK = DM / GBK;
    __syncthreads();
    G_LOAD(ra0, rb0, row0, col0, 0) G_LOAD(ra1, rb1, row0, col0, 1)
    S_WRITE(ra0, rb0, 0)
    G_LOAD(ra0, rb0, row0, col0, 2)
    __syncthreads();
#pragma unroll 1
    for (;;) {
#pragma unroll 1
        for (int kt = 0; kt < NK; kt += 2) {
            G_COMPUTE_W(0, ra1, rb1, 1, true)
            __syncthreads();
            { const bool nx = kt + 3 >= NK; const int r_ = nx ? nrow0 : row0, c_ = nx ? ncol0 : col0, k_ = nx ? kt + 3 - NK : kt + 3; G_LOAD(ra1, rb1, r_, c_, k_) }
            G_COMPUTE_W(1, ra0, rb0, 0, true)
            __syncthreads();
            { const bool nx = kt + 4 >= NK; const int r_ = nx ? nrow0 : row0, c_ = nx ? ncol0 : col0, k_ = nx ? kt + 4 - NK : kt + 4; G_LOAD(ra0, rb0, r_, c_, k_) }
        }
        f32x4 ggn[4];
        if (EPI == 1 && !dry && l + 1 < NL) {
#pragma unroll
            for (int n = 0; n < 4; ++n) ggn[n] = *(const f32x4*)(p.norm_g + (l + 1) * DM + col0 + wc * 64 + n * 16 + fq * 4);
        }
#pragma unroll
        for (int mh = 0; mh < 2; ++mh) {
            float rsm[2] = {1.f, 1.f};
            f32x4 xres[2][4];
            if (EPI == 0) {
                f32x4 q[2][4];
#pragma unroll
                for (int mm = 0; mm < 2; ++mm) {
                    const f32x4* pp = (const f32x4*)(ws_part(p) + (size_t)(row0 + wr * 64 + (2 * mh + mm) * 16 + fr) * 16);
#pragma unroll
                    for (int k = 0; k < 4; ++k) q[mm][k] = pp[k];
                }
#pragma unroll
                for (int mm = 0; mm < 2; ++mm) {
                    const f32x4 t = (q[mm][0] + q[mm][1]) + (q[mm][2] + q[mm][3]);
                    rsm[mm] = rsqrtf(((t[0] + t[1]) + (t[2] + t[3])) * (1.f / DM) + 1e-6f);
                }
            } else if (!dry) {
#pragma unroll
                for (int mm = 0; mm < 2; ++mm)
#pragma unroll
                    for (int n = 0; n < 4; ++n) xres[mm][n] = *(const f32x4*)(xrow(p, l, row0 + wr * 64 + (2 * mh + mm) * 16 + fr) + col0 + wc * 64 + n * 16 + fq * 4);
            }
#pragma unroll
            for (int mm = 0; mm < 2; ++mm) {
                const int m = 2 * mh + mm;
                const int row = row0 + wr * 64 + m * 16 + fr;
                const float rs = rsm[mm];
                float ssq = 0.f;
#pragma unroll
                for (int n = 0; n < 4; ++n) {
                    const int col = col0 + wc * 64 + n * 16 + fq * 4;
                    if (dry) { if (acc[m][n][0] == 1.2345e30f) ws_ctr(p)[63] = 1; }
                    else if (EPI == 0) {
                        uint2 o; o.x = pk2(acc[m][n][0] * rs, acc[m][n][1] * rs); o.y = pk2(acc[m][n][2] * rs, acc[m][n][3] * rs);
                        *(uint2*)(ws_z(p) + (size_t)row * DIN + col) = o;
                    } else {
                        const f32x4 o = xres[mm][n] + acc[m][n];
                        *(f32x4*)(p.out + (size_t)row * DM + col) = o;
                        ssq += (o[0] * o[0] + o[1] * o[1]) + (o[2] * o[2] + o[3] * o[3]);
                        if (l + 1 < NL) {
                            const f32x4 og = o * ggn[n];
                            uint2 ob; ob.x = pk2(og[0], og[1]); ob.y = pk2(og[2], og[3]);
                            *(uint2*)(ws_xb(p) + (size_t)row * DM + col) = ob;
                        }
                    }
                }
                if (EPI == 1 && !dry) {
                    ssq += __shfl_xor(ssq, 16); ssq += __shfl_xor(ssq, 32);
                    if (fq == 0) ws_part(p)[(size_t)row * 16 + pn * 2 + wc] = ssq;
                }
            }
        }
        if (!hasn) break;
#pragma unroll
        for (int m = 0; m < 4; ++m)
#pragma unroll
            for (int n = 0; n < 4; ++n) acc[m][n] = (f32x4){0.f, 0.f, 0.f, 0.f};
        item += G; row0 = nrow0; col0 = ncol0; pn = npn;
        hasn = item + G < NTILES;
        if (hasn) G_COORDS(item + G, nrow0, ncol0, npn)
    }
#undef G_LOAD
#undef S_WRITE
#undef G_LOAD1
#undef S_WRITE1
#undef G_COMPUTE_W
#undef G_COORDS
}

constexpr int XLD = 264, LLD = 72;
constexpr int PREP_LDS = 64 * XLD * 2 + 2 * 64 * LLD * 2;
DEVI float ropeT(f2 cs, float x, int d) {
    const int e = d & 31;
    const float pr = __shfl_xor(x, 16);
    return (e < 16) ? x * cs.x - pr * cs.y : pr * cs.y + x * cs.x;
}
DEVI void ph_prep(const Params& p, int l, int item, char* smem, bool dry = false) {
    bf16_t* xc_s = (bf16_t*)smem;
    bf16_t* wl_s = xc_s + 64 * XLD;
    bf16_t* al_s = wl_s + 64 * LLD;
    const int tid = tidx(), w = tid >> 6, lane = tid & 63, fr = lane & 15, fq = lane >> 4;
    const int b = item >> 6, t0 = (item & 63) * 32;
    const size_t mbase = (size_t)b * T_ + t0;
    bf16_t* zt = ws_z(p) + mbase * DIN;
    __syncthreads();
    {
        const float* sh = p.rwkv_shift + l * 2 * 896;
        float s0[4], s1[4], pv[4], cu[4];
#pragma unroll
        for (int s_ = 0; s_ < 4; ++s_) {
            const int c = tid + 256 * s_;
            const bool ok = c < 896;
            s0[s_] = ok ? sh[c] : 0.f; s1[s_] = ok ? sh[896 + c] : 0.f;
            pv[s_] = (ok && t0 > 0) ? bf2f(zt[c - DIN]) : 0.f;
            cu[s_] = ok ? bf2f(zt[c]) : 0.f;
        }
        const float kkw = p.rwkv_k_k[l * 256 + tid];
        float cw[4];
#pragma unroll
        for (int jj = 0; jj < 4; ++jj) cw[jj] = p.lru_conv_w[(l * 4 + jj) * 256 + tid];
        const float cb = p.lru_conv_b[l * 256 + tid];
        float xm2 = t0 >= 2 ? bf2f(zt[OFF_C + tid - 2 * DIN]) : 0.f, xm1 = t0 >= 1 ? bf2f(zt[OFF_C + tid - DIN]) : 0.f, x0 = bf2f(zt[OFF_C + tid]);
        const float qnw = p.attn_q_norm[l * 64 + lane], knw = p.attn_k_norm[l * 64 + lane];
        const bool c3 = tid < 128;
        bf16_t nA[2][4][4], nC[2][4], qB[2][4], kB[2][4];
        f2 cs8[2][4];
#define PREP_LOADG(B_, G_) { \
            _Pragma("unroll") for (int i8 = 0; i8 < 4; ++i8) { \
                const int tt = (G_) * 4 + i8; \
                const bf16_t* zr = zt + (size_t)tt * DIN; \
                const bool hasn = t0 + tt + 1 < T_; \
                _Pragma("unroll") for (int s_ = 0; s_ < 4; ++s_) nA[B_][i8][s_] = (hasn && (s_ < 3 || c3)) ? zr[tid + 256 * s_ + DIN] : (bf16_t)0; \
                nC[B_][i8] = hasn ? zr[OFF_C + tid + DIN] : (bf16_t)0; \
                qB[B_][i8] = zr[OFF_B + tid]; \
                kB[B_][i8] = c3 ? zr[OFF_B + 256 + tid] : (bf16_t)0; \
                cs8[B_][i8] = *(const f2*)(ws_rope(p) + 2 * (((lane >> 5) ? (t0 & 63) + tt : (t0 >> 6)) * 16 + (lane & 15))); \
            } }
#define PREP_COMPG(B_, G_) { \
            _Pragma("unroll") for (int i8 = 0; i8 < 4; ++i8) { \
                const int tt = (G_) * 4 + i8; \
                bf16_t* zr = zt + (size_t)tt * DIN; \
                float xs[4]; \
                _Pragma("unroll") for (int s_ = 0; s_ < 4; ++s_) { \
                    const float nx = bf2f(nA[B_][i8][s_]); \
                    xs[s_] = cu[s_] + s0[s_] * (pv[s_] - cu[s_]) + s1[s_] * (nx - cu[s_]); \
                    pv[s_] = cu[s_]; cu[s_] = nx; \
                } \
                const size_t o = (mbase + tt) * 256 + tid; \
                const float kkv = xs[1] * kkw; \
                const float ss = wave_sum(kkv * kkv); \
                ws_sR(p)[o] = f2bf(xs[0]); ws_sK(p)[o] = f2bf(xs[1]); ws_sV(p)[o] = f2bf(xs[2]); ws_sKK(p)[o] = f2bf(kkv * rsqrtf(fmaxf(ss, 1e-24f))); \
                if (tid < 64) wl_s[tt * LLD + tid] = f2bf(1.f - 2.f / (1.f + __expf(2.f * xs[3]))); \
                else if (tid < 128) al_s[tt * LLD + tid - 64] = f2bf(xs[3]); \
                const float xp1 = bf2f(nC[B_][i8]); \
                xc_s[tt * XLD + tid] = f2bf(cb + cw[0] * xm2 + cw[1] * xm1 + cw[2] * x0 + cw[3] * xp1); \
                xm2 = xm1; xm1 = x0; x0 = xp1; \
                const float q = bf2f(qB[B_][i8]); \
                const float s2 = wave_sum(q * q); \
                const float qn = ropeT(cs8[B_][i8], q * rsqrtf(s2 * (1.f / 64.f) + 1e-6f) * qnw, lane) * (0.125f * 1.4426950408889634f); \
                if (!dry) zr[OFF_B + tid] = f2bf(qn); \
                if (c3) { \
                    const float kx = bf2f(kB[B_][i8]); \
                    const float s3 = wave_sum(kx * kx); \
                    const float kro = ropeT(cs8[B_][i8], kx * rsqrtf(s3 * (1.f / 64.f) + 1e-6f) * knw, lane); \
                    if (!dry) zr[OFF_B + 256 + tid] = f2bf(kro); \
                } \
            } }
        PREP_LOADG(0, 0)
#pragma unroll 1
        for (int g = 0; g < 8; g += 2) {
            PREP_LOADG(1, g + 1)
            PREP_COMPG(0, g)
            if (g + 2 < 8) PREP_LOADG(0, g + 2)
            PREP_COMPG(1, g + 1)
        }
#undef PREP_LOADG
#undef PREP_COMPG
    }
    __syncthreads();
#pragma unroll 1
    for (int dm = 0; dm < 4; ++dm) {
        const int d = dm >> 1, mat = dm & 1;
        const bf16_t* Bt = (mat ? ws_aup_t(p) : ws_wup_t(p)) + ((size_t)(l * 2 + d) * 256 + 64 * w) * 64;
        bf16x8 bfr[4][2];
#pragma unroll
        for (int nt = 0; nt < 4; ++nt)
#pragma unroll
            for (int ks = 0; ks < 2; ++ks) bfr[nt][ks] = *(const bf16x8*)(Bt + (16 * nt + fr) * 64 + 32 * ks + 8 * fq);
        const bf16_t* As = mat ? al_s : wl_s;
        const float* bias = (mat ? p.rwkv_a0 : p.rwkv_w0) + (l * 2 + d) * 256 + 64 * w + 4 * fq;
        bf16_t* dst = (mat ? ws_sA0(p) : ws_sW0(p)) + d * SA_EL + mbase * 256 + 64 * w + 4 * fq;
#pragma unroll 1
        for (int m = 0; m < 2; ++m) {
            bf16x8 af[2];
#pragma unroll
            for (int ks = 0; ks < 2; ++ks) af[ks] = *(const bf16x8*)(As + (16 * m + fr) * LLD + 32 * ks + 8 * fq);
#pragma unroll
            for (int nt = 0; nt < 4; ++nt) {
                f32x4 acc = (f32x4){0.f, 0.f, 0.f, 0.f};
#pragma unroll
                for (int ks = 0; ks < 2; ++ks) acc = __builtin_amdgcn_mfma_f32_16x16x32_bf16(bfr[nt][ks], af[ks], acc, 0, 0, 0);
                const f32x4 bv = *(const f32x4*)(bias + 16 * nt);
                float ov[4];
#pragma unroll
                for (int jj = 0; jj < 4; ++jj) {
                    const float sg = sigm(acc[jj] + bv[jj]);
                    ov[jj] = mat ? sg : 1.f - __expf(-0.6065306597126334f * sg);
                }
                u32x2 o2; o2[0] = pk2(ov[0], ov[1]); o2[1] = pk2(ov[2], ov[3]);
                *(u32x2*)(dst + (size_t)(16 * m + fr) * 256 + 16 * nt) = o2;
            }
        }
    }
#pragma unroll 1
    for (int d = 0; d < 2; ++d) {
        bf16x8 bfr[2][4][2];
#pragma unroll
        for (int k = 0; k < 2; ++k)
#pragma unroll
            for (int nt = 0; nt < 4; ++nt)
#pragma unroll
                for (int ks = 0; ks < 2; ++ks)
                    bfr[k][nt][ks] = *(const bf16x8*)(ws_gw_t(p) + ((size_t)(((l * 2 + d) * 2 + k) * 4 + w) * 64 + 16 * nt + fr) * 64 + 32 * ks + 8 * fq);
        const int e00 = 64 * w + 4 * fq;
#pragma unroll 1
        for (int m = 0; m < 2; ++m) {
            bf16x8 af[2];
#pragma unroll
            for (int ks = 0; ks < 2; ++ks) af[ks] = *(const bf16x8*)(xc_s + (16 * m + fr) * XLD + 64 * w + 32 * ks + 8 * fq);
#pragma unroll
            for (int nt = 0; nt < 4; ++nt) {
                f32x4 g0 = (f32x4){0.f, 0.f, 0.f, 0.f}, g1 = g0;
#pragma unroll
                for (int ks = 0; ks < 2; ++ks) {
                    g0 = __builtin_amdgcn_mfma_f32_16x16x32_bf16(bfr[0][nt][ks], af[ks], g0, 0, 0, 0);
                    g1 = __builtin_amdgcn_mfma_f32_16x16x32_bf16(bfr[1][nt][ks], af[ks], g1, 0, 0, 0);
                }
                const int e0 = e00 + 16 * nt;
                const f32x4 gb0 = *(const f32x4*)(p.lru_gate_b + ((l * 2 + d) * 2 + 0) * 256 + e0), gb1 = *(const f32x4*)(p.lru_gate_b + ((l * 2 + d) * 2 + 1) * 256 + e0);
                const f32x4 lam = *(const f32x4*)(p.lru_lambda + (l * 2 + d) * 256 + e0);
                const u32x2 xu = *(const u32x2*)(xc_s + (16 * m + fr) * XLD + e0);
                const float xv[4] = {__uint_as_float(xu[0] << 16), __uint_as_float(xu[0] & 0xffff0000u), __uint_as_float(xu[1] << 16), __uint_as_float(xu[1] & 0xffff0000u)};
                float a1[4], bt[4];
#pragma unroll
                for (int jj = 0; jj < 4; ++jj) {
                    const float r = sigm(g0[jj] + gb0[jj]), ig = sigm(g1[jj] + gb1[jj]);
                    const float sp = __logf(1.f + __expf(-lam[jj]));
                    const float a = __expf(-8.f * r * sp);
                    a1[jj] = 1.f - a;
                    bt[jj] = sqrtf(a1[jj] * (1.f + a)) * ig * xv[jj];
                }
                const size_t o = d * SA_EL + (mbase + 16 * m + fr) * 256 + e0;
                u32x2 oa; oa[0] = pk2(a1[0], a1[1]); oa[1] = pk2(a1[2], a1[3]);
                u32x2 ob; ob[0] = pk2(bt[0], bt[1]); ob[1] = pk2(bt[2], bt[3]);
                *(u32x2*)(ws_la(p) + o) = oa; *(u32x2*)(ws_h0(p) + o) = ob;
            }
        }
    }
}

DEVI f2 fma2(f2 a, f2 b, f2 c) { return __builtin_elementwise_fma(a, b, c); }
DEVI void ph_rwkv_scan(const Params& p, int l, int item, char* smem, bool dry = false) {
    const int wv = __builtin_amdgcn_readfirstlane(tidx() >> 6), lane = tidx() & 63;
    const int wi = item * 4 + wv;
    const int scan = wi / 3, part = wi - scan * 3;
    const int b = scan >> 3, h = (scan >> 1) & 3, d = scan & 1;
    const int c8 = lane & 7, r8 = lane >> 3;
    float* ring = (float*)smem + wv * 1280;
    const char* A = (const char*)(ws_sA0(p) + d * SA_EL);
    const char* Wm = (const char*)(ws_sW0(p) + d * SA_EL);
    const char *R = (const char*)ws_sR(p), *K = (const char*)ws_sK(p), *V = (const char*)ws_sV(p), *KK = (const char*)ws_sKK(p);
    char* Y = (char*)(ws_z(p) + 256 + 256 * d + h * 64);
#define LDB(base, bo) (*(const bf16_t*)((base) + (bo)))
    const float ka = p.rwkv_k_a[l * 256 + h * 64 + lane];
    f2 S[3][4];
#pragma unroll
    for (int pp = 0; pp < 3; ++pp)
#pragma unroll
        for (int k = 0; k < 4; ++k) S[pp][k] = (f2){0.f, 0.f};
    const unsigned t00 = (unsigned)(b * T_ + (d ? T_ - 1 : 0)) * 256u + h * 64;
    const unsigned o0 = (t00 + lane) * 2u;
    int rowp[3]; unsigned ov[3];
#pragma unroll
    for (int pp = 0; pp < 3; ++pp) { rowp[pp] = 24 * part + 8 * pp + r8; ov[pp] = (t00 + (rowp[pp] < 64 ? rowp[pp] : 63)) * 2u; }
    const int stp = d ? -512 : 512;
    const int myp = c8 < 3 ? c8 : 0;
    const int myrow = 24 * part + 8 * myp + r8;
    const bool ystore = c8 < 3 && myrow < 64 && !dry;
    const unsigned yrow_b = (unsigned)myrow * 2u;
    float vcur[3], vnx[3];
#pragma unroll
    for (int s_ = 0; s_ < 2; ++s_) {
        const unsigned o = o0 + s_ * stp;
        const float r = bf2f(LDB(R, o)), k = bf2f(LDB(K, o)), kk = bf2f(LDB(KK, o)), a = bf2f(LDB(A, o)), w = 1.f - bf2f(LDB(Wm, o));
#pragma unroll
        for (int pp = 0; pp < 3; ++pp) { const float vv = bf2f(LDB(V, ov[pp] + s_ * stp)); if (s_ == 0) vcur[pp] = vv; else vnx[pp] = vv; }
        float* sl = ring + s_ * 320;
        sl[0 * 64 + lane] = w; sl[1 * 64 + lane] = kk * a; sl[2 * 64 + lane] = k * (1.f + (a - 1.f) * ka); sl[3 * 64 + lane] = r; sl[4 * 64 + lane] = kk;
    }
    bf16_t rr[8], rk[8], rkk[8], ra[8], rw[8], rv[8][3];
#pragma unroll
    for (int i = 0; i < 8; ++i) {
        const int st = (i < 2 ? 8 + i : i) * stp;
        rr[i] = LDB(R, o0 + st); rk[i] = LDB(K, o0 + st); rkk[i] = LDB(KK, o0 + st); ra[i] = LDB(A, o0 + st); rw[i] = LDB(Wm, o0 + st);
#pragma unroll
        for (int pp = 0; pp < 3; ++pp) rv[i][pp] = LDB(V, ov[pp] + st);
    }
    __builtin_amdgcn_wave_barrier();
    f32x4 OB[2][5][2];
#define RW_LDO(set, slw, slk) { _Pragma("unroll") for (int g = 0; g < 2; ++g) { \
        OB[set][0][g] = *(const f32x4*)((slw) + 0 * 64 + 8 * c8 + 4 * g); OB[set][1][g] = *(const f32x4*)((slw) + 1 * 64 + 8 * c8 + 4 * g); \
        OB[set][2][g] = *(const f32x4*)((slw) + 2 * 64 + 8 * c8 + 4 * g); OB[set][3][g] = *(const f32x4*)((slw) + 3 * 64 + 8 * c8 + 4 * g); \
        OB[set][4][g] = *(const f32x4*)((slk) + 4 * 64 + 8 * c8 + 4 * g); } }
    RW_LDO(0, ring, ring + 320)
    float sktot[3] = {0.f, 0.f, 0.f};
    __builtin_amdgcn_s_setprio(3);
    for (int sb = 0; sb < T_; sb += 8) {
#pragma unroll
        for (int i = 0; i < 8; ++i) {
            const int step = sb + i;
            const int slot = (i + 2) & 7;
            float v2n[3];
            {
                float* sn = ring + ((i + 2) & 3) * 320;
                const float r1 = bf2f(rr[slot]), k1 = bf2f(rk[slot]), kk1 = bf2f(rkk[slot]), a1 = bf2f(ra[slot]), w1 = 1.f - bf2f(rw[slot]);
                sn[0 * 64 + lane] = w1; sn[1 * 64 + lane] = kk1 * a1; sn[2 * 64 + lane] = k1 * (1.f + (a1 - 1.f) * ka); sn[3 * 64 + lane] = r1; sn[4 * 64 + lane] = kk1;
#pragma unroll
                for (int pp = 0; pp < 3; ++pp) v2n[pp] = bf2f(rv[slot][pp]);
            }
            {
                const int s10 = (step + 10 < T_ ? step + 10 : T_ - 1) * stp;
                const unsigned oc = o0 + s10;
                rr[slot] = LDB(R, oc); rk[slot] = LDB(K, oc); rkk[slot] = LDB(KK, oc); ra[slot] = LDB(A, oc); rw[slot] = LDB(Wm, oc);
#pragma unroll
                for (int pp = 0; pp < 3; ++pp) rv[slot][pp] = LDB(V, ov[pp] + s10);
            }
            __builtin_amdgcn_wave_barrier();
            RW_LDO((i + 1) & 1, ring + ((i + 1) & 3) * 320, ring + ((i + 2) & 3) * 320)
            const unsigned tok_b = (unsigned)(b * T_ + (d ? T_ - 1 - step : step)) * (unsigned)(DIN * 2);
            float pyv[3];
#pragma unroll
            for (int pp = 0; pp < 3; ++pp) {
                const f2 nsk2 = (f2){-sktot[pp], -sktot[pp]}, v2 = (f2){vcur[pp], vcur[pp]};
                f2 y2 = (f2){0.f, 0.f}, sk2 = (f2){0.f, 0.f};
#pragma unroll
                for (int g = 0; g < 2; ++g) {
                    const f32x4 w4 = OB[i & 1][0][g], b4 = OB[i & 1][1][g], kd4 = OB[i & 1][2][g], r4 = OB[i & 1][3][g], kn4 = OB[i & 1][4][g];
                    f2 t0 = v2 * kd4.xy; t0 = fma2(nsk2, b4.xy, t0);
                    S[pp][2 * g] = fma2(S[pp][2 * g], w4.xy, t0);
                    y2 = fma2(S[pp][2 * g], r4.xy, y2); sk2 = fma2(S[pp][2 * g], kn4.xy, sk2);
                    f2 t1 = v2 * kd4.zw; t1 = fma2(nsk2, b4.zw, t1);
                    S[pp][2 * g + 1] = fma2(S[pp][2 * g + 1], w4.zw, t1);
                    y2 = fma2(S[pp][2 * g + 1], r4.zw, y2); sk2 = fma2(S[pp][2 * g + 1], kn4.zw, sk2);
                }
                float ps = sk2.x + sk2.y, py = y2.x + y2.y;
                ps += dppx<0xB1>(ps); py += dppx<0xB1>(py);
                ps += dppx<0x4E>(ps); py += dppx<0x4E>(py);
                ps += dppx<0x141>(ps); py += dppx<0x141>(py);
                sktot[pp] = ps; pyv[pp] = py;
                vcur[pp] = vnx[pp]; vnx[pp] = v2n[pp];
            }
            {
                const float ysel = c8 == 0 ? pyv[0] : c8 == 1 ? pyv[1] : pyv[2];
                if (ystore) *(bf16_t*)(Y + (tok_b + yrow_b)) = f2bf(ysel);
            }
        }
    }
    __builtin_amdgcn_s_setprio(0);
#undef RW_LDO
#undef LDB
}

DEVI void ph_lru_scan(const Params& p, int l, int item, bool dry = false) {
    const int lane = tidx() & 63, idx = item * 4 + (tidx() >> 6);
    const int b = idx >> 3, n = (idx >> 1) & 3, d = idx & 1;
    const bf16_t* A = ws_la(p) + d * SA_EL + (size_t)b * T_ * 256 + n * 64 + lane;
    bf16_t* H = ws_h0(p) + d * SA_EL + (size_t)b * T_ * 256 + n * 64 + lane;
    float h = 0.f;
    for (int s0 = 0; s0 < T_; s0 += 32) {
        bf16_t av[32], bv[32];
#pragma unroll
        for (int i = 0; i < 32; ++i) { const int t = d ? T_ - 1 - (s0 + i) : s0 + i; av[i] = A[(size_t)t * 256]; bv[i] = H[(size_t)t * 256]; }
#pragma unroll
        for (int i = 0; i < 32; ++i) {
            const int t = d ? T_ - 1 - (s0 + i) : s0 + i;
            h = (1.f - bf2f(av[i])) * h + bf2f(bv[i]);
            if (!dry) H[(size_t)t * 256] = f2bf(h);
        }
    }
}

DEVI void ph_post_all(const Params& p, int l, int bid, int G) {
    const int j = tidx();
    const float lg = p.rwkv_ln_g[l * 256 + j], lb = p.rwkv_ln_b[l * 256 + j], ka = p.rwkv_k_a[l * 256 + j], rk_ = p.rwkv_r_k[l * 256 + j];
    constexpr int NIT = NTOK / 8;
    if (bid >= NIT) return;
    const int ng = (NIT - bid + G - 1) / G;
    bf16_t yf[2][8], yr[2][8], r_[2][8], k_[2][8], v_[2][8], af[2][8], ar[2][8], ga[2][8], hf[2][8], hr[2][8], gc[2][8];
#define POST_LOAD(B_, GI_) { \
        _Pragma("unroll") for (int i = 0; i < 8; ++i) { \
            const int m = (bid + (GI_) * G) * 8 + i; \
            const size_t o = (size_t)m * 256 + j; \
            const bf16_t* zr = ws_z(p) + (size_t)m * DIN; \
            yf[B_][i] = zr[256 + j]; yr[B_][i] = zr[512 + j]; r_[B_][i] = ws_sR(p)[o]; k_[B_][i] = ws_sK(p)[o]; v_[B_][i] = ws_sV(p)[o]; \
            af[B_][i] = ws_sA0(p)[o]; ar[B_][i] = ws_sA0(p)[o + SA_EL]; ga[B_][i] = zr[OFF_A + 896 + j]; \
            hf[B_][i] = ws_h0(p)[o]; hr[B_][i] = ws_h0(p)[o + SA_EL]; gc[B_][i] = zr[OFF_C + 256 + j]; \
        } }
#define POST_COMP(B_, GI_) { \
        _Pragma("unroll") for (int i = 0; i < 8; ++i) { \
            const int m = (bid + (GI_) * G) * 8 + i; \
            bf16_t* zr = ws_z(p) + (size_t)m * DIN; \
            const float y = bf2f(yf[B_][i]) + bf2f(yr[B_][i]); \
            const float mu = wave_sum(y) * (1.f / 64.f); \
            const float dv = y - mu; \
            const float var = wave_sum(dv * dv) * (1.f / 64.f); \
            const float yn = dv * rsqrtf(var + 64e-5f) * lg + lb; \
            const float r = bf2f(r_[B_][i]), k = bf2f(k_[B_][i]), v = bf2f(v_[B_][i]), a_f = bf2f(af[B_][i]), a_r = bf2f(ar[B_][i]); \
            const float ksum = k * (1.f + (a_f - 1.f) * ka) + k * (1.f + (a_r - 1.f) * ka); \
            const float bon = wave_sum(r * ksum * rk_) * v; \
            const float g = bf2f(ga[B_][i]); \
            zr[OFF_A + j] = f2bf((yn + bon) * g * sigm(g)); \
            const float h = bf2f(hf[B_][i]) + bf2f(hr[B_][i]); \
            const float g2 = bf2f(gc[B_][i]); \
            zr[OFF_C + j] = f2bf(h * g2 * sigm(g2)); \
        } }
    POST_LOAD(0, 0)
#pragma unroll 1
    for (int gi = 0; gi < ng; gi += 2) {
        if (gi + 1 < ng) POST_LOAD(1, gi + 1)
        POST_COMP(0, gi)
        if (gi + 2 < ng) POST_LOAD(0, gi + 2)
        if (gi + 1 < ng) POST_COMP(1, gi + 1)
    }
#undef POST_LOAD
#undef POST_COMP
}

template <int WIN>
DEVI void ph_attn_naive(const Params& p, int l, int item) {
    const int lane = tidx() & 63, idx = item * 4 + (tidx() >> 6);
    const int qb = idx & 31, hq = (idx >> 5) & 3, b = idx >> 7;
    const int g = hq >> 1;
    constexpr int OFF = WIN ? OFF_D : OFF_B;
    const int t0 = qb * 64, t = t0 + lane;
    bf16_t* zq = ws_z(p) + ((size_t)b * T_ + t) * DIN + OFF + hq * 64;
    float q[64], o[64];
#pragma unroll
    for (int c = 0; c < 8; ++c) {
        const uint4 u = *(const uint4*)(zq + c * 8);
        const unsigned uu[4] = {u.x, u.y, u.z, u.w};
#pragma unroll
        for (int e = 0; e < 4; ++e) { q[c * 8 + 2 * e] = __uint_as_float(uu[e] << 16); q[c * 8 + 2 * e + 1] = __uint_as_float(uu[e] & 0xffff0000u); }
    }
#pragma unroll
    for (int dd = 0; dd < 64; ++dd) o[dd] = 0.f;
    float mx, ls;
    float slope = 0.f;
    if (WIN) { mx = p.swa_sink[l * 4 + hq]; ls = 1.f; slope = exp2f(-8.f * (float)(hq + 1) / 4.f); }
    else { mx = -1e30f; ls = 0.f; }
    const int s0 = WIN ? max(0, t0 - 128) : 0, s1 = WIN ? min(T_ - 1, t0 + 63 + 128) : T_ - 1;
    const bf16_t* kb = ws_z(p) + (size_t)b * T_ * DIN + OFF + 256 + g * 64;
    for (int s = s0; s <= s1; ++s) {
        const bf16_t* kr = kb + (size_t)s * DIN;
        float sc = 0.f;
#pragma unroll
        for (int c = 0; c < 8; ++c) {
            const uint4 u = *(const uint4*)(kr + c * 8);
            const unsigned uu[4] = {u.x, u.y, u.z, u.w};
#pragma unroll
            for (int e = 0; e < 4; ++e) { sc += q[c * 8 + 2 * e] * __uint_as_float(uu[e] << 16); sc += q[c * 8 + 2 * e + 1] * __uint_as_float(uu[e] & 0xffff0000u); }
        }
        bool valid = true;
        if (WIN) { const int dist = abs(t - s); valid = dist <= 128; sc = sc * 0.125f - slope * (float)dist; }
        const float mn = valid ? fmaxf(mx, sc) : mx;
        const float al = __expf(mx - mn);
        const float pp = valid ? __expf(sc - mn) : 0.f;
        mx = mn; ls = ls * al + pp;
#pragma unroll
        for (int c = 0; c < 8; ++c) {
            const uint4 u = *(const uint4*)(kr + 128 + c * 8);
            const unsigned uu[4] = {u.x, u.y, u.z, u.w};
#pragma unroll
            for (int e = 0; e < 4; ++e) {
                o[c * 8 + 2 * e] = o[c * 8 + 2 * e] * al + pp * __uint_as_float(uu[e] << 16);
                o[c * 8 + 2 * e + 1] = o[c * 8 + 2 * e + 1] * al + pp * __uint_as_float(uu[e] & 0xffff0000u);
            }
        }
    }
    const float il = 1.f / ls;
    const bf16_t* zg = zq - hq * 64 + 512 + hq * 64;
#pragma unroll
    for (int c = 0; c < 8; ++c) {
        const uint4 u = *(const uint4*)(zg + c * 8);
        const unsigned uu[4] = {u.x, u.y, u.z, u.w};
        unsigned ov[4];
#pragma unroll
        for (int e = 0; e < 4; ++e) {
            const float g0 = __uint_as_float(uu[e] << 16), g1 = __uint_as_float(uu[e] & 0xffff0000u);
            ov[e] = pk2(o[c * 8 + 2 * e] * il * g0 * sigm(g0), o[c * 8 + 2 * e + 1] * il * g1 * sigm(g1));
        }
        *(uint4*)(zq + c * 8) = make_uint4(ov[0], ov[1], ov[2], ov[3]);
    }
}

constexpr int ALD = 72;
template <int WIN>
DEVI void ph_attn(const Params& p, int l, int item, char* smem, bool dry = false) {
    constexpr int OFF = WIN ? OFF_D : OFF_B;
    const int qb = item & 15, hq = (item >> 4) & 3, b = item >> 6, g = hq >> 1;
    const int tid = tidx(), w = tid >> 6, lane = tid & 63, fr = lane & 15, fq = lane >> 4;
    const int t0 = qb * 128, tw = t0 + 32 * w;
    bf16_t* Ks = (bf16_t*)smem;
    bf16_t* Vt = Ks + 2 * 64 * ALD;
    bf16_t* zb = ws_z(p) + (size_t)b * T_ * DIN;
    bf16x8 qf[2][2];
#pragma unroll
    for (int n = 0; n < 2; ++n)
#pragma unroll
        for (int ks = 0; ks < 2; ++ks) {
            u32x4 u = *(const u32x4*)(zb + (size_t)(tw + 16 * n + fr) * DIN + OFF + hq * 64 + 32 * ks + 8 * fq);
            if (WIN) {
                constexpr float sc = 0.125f * 1.4426950408889634f;
#pragma unroll
                for (int e = 0; e < 4; ++e) u[e] = pk2(__uint_as_float(u[e] << 16) * sc, __uint_as_float(u[e] & 0xffff0000u) * sc);
            }
            qf[n][ks] = __builtin_bit_cast(bf16x8, u);
        }
    const int kt0 = WIN ? max(0, t0 - 128) / 64 : 0, kt1 = WIN ? min(T_, t0 + 256) / 64 : T_ / 64;
    f32x4 ot[4][2];
#pragma unroll
    for (int dm = 0; dm < 4; ++dm)
#pragma unroll
        for (int n = 0; n < 2; ++n) ot[dm][n] = (f32x4){0.f, 0.f, 0.f, 0.f};
    float mrun[2], lrun[2];
    float slope2 = 0.f;
    if (WIN) {
        const float sk = p.swa_sink[l * 4 + hq] * 1.4426950408889634f;
        mrun[0] = mrun[1] = sk; lrun[0] = lrun[1] = fq == 0 ? 1.f : 0.f;
        slope2 = exp2f(-2.f * (float)(hq + 1)) * 1.4426950408889634f;
    } else { mrun[0] = mrun[1] = -1e30f; lrun[0] = lrun[1] = 0.f; }
    const bf16_t* kbase = zb + OFF + 256 + g * 64;
    const bf16_t* vbase = zb + OFF + 384 + g * 64;
    u32x4 rk[2], rv[2];
    const int kkey = tid >> 2, kc = tid & 3, vkey = tid & 63, vc = tid >> 6;
    auto gload = [&](int kt) __attribute__((always_inline)) {
        const bf16_t* kp = kbase + (size_t)(kt * 64 + kkey) * DIN + kc * 16;
        rk[0] = *(const u32x4*)kp; rk[1] = *(const u32x4*)(kp + 8);
        const bf16_t* vp = vbase + (size_t)(kt * 64 + vkey) * DIN + vc * 16;
        rv[0] = *(const u32x4*)vp; rv[1] = *(const u32x4*)(vp + 8);
    };
    auto swrite = [&](int buf) __attribute__((always_inline)) {
        bf16_t* kd = Ks + (buf * 64 + kkey) * ALD + kc * 16;
        *(u32x4*)kd = rk[0]; *(u32x4*)(kd + 8) = rk[1];
        bf16_t* vd = Vt + (buf * 64 + vc * 16) * ALD + vkey;
#pragma unroll
        for (int h = 0; h < 2; ++h)
#pragma unroll
            for (int e = 0; e < 4; ++e) {
                vd[(h * 8 + 2 * e) * ALD] = (bf16_t)(rv[h][e] & 0xffffu);
                vd[(h * 8 + 2 * e + 1) * ALD] = (bf16_t)(rv[h][e] >> 16);
            }
    };
    __syncthreads();
    gload(kt0); swrite(0);
    __syncthreads();
    for (int kt = kt0; kt < kt1; ++kt) {
        const int buf = (kt - kt0) & 1;
        if (kt + 1 < kt1) gload(kt + 1);
        f32x4 st[4][2];
#pragma unroll
        for (int m = 0; m < 4; ++m)
#pragma unroll
            for (int n = 0; n < 2; ++n) st[m][n] = (f32x4){0.f, 0.f, 0.f, 0.f};
#pragma unroll
        for (int ks = 0; ks < 2; ++ks)
#pragma unroll
            for (int m = 0; m < 4; ++m) {
                const bf16x8 kf = *(const bf16x8*)(Ks + (buf * 64 + 16 * m + fr) * ALD + 32 * ks + 8 * fq);
#pragma unroll
                for (int n = 0; n < 2; ++n) st[m][n] = __builtin_amdgcn_mfma_f32_16x16x32_bf16(kf, qf[n][ks], st[m][n], 0, 0, 0);
            }
        if (WIN) {
#pragma unroll
            for (int m = 0; m < 4; ++m)
#pragma unroll
                for (int n = 0; n < 2; ++n)
#pragma unroll
                    for (int j = 0; j < 4; ++j) {
                        const int dist = abs((tw + 16 * n + fr) - (kt * 64 + 16 * m + 4 * fq + j));
                        st[m][n][j] = dist <= 128 ? st[m][n][j] - slope2 * (float)dist : -1e30f;
                    }
        }
#pragma unroll
        for (int n = 0; n < 2; ++n) {
            float mt = st[0][n][0];
#pragma unroll
            for (int m = 0; m < 4; ++m)
#pragma unroll
                for (int j = 0; j < 4; ++j) mt = fmaxf(mt, st[m][n][j]);
            mt = fmaxf(mt, __shfl_xor(mt, 16)); mt = fmaxf(mt, __shfl_xor(mt, 32));
            const float mn = fmaxf(mrun[n], mt);
            const float alpha = __builtin_amdgcn_exp2f(mrun[n] - mn);
            mrun[n] = mn;
            float lsum = 0.f;
#pragma unroll
            for (int m = 0; m < 4; ++m)
#pragma unroll
                for (int j = 0; j < 4; ++j) { const float pv = __builtin_amdgcn_exp2f(st[m][n][j] - mn); lsum += pv; st[m][n][j] = pv; }
            lrun[n] = lrun[n] * alpha + lsum;
#pragma unroll
            for (int dm = 0; dm < 4; ++dm) ot[dm][n] = ot[dm][n] * alpha;
        }
#pragma unroll
        for (int kk = 0; kk < 2; ++kk) {
            bf16x8 pf[2];
#pragma unroll
            for (int n = 0; n < 2; ++n) {
                u32x4 u;
                u[0] = pk2(st[2 * kk][n][0], st[2 * kk][n][1]); u[1] = pk2(st[2 * kk][n][2], st[2 * kk][n][3]);
                u[2] = pk2(st[2 * kk + 1][n][0], st[2 * kk + 1][n][1]); u[3] = pk2(st[2 * kk + 1][n][2], st[2 * kk + 1][n][3]);
                pf[n] = __builtin_bit_cast(bf16x8, u);
            }
#pragma unroll
            for (int dm = 0; dm < 4; ++dm) {
                const bf16_t* vp = Vt + (buf * 64 + 16 * dm + fr) * ALD + 32 * kk + 4 * fq;
                const u32x2 v0 = *(const u32x2*)vp, v1 = *(const u32x2*)(vp + 16);
                const bf16x8 vf = __builtin_bit_cast(bf16x8, (u32x4){v0[0], v0[1], v1[0], v1[1]});
#pragma unroll
                for (int n = 0; n < 2; ++n) ot[dm][n] = __builtin_amdgcn_mfma_f32_16x16x32_bf16(vf, pf[n], ot[dm][n], 0, 0, 0);
            }
        }
        if (kt + 1 < kt1) swrite(buf ^ 1);
        __syncthreads();
    }
#pragma unroll
    for (int n = 0; n < 2; ++n) {
        float lt = lrun[n];
        lt += __shfl_xor(lt, 16); lt += __shfl_xor(lt, 32);
        const float il = 1.f / lt;
        bf16_t* zr = zb + (size_t)(tw + 16 * n + fr) * DIN + OFF + hq * 64 + 4 * fq;
#pragma unroll
        for (int dm = 0; dm < 4; ++dm) {
            const u32x2 gu = *(const u32x2*)(zr + 512 + 16 * dm);
            float gv[4] = {__uint_as_float(gu[0] << 16), __uint_as_float(gu[0] & 0xffff0000u), __uint_as_float(gu[1] << 16), __uint_as_float(gu[1] & 0xffff0000u)};
            float ov[4];
#pragma unroll
            for (int j = 0; j < 4; ++j) ov[j] = ot[dm][n][j] * il * gv[j] * sigm(gv[j]);
            u32x2 o2; o2[0] = pk2(ov[0], ov[1]); o2[1] = pk2(ov[2], ov[3]);
            if (!dry) *(u32x2*)(zr + 16 * dm) = o2;
        }
    }
}

DEVI void gbar(unsigned* ctr, unsigned target) {
    asm volatile("s_waitcnt vmcnt(0)" ::: "memory");
    __syncthreads();
    if (threadIdx.x == 0) {
        __builtin_amdgcn_fence(__ATOMIC_RELEASE, "agent");
        asm volatile("s_waitcnt vmcnt(0)" ::: "memory");
        (void)__hip_atomic_fetch_add(ctr, 1u, __ATOMIC_RELAXED, __HIP_MEMORY_SCOPE_AGENT);
        while (__hip_atomic_load(ctr, __ATOMIC_RELAXED, __HIP_MEMORY_SCOPE_AGENT) < target) __builtin_amdgcn_s_sleep(1);
        __builtin_amdgcn_fence(__ATOMIC_ACQUIRE, "agent");
        asm volatile("s_waitcnt vmcnt(0)" ::: "memory");
    }
    __syncthreads();
}

enum { PH_CONVW, PH_ROWNORM, PH_GEMM1, PH_PREP, PH_RWKV, PH_LRU, PH_ATTNB, PH_ATTND, PH_POST, PH_GEMM2, PH_FINAL };
#ifndef MK_MULTI
#define MK_MULTI 0
#endif
#ifndef PROBE_PREP
#define PROBE_PREP 0
#endif
#ifndef PROBE_MIX
#define PROBE_MIX 0
#endif
#ifndef PROBE_G2
#define PROBE_G2 0
#endif
#if MK_MULTI
template <int PH>
__global__ void __launch_bounds__(256) kph(Params p, int l, int nitems) {
    extern __shared__ __attribute__((aligned(16))) char smem[];
    for (int item = blockIdx.x; item < nitems; item += gridDim.x) {
        if (PH == PH_CONVW) ph_convw(p, item, smem);
        if (PH == PH_ROWNORM) ph_rownorm(p, l, item);
        if (PH == PH_GEMM1) { if (item == (int)blockIdx.x) ph_gemm_all<0>(p, l, blockIdx.x, gridDim.x, smem); }
        if (PH == PH_PREP) ph_prep(p, l, item, smem);
        if (PH == PH_RWKV) ph_rwkv_scan(p, l, item, smem);
        if (PH == PH_LRU) ph_lru_scan(p, l, item);
        if (PH == PH_ATTNB) ph_attn_naive<0>(p, l, item);
        if (PH == PH_ATTND) ph_attn_naive<1>(p, l, item);
        if (PH == PH_POST) { if (item == (int)blockIdx.x) ph_post_all(p, l, blockIdx.x, gridDim.x); }
        if (PH == PH_GEMM2) { if (item == (int)blockIdx.x) ph_gemm_all<1>(p, l, blockIdx.x, gridDim.x, smem); }
        if (PH == PH_FINAL) ph_final(p, item);
    }
}
template <int PH>
static void launch(const Params& p, int l, int nitems, int lds, hipStream_t stream) {
    if (lds > 48 * 1024) (void)hipFuncSetAttribute((const void*)kph<PH>, hipFuncAttributeMaxDynamicSharedMemorySize, lds);
    int grid = nitems < 65536 ? nitems : 65536;
    hipLaunchKernelGGL(kph<PH>, dim3(grid), dim3(256), lds, stream, p, l, nitems);
}
#else
constexpr int MIX_ITEMS = 80 + 2560 + 2560;
__global__ void __launch_bounds__(256, 2) mega(Params p) {
    extern __shared__ __attribute__((aligned(16))) char smem[];
    __shared__ int s_item;
    cg::grid_group grid = cg::this_grid();
    const int G = gridDim.x, bid = blockIdx.x;
    unsigned nbar = 0;
    if (bid == 0 && threadIdx.x < 64) ws_ctr(p)[threadIdx.x] = 0;
    for (int it = bid; it < CW_ITEMS; it += G) ph_convw(p, it, smem);
    grid.sync();
    for (int l = 0; l < NL; ++l) {
        if (l == 0) {
            for (int it = bid; it < NTOK / 4; it += G) ph_rownorm(p, l, it);
            gbar(ws_gbar(p), (nbar += (unsigned)G));
        }
        ph_gemm_all<0>(p, l, bid, G, smem);
        gbar(ws_gbar(p), (nbar += (unsigned)G));
#if PROBE_PREP
        for (int it = bid; it < NTOK / 32; it += G) ph_prep(p, l, it, smem, true);
#endif
        for (int it = bid; it < NTOK / 32; it += G) ph_prep(p, l, it, smem);
        gbar(ws_gbar(p), (nbar += (unsigned)G));
#if PROBE_MIX
        for (int rep = 0; rep < 2; ++rep) {
        const bool dry = rep == 0;
        int* ctrp = &ws_ctr(p)[l + 4 * rep];
#else
        {
        const bool dry = false;
        int* ctrp = &ws_ctr(p)[l];
#endif
        for (int it = bid; it < 240; it += G) ph_rwkv_scan(p, l, it, smem, dry);
        for (;;) {
            __syncthreads();
            if (threadIdx.x == 0) s_item = atomicAdd(ctrp, 1);
            __syncthreads();
            const int it = s_item;
            if (it >= MIX_ITEMS) break;
            if (it < 80) ph_lru_scan(p, l, it, dry);
            else if (it < 2640) ph_attn<0>(p, l, it - 80, smem, dry);
            else ph_attn<1>(p, l, it - 2640, smem, dry);
        }
        }
        gbar(ws_gbar(p), (nbar += (unsigned)G));
        ph_post_all(p, l, bid, G);
        gbar(ws_gbar(p), (nbar += (unsigned)G));
#if PROBE_G2
        ph_gemm_all<1>(p, l, bid, G, smem, true);
#endif
        ph_gemm_all<1>(p, l, bid, G, smem);
        gbar(ws_gbar(p), (nbar += (unsigned)G));
    }
    for (int it = bid; it < NTOK / 4; it += G) ph_final(p, it);
}
#endif

extern "C" void kernel_launch(void* const* d_in, const int* in_sizes, int n_in, void* d_out, int out_size, void* d_ws, size_t ws_size,
                              hipStream_t stream) {
    Params p{};
    const float* const* in = (const float* const*)d_in;
    p.x_prompt = in[0]; p.x_sample = in[1]; p.norm_g = in[2]; p.w_in = in[3]; p.w_out = in[4]; p.rwkv_shift = in[5]; p.rwkv_w0 = in[6];
    p.rwkv_w_up = in[7]; p.rwkv_a0 = in[8]; p.rwkv_a_up = in[9]; p.rwkv_k_k = in[10]; p.rwkv_k_a = in[11]; p.rwkv_r_k = in[12];
    p.rwkv_ln_g = in[13]; p.rwkv_ln_b = in[14]; p.attn_q_norm = in[15]; p.attn_k_norm = in[16]; p.lru_conv_w = in[17]; p.lru_conv_b = in[18];
    p.lru_gate_w = in[19]; p.lru_gate_b = in[20]; p.lru_lambda = in[21]; p.swa_sink = in[22]; p.final_g = in[23];
    p.out = (float*)d_out;
    p.ws = (char*)d_ws;
    if (WS_NEED > ws_size) { fprintf(stderr, "workspace too small: need %zu have %zu\n", (size_t)WS_NEED, ws_size); }

#if MK_MULTI
    launch<PH_CONVW>(p, 0, CW_ITEMS, 64 * 65 * 4, stream);
    for (int l = 0; l < NL; ++l) {
        if (l == 0) launch<PH_ROWNORM>(p, l, NTOK / 4, 0, stream);
        launch<PH_GEMM1>(p, l, (NTOK / GBM) * (DIN / GBN), GEMM_LDS, stream);
        launch<PH_PREP>(p, l, NTOK / 32, PREP_LDS, stream);
        launch<PH_RWKV>(p, l, 240, 4 * 5120, stream);
        launch<PH_LRU>(p, l, 80, 0, stream);
        launch<PH_ATTNB>(p, l, 1280, 0, stream);
        launch<PH_ATTND>(p, l, 1280, 0, stream);
        launch<PH_POST>(p, l, NTOK / 8, 0, stream);
        launch<PH_GEMM2>(p, l, (NTOK / GBM) * (DM / GBN), GEMM_LDS, stream);
    }
    launch<PH_FINAL>(p, 0, NTOK / 4, 0, stream);
#else
    constexpr size_t kDynLds = GEMM_LDS;
    static int grid_blocks = 0;
    if (!grid_blocks) {
        (void)hipFuncSetAttribute((const void*)mega, hipFuncAttributeMaxDynamicSharedMemorySize, (int)kDynLds);
        int dev = 0, cus = 0, per_cu = 0;
        (void)hipGetDevice(&dev);
        (void)hipDeviceGetAttribute(&cus, hipDeviceAttributeMultiprocessorCount, dev);
        (void)hipOccupancyMaxActiveBlocksPerMultiprocessor(&per_cu, mega, 256, kDynLds);
        if (per_cu < 1) per_cu = 1;
        grid_blocks = cus * per_cu;
    }
    (void)hipMemsetAsync((char*)d_ws + WO_GBAR, 0, 256, stream);
    void* args[] = {&p};
    hipError_t e = hipLaunchCooperativeKernel((void*)mega, dim3(grid_blocks), dim3(256), args, kDynLds, stream);
    if (e != hipSuccess) fprintf(stderr, "cooperative launch failed: %s (grid %d)\n", hipGetErrorString(e), grid_blocks);
#endif
}
```

```cpp
#include <hip/hip_runtime.h>
#include <hip/hip_cooperative_groups.h>
#include <cstdio>
#include <cstdint>
namespace cg = cooperative_groups;

#define DEVI __device__ __forceinline__
typedef unsigned short bf16_t;
typedef short bf16x8 __attribute__((ext_vector_type(8)));
typedef float f32x4 __attribute__((ext_vector_type(4)));

constexpr int T_ = 2048, NB_ = 40, NTOK = NB_ * T_, DM = 1024, DIN = 3200, NL = 4;
constexpr int NPROMPT = 32 * T_;
constexpr size_t SA_EL = (size_t)NTOK * 256;
constexpr int OFF_A = 0, OFF_B = 1152, OFF_C = 1920, OFF_D = 2432;

struct Params {
    const float *x_prompt, *x_sample, *norm_g, *w_in, *w_out, *rwkv_shift, *rwkv_w0, *rwkv_w_up, *rwkv_a0, *rwkv_a_up,
        *rwkv_k_k, *rwkv_k_a, *rwkv_r_k, *rwkv_ln_g, *rwkv_ln_b, *attn_q_norm, *attn_k_norm, *lru_conv_w, *lru_conv_b,
        *lru_gate_w, *lru_gate_b, *lru_lambda, *swa_sink, *final_g;
    float* out;
    char* ws;
};
constexpr size_t al256(size_t x) { return (x + 255) & ~(size_t)255; }
constexpr size_t WO_WT_IN = 0;
constexpr size_t WO_WT_OUT = WO_WT_IN + al256((size_t)NL * DIN * DM * 2);
constexpr size_t WO_XB = WO_WT_OUT + al256((size_t)NL * DM * DM * 2);
constexpr size_t WO_Z = WO_XB + al256((size_t)NTOK * DM * 2);
constexpr size_t WO_SR = WO_Z + al256((size_t)NTOK * DIN * 2);
constexpr size_t WO_SK = WO_SR + SA_EL * 2, WO_SV = WO_SK + SA_EL * 2, WO_SKK = WO_SV + SA_EL * 2, WO_SA0 = WO_SKK + SA_EL * 2, WO_SW0 = WO_SA0 + 2 * SA_EL * 2;
constexpr size_t WO_CTR = WO_SW0 + 2 * SA_EL * 2;
constexpr size_t WO_WUP = WO_CTR + 256, WO_AUP = WO_WUP + (size_t)NL * 2 * 256 * 64 * 2, WO_GW = WO_AUP + (size_t)NL * 2 * 256 * 64 * 2, WO_ROPE = WO_GW + (size_t)NL * 16 * 4096 * 2;
constexpr size_t WO_GBAR = WO_ROPE + 2048 * 4;
constexpr size_t WO_PART = WO_GBAR + 256;
constexpr size_t WS_NEED = WO_PART + (size_t)NTOK * 16 * 4;
#define WSF(name, T, off) DEVI T* ws_##name(const Params& p) { return (T*)(p.ws + (off)); }
WSF(wt_in, bf16_t, WO_WT_IN) WSF(wt_out, bf16_t, WO_WT_OUT) WSF(xb, bf16_t, WO_XB) WSF(z, bf16_t, WO_Z) WSF(sR, bf16_t, WO_SR) WSF(sK, bf16_t, WO_SK)
WSF(sV, bf16_t, WO_SV) WSF(sKK, bf16_t, WO_SKK) WSF(sA0, bf16_t, WO_SA0) WSF(sW0, bf16_t, WO_SW0) WSF(la, bf16_t, WO_XB) WSF(h0, bf16_t, WO_XB + 2 * SA_EL * 2)
WSF(ctr, int, WO_CTR) WSF(gbar, unsigned, WO_GBAR) WSF(part, float, WO_PART) WSF(wup_t, bf16_t, WO_WUP) WSF(aup_t, bf16_t, WO_AUP) WSF(gw_t, bf16_t, WO_GW) WSF(rope, float, WO_ROPE)

DEVI float bf2f(bf16_t h) { return __uint_as_float(((unsigned)h) << 16); }
DEVI bf16_t f2bf(float f) { return __builtin_bit_cast(bf16_t, (__bf16)f); }
typedef float f2 __attribute__((ext_vector_type(2)));
typedef __bf16 b2_t __attribute__((ext_vector_type(2)));
DEVI unsigned pk2(float lo, float hi) { f2 v = {lo, hi}; return __builtin_bit_cast(unsigned, __builtin_convertvector(v, b2_t)); }
typedef unsigned u32x4 __attribute__((ext_vector_type(4)));
typedef unsigned u32x2 __attribute__((ext_vector_type(2)));
DEVI float sigm(float x) { return 1.f / (1.f + __expf(-x)); }
DEVI float dpp_f(float v, int) { return v; }
template <int CTRL> DEVI float dppx(float v) { return __builtin_bit_cast(float, __builtin_amdgcn_update_dpp(0, __builtin_bit_cast(int, v), CTRL, 0xf, 0xf, true)); }
DEVI float wave_sum(float v) {
    v += dppx<0xB1>(v);
    v += dppx<0x4E>(v);
    v += dppx<0x141>(v);
    v += dppx<0x140>(v);
    v += __shfl_xor(v, 16); v += __shfl_xor(v, 32);
    return v;
}
DEVI float rdl(float v, int j) { return __builtin_bit_cast(float, __builtin_amdgcn_readlane(__builtin_bit_cast(int, v), j)); }
DEVI const float* xrow(const Params& p, int l, int m) {
    if (l > 0) return p.out + (size_t)m * DM;
    const float* xp = p.x_prompt; const float* xs = p.x_sample;
    const long delta = (xs - xp) - (long)NPROMPT * DM;
    return xp + (size_t)m * DM + (m >= NPROMPT ? delta : (long)0);
}

DEVI int tidx() { int t = threadIdx.x; asm volatile("" : "+v"(t)); return t; }
constexpr int CW_PER_L = 1088, CW_ITEMS = NL * CW_PER_L + 1;
DEVI void ph_convw(const Params& p, int item, char* smem) {
    float* tile = (float*)smem;
    if (item == NL * CW_PER_L) {
        for (int e = tidx(); e < 1024; e += 256) {
            const int pos = e >> 4, i = e & 15;
            const float inv = exp2f(-(float)i * (13.287712379549449f / 16.f));
            const float ang = (float)pos * inv;
            ws_rope(p)[2 * e] = cosf(ang); ws_rope(p)[2 * e + 1] = sinf(ang);
        }
        return;
    }
    const int l = item / CW_PER_L; int r = item % CW_PER_L;
    const float* src; bf16_t* dst; int N, K, k0, n0;
    if (r < 800) { src = p.w_in + (size_t)l * DM * DIN; dst = ws_wt_in(p) + (size_t)l * DIN * DM; N = DIN; K = DM; k0 = (r / 50) * 64; n0 = (r % 50) * 64; }
    else if (r < 1056) { r -= 800; src = p.w_out + (size_t)l * DM * DM; dst = ws_wt_out(p) + (size_t)l * DM * DM; N = DM; K = DM; k0 = (r / 16) * 64; n0 = (r % 16) * 64; }
    else if (r < 1072) { r -= 1056; const int d = (r >> 2) & 1, up = r >> 3; const size_t o = (size_t)(l * 2 + d) * 64 * 256;
        src = (up ? p.rwkv_a_up : p.rwkv_w_up) + o; dst = (up ? ws_aup_t(p) : ws_wup_t(p)) + o; N = 256; K = 64; k0 = 0; n0 = (r & 3) * 64; }
    else { r -= 1072; const size_t o = (size_t)(l * 16 + r) * 4096; src = p.lru_gate_w + o; dst = ws_gw_t(p) + o; N = 64; K = 64; k0 = 0; n0 = 0; }
    int tx = tidx() & 63, ty = tidx() >> 6;
    __syncthreads();
    for (int i = 0; i < 16; ++i) { int k = ty + 4 * i; tile[k * 65 + tx] = src[(size_t)(k0 + k) * N + n0 + tx]; }
    __syncthreads();
    for (int i = 0; i < 16; ++i) { int n = ty + 4 * i; dst[(size_t)(n0 + n) * K + k0 + tx] = f2bf(tile[tx * 65 + n]); }
}

DEVI void ph_rownorm(const Params& p, int l, int item) {
    int w = tidx() >> 6, lane = tidx() & 63;
    int m = item * 4 + w;
    const float* x = xrow(p, l, m);
    const float* g = p.norm_g + l * DM;
    float4 v[4]; float ss = 0.f;
#pragma unroll
    for (int i = 0; i < 4; ++i) { v[i] = *(const float4*)(x + lane * 4 + 256 * i); ss += v[i].x * v[i].x + v[i].y * v[i].y + v[i].z * v[i].z + v[i].w * v[i].w; }
    ss = wave_sum(ss);
    if (lane < 16) ws_part(p)[(size_t)m * 16 + lane] = lane == 0 ? ss : 0.f;
#pragma unroll
    for (int i = 0; i < 4; ++i) {
        float4 gg = *(const float4*)(g + lane * 4 + 256 * i);
        uint2 o; o.x = pk2(v[i].x * gg.x, v[i].y * gg.y); o.y = pk2(v[i].z * gg.z, v[i].w * gg.w);
        *(uint2*)(ws_xb(p) + (size_t)m * DM + lane * 4 + 256 * i) = o;
    }
}

DEVI void ph_final(const Params& p, int item) {
    int w = tidx() >> 6, lane = tidx() & 63;
    int m = item * 4 + w;
    float* x = p.out + (size_t)m * DM;
    float4 v[4]; float ss = 0.f;
#pragma unroll
    for (int i = 0; i < 4; ++i) { v[i] = *(const float4*)(x + lane * 4 + 256 * i); ss += v[i].x * v[i].x + v[i].y * v[i].y + v[i].z * v[i].z + v[i].w * v[i].w; }
    ss = wave_sum(ss);
    float rs = rsqrtf(ss * (1.f / DM) + 1e-6f);
#pragma unroll
    for (int i = 0; i < 4; ++i) {
        float4 gg = *(const float4*)(p.final_g + lane * 4 + 256 * i);
        float4 o; o.x = v[i].x * rs * gg.x; o.y = v[i].y * rs * gg.y; o.z = v[i].z * rs * gg.z; o.w = v[i].w * rs * gg.w;
        *(float4*)(x + lane * 4 + 256 * i) = o;
    }
}

constexpr int GBM = 128, GBN = 128, GBK = 64, GLD = 72;
constexpr int GEMM_LDS = 2 * 2 * 128 * GLD * 2;
template <int EPI>
DEVI void ph_gemm_all(const Params& p, int l, int bid, int G, char* smem, bool dry = false) {
    constexpr int NT = EPI == 0 ? DIN / GBN : DM / GBN;
    constexpr int NTILES = (NTOK / GBM) * NT;
    if (bid >= NTILES) return;
#define G_COORDS(item_, r0_, c0_, pn_) { const int xcd_ = (item_) & 7, jx_ = (item_) >> 3; const int rg_ = jx_ / (8 * NT), wi_ = jx_ % (8 * NT); \
        pn_ = wi_ >> 3; r0_ = (xcd_ * 80 + rg_ * 8 + (wi_ & 7)) * GBM; c0_ = pn_ * GBN; }
    const bf16_t* A = EPI == 0 ? ws_xb(p) : ws_z(p);
    const int lda = EPI == 0 ? DM : DIN;
    const bf16_t* Bt = EPI == 0 ? ws_wt_in(p) + (size_t)l * DIN * DM : ws_wt_out(p) + (size_t)l * DM * DM;
    bf16_t* As = (bf16_t*)smem;
    bf16_t* Bs = As + 2 * 128 * GLD;
    const int tid = tidx(), wid = tid >> 6, lane = tid & 63, wr = wid >> 1, wc = wid & 1, fr = lane & 15, fq = lane >> 4;
    int item = bid, row0, col0, pn, nrow0 = 0, ncol0 = 0, npn = 0;
    G_COORDS(item, row0, col0, pn)
    bool hasn = item + G < NTILES;
    nrow0 = row0; ncol0 = col0; npn = pn;
    if (hasn) G_COORDS(item + G, nrow0, ncol0, npn)
    f32x4 acc[4][4];
#pragma unroll
    for (int m = 0; m < 4; ++m)
#pragma unroll
        for (int n = 0; n < 4; ++n) acc[m][n] = (f32x4){0.f, 0.f, 0.f, 0.f};
    u32x4 ra0[4], rb0[4], ra1[4], rb1[4];
    auto aoff = [&](int kt) __attribute__((always_inline)) -> int {
        if (EPI == 0) return kt * 64;
        const int blk = kt >> 2;
        const int bo = blk == 0 ? OFF_A : blk == 1 ? OFF_B : blk == 2 ? OFF_C : OFF_D;
        return bo + (kt & 3) * 64;
    };
    const int lr = tid >> 3, lch = (tid & 7) * 8;
    const unsigned va0 = (unsigned)(lr * lda + lch) * 2u, vb0 = (unsigned)(lr * DM + lch) * 2u;
    const unsigned vas = (unsigned)(32 * lda) * 2u, vbs = (unsigned)(32 * DM) * 2u;
#define G_LOAD1(ra, rb, i) ra[i] = *(const u32x4*)(ab_ + (va0 + (i) * vas)); rb[i] = *(const u32x4*)(bb_ + (vb0 + (i) * vbs));
#define G_LOAD(ra, rb, r0_, c0_, kt_) { const char* ab_ = (const char*)(A + (size_t)(r0_) * lda + aoff(kt_)); const char* bb_ = (const char*)(Bt + (size_t)(c0_) * DM + (kt_) * 64); \
        G_LOAD1(ra, rb, 0) G_LOAD1(ra, rb, 1) G_LOAD1(ra, rb, 2) G_LOAD1(ra, rb, 3) }
#define S_WRITE1(ra, rb, buf_, i) *(u32x4*)(As + ((buf_) * 128 + lr + 32 * (i)) * GLD + lch) = ra[i]; *(u32x4*)(Bs + ((buf_) * 128 + lr + 32 * (i)) * GLD + lch) = rb[i];
#define S_WRITE(ra, rb, buf_) { S_WRITE1(ra, rb, buf_, 0) S_WRITE1(ra, rb, buf_, 1) S_WRITE1(ra, rb, buf_, 2) S_WRITE1(ra, rb, buf_, 3) }
#define G_COMPUTE_W(buf_, ra, rb, wbuf_, dow_) { \
    bf16x8 af[2][4], bfr[2][4]; \
    _Pragma("unroll") for (int ks = 0; ks < 2; ++ks) { \
        _Pragma("unroll") for (int m = 0; m < 4; ++m) af[ks][m] = *(const bf16x8*)(As + ((buf_) * 128 + wr * 64 + m * 16 + fr) * GLD + ks * 32 + fq * 8); \
        _Pragma("unroll") for (int n = 0; n < 4; ++n) bfr[ks][n] = *(const bf16x8*)(Bs + ((buf_) * 128 + wc * 64 + n * 16 + fr) * GLD + ks * 32 + fq * 8); \
    } \
    if (dow_) S_WRITE(ra, rb, wbuf_) \
    __builtin_amdgcn_s_setprio(1); \
    _Pragma("unroll") for (int ks = 0; ks < 2; ++ks) \
        _Pragma("unroll") for (int m = 0; m < 4; ++m) \
            _Pragma("unroll") for (int n = 0; n < 4; ++n) acc[m][n] = __builtin_amdgcn_mfma_f32_16x16x32_bf16(bfr[ks][n], af[ks][m], acc[m][n], 0, 0, 0); \
    __builtin_amdgcn_s_setprio(0); }
    constexpr int NK = DM / GBK;
    __syncthreads();
    G_LOAD(ra0, rb0, row0, col0, 0) G_LOAD(ra1, rb1, row0, col0, 1)
    S_WRITE(ra0, rb0, 0)
    G_LOAD(ra0, rb0, row0, col0, 2)
    __syncthreads();
#pragma unroll 1
    for (;;) {
#pragma unroll 1
        for (int kt = 0; kt < NK; kt += 2) {
            G_COMPUTE_W(0, ra1, rb1, 1, true)
            __syncthreads();
            { const bool nx = kt + 3 >= NK; const int r_ = nx ? nrow0 : row0, c_ = nx ? ncol0 : col0, k_ = nx ? kt + 3 - NK : kt + 3; G_LOAD(ra1, rb1, r_, c_, k_) }
            G_COMPUTE_W(1, ra0, rb0, 0, true)
            __syncthreads();
            { const bool nx = kt + 4 >= NK; const int r_ = nx ? nrow0 : row0, c_ = nx ? ncol0 : col0, k_ = nx ? kt + 4 - NK : kt + 4; G_LOAD(ra0, rb0, r_, c_, k_) }
        }
        f32x4 ggn[4];
        if (EPI == 1 && !dry && l + 1 < NL) {
#pragma unroll
            for (int n = 0; n < 4; ++n) ggn[n] = *(const f32x4*)(p.norm_g + (l + 1) * DM + col0 + wc * 64 + n * 16 + fq * 4);
        }
#pragma unroll
        for (int mh = 0; mh < 2; ++mh) {
            float rsm[2] = {1.f, 1.f};
            f32x4 xres[2][4];
            if (EPI == 0) {
                f32x4 q[2][4];
#pragma unroll
                for (int mm = 0; mm < 2; ++mm) {
                    const f32x4* pp = (const f32x4*)(ws_part(p) + (size_t)(row0 + wr * 64 + (2 * mh + mm) * 16 + fr) * 16);
#pragma unroll
                    for (int k = 0; k < 4; ++k) q[mm][k] = pp[k];
                }
#pragma unroll
                for (int mm = 0; mm < 2; ++mm) {
                    const f32x4 t = (q[mm][0] + q[mm][1]) + (q[mm][2] + q[mm][3]);
                    rsm[mm] = rsqrtf(((t[0] + t[1]) + (t[2] + t[3])) * (1.f / DM) + 1e-6f);
                }
            } else if (!dry) {
#pragma unroll
                for (int mm = 0; mm < 2; ++mm)
#pragma unroll
                    for (int n = 0; n < 4; ++n) xres[mm][n] = *(const f32x4*)(xrow(p, l, row0 + wr * 64 + (2 * mh + mm) * 16 + fr) + col0 + wc * 64 + n * 16 + fq * 4);
            }
#pragma unroll
            for (int mm = 0; mm < 2; ++mm) {
                const int m = 2 * mh + mm;
                const int row = row0 + wr * 64 + m * 16 + fr;
                const float rs = rsm[mm];
                float ssq = 0.f;
#pragma unroll
                for (int n = 0; n < 4; ++n) {
                    const int col = col0 + wc * 64 + n * 16 + fq * 4;
                    if (dry) { if (acc[m][n][0] == 1.2345e30f) ws_ctr(p)[63] = 1; }
                    else if (EPI == 0) {
                        uint2 o; o.x = pk2(acc[m][n][0] * rs, acc[m][n][1] * rs); o.y = pk2(acc[m][n][2] * rs, acc[m][n][3] * rs);
                        *(uint2*)(ws_z(p) + (size_t)row * DIN + col) = o;
                    } else {
                        const f32x4 o = xres[mm][n] + acc[m][n];
                        *(f32x4*)(p.out + (size_t)row * DM + col) = o;
                        ssq += (o[0] * o[0] + o[1] * o[1]) + (o[2] * o[2] + o[3] * o[3]);
                        if (l + 1 < NL) {
                            const f32x4 og = o * ggn[n];
                            uint2 ob; ob.x = pk2(og[0], og[1]); ob.y = pk2(og[2], og[3]);
                            *(uint2*)(ws_xb(p) + (size_t)row * DM + col) = ob;
                        }
                    }
                }
                if (EPI == 1 && !dry) {
                    ssq += __shfl_xor(ssq, 16); ssq += __shfl_xor(ssq, 32);
                    if (fq == 0) ws_part(p)[(size_t)row * 16 + pn * 2 + wc] = ssq;
                }
            }
        }
        if (!hasn) break;
#pragma unroll
        for (int m = 0; m < 4; ++m)
#pragma unroll
            for (int n = 0; n < 4; ++n) acc[m][n] = (f32x4){0.f, 0.f, 0.f, 0.f};
        item += G; row0 = nrow0; col0 = ncol0; pn = npn;
        hasn = item + G < NTILES;
        if (hasn) G_COORDS(item + G, nrow0, ncol0, npn)
    }
#undef G_LOAD
#undef S_WRITE
#undef G_LOAD1
#undef S_WRITE1
#undef G_COMPUTE_W
#undef G_COORDS
}

constexpr int XLD = 264, LLD = 72;
constexpr int PREP_LDS = 64 * XLD * 2 + 2 * 64 * LLD * 2;
DEVI float ropeT(f2 cs, float x, int d) {
    const int e = d & 31;
    const float pr = __shfl_xor(x, 16);
    return (e < 16) ? x * cs.x - pr * cs.y : pr * cs.y + x * cs.x;
}
DEVI void ph_prep(const Params& p, int l, int item, char* smem, bool dry = false) {
    bf16_t* xc_s = (bf16_t*)smem;
    bf16_t* wl_s = xc_s + 64 * XLD;
    bf16_t* al_s = wl_s + 64 * LLD;
    const int tid = tidx(), w = tid >> 6, lane = tid & 63, fr = lane & 15, fq = lane >> 4;
    const int b = item >> 6, t0 = (item & 63) * 32;
    const size_t mbase = (size_t)b * T_ + t0;
    bf16_t* zt = ws_z(p) + mbase * DIN;
    __syncthreads();
    {
        const float* sh = p.rwkv_shift + l * 2 * 896;
        float s0[4], s1[4], pv[4], cu[4];
#pragma unroll
        for (int s_ = 0; s_ < 4; ++s_) {
            const int c = tid + 256 * s_;
            const bool ok = c < 896;
            s0[s_] = ok ? sh[c] : 0.f; s1[s_] = ok ? sh[896 + c] : 0.f;
            pv[s_] = (ok && t0 > 0) ? bf2f(zt[c - DIN]) : 0.f;
            cu[s_] = ok ? bf2f(zt[c]) : 0.f;
        }
        const float kkw = p.rwkv_k_k[l * 256 + tid];
        float cw[4];
#pragma unroll
        for (int jj = 0; jj < 4; ++jj) cw[jj] = p.lru_conv_w[(l * 4 + jj) * 256 + tid];
        const float cb = p.lru_conv_b[l * 256 + tid];
        float xm2 = t0 >= 2 ? bf2f(zt[OFF_C + tid - 2 * DIN]) : 0.f, xm1 = t0 >= 1 ? bf2f(zt[OFF_C + tid - DIN]) : 0.f, x0 = bf2f(zt[OFF_C + tid]);
        const float qnw = p.attn_q_norm[l * 64 + lane], knw = p.attn_k_norm[l * 64 + lane];
        const bool c3 = tid < 128;
        bf16_t nA[2][4][4], nC[2][4], qB[2][4], kB[2][4];
        f2 cs8[2][4];
#define PREP_LOADG(B_, G_) { \
            _Pragma("unroll") for (int i8 = 0; i8 < 4; ++i8) { \
                const int tt = (G_) * 4 + i8; \
                const bf16_t* zr = zt + (size_t)tt * DIN; \
                const bool hasn = t0 + tt + 1 < T_; \
                _Pragma("unroll") for (int s_ = 0; s_ < 4; ++s_) nA[B_][i8][s_] = (hasn && (s_ < 3 || c3)) ? zr[tid + 256 * s_ + DIN] : (bf16_t)0; \
                nC[B_][i8] = hasn ? zr[OFF_C + tid + DIN] : (bf16_t)0; \
                qB[B_][i8] = zr[OFF_B + tid]; \
                kB[B_][i8] = c3 ? zr[OFF_B + 256 + tid] : (bf16_t)0; \
                cs8[B_][i8] = *(const f2*)(ws_rope(p) + 2 * (((lane >> 5) ? (t0 & 63) + tt : (t0 >> 6)) * 16 + (lane & 15))); \
            } }
#define PREP_COMPG(B_, G_) { \
            _Pragma("unroll") for (int i8 = 0; i8 < 4; ++i8) { \
                const int tt = (G_) * 4 + i8; \
                bf16_t* zr = zt + (size_t)tt * DIN; \
                float xs[4]; \
                _Pragma("unroll") for (int s_ = 0; s_ < 4; ++s_) { \
                    const float nx = bf2f(nA[B_][i8][s_]); \
                    xs[s_] = cu[s_] + s0[s_] * (pv[s_] - cu[s_]) + s1[s_] * (nx - cu[s_]); \
                    pv[s_] = cu[s_]; cu[s_] = nx; \
                } \
                const size_t o = (mbase + tt) * 256 + tid; \
                const float kkv = xs[1] * kkw; \
                const float ss = wave_sum(kkv * kkv); \
                ws_sR(p)[o] = f2bf(xs[0]); ws_sK(p)[o] = f2bf(xs[1]); ws_sV(p)[o] = f2bf(xs[2]); ws_sKK(p)[o] = f2bf(kkv * rsqrtf(fmaxf(ss, 1e-24f))); \
                if (tid < 64) wl_s[tt * LLD + tid] = f2bf(1.f - 2.f / (1.f + __expf(2.f * xs[3]))); \
                else if (tid < 128) al_s[tt * LLD + tid - 64] = f2bf(xs[3]); \
                const float xp1 = bf2f(nC[B_][i8]); \
                xc_s[tt * XLD + tid] = f2bf(cb + cw[0] * xm2 + cw[1] * xm1 + cw[2] * x0 + cw[3] * xp1); \
                xm2 = xm1; xm1 = x0; x0 = xp1; \
                const float q = bf2f(qB[B_][i8]); \
                const float s2 = wave_sum(q * q); \
                const float qn = ropeT(cs8[B_][i8], q * rsqrtf(s2 * (1.f / 64.f) + 1e-6f) * qnw, lane) * (0.125f * 1.4426950408889634f); \
                if (!dry) zr[OFF_B + tid] = f2bf(qn); \
                if (c3) { \
                    const float kx = bf2f(kB[B_][i8]); \
                    const float s3 = wave_sum(kx * kx); \
                    const float kro = ropeT(cs8[B_][i8], kx * rsqrtf(s3 * (1.f / 64.f) + 1e-6f) * knw, lane); \
                    if (!dry) zr[OFF_B + 256 + tid] = f2bf(kro); \
                } \
            } }
        PREP_LOADG(0, 0)
#pragma unroll 1
        for (int g = 0; g < 8; g += 2) {
            PREP_LOADG(1, g + 1)
            PREP_COMPG(0, g)
            if (g + 2 < 8) PREP_LOADG(0, g + 2)
            PREP_COMPG(1, g + 1)
        }
#undef PREP_LOADG
#undef PREP_COMPG
    }
    __syncthreads();
#pragma unroll 1
    for (int dm = 0; dm < 4; ++dm) {
        const int d = dm >> 1, mat = dm & 1;
        const bf16_t* Bt = (mat ? ws_aup_t(p) : ws_wup_t(p)) + ((size_t)(l * 2 + d) * 256 + 64 * w) * 64;
        bf16x8 bfr[4][2];
#pragma unroll
        for (int nt = 0; nt < 4; ++nt)
#pragma unroll
            for (int ks = 0; ks < 2; ++ks) bfr[nt][ks] = *(const bf16x8*)(Bt + (16 * nt + fr) * 64 + 32 * ks + 8 * fq);
        const bf16_t* As = mat ? al_s : wl_s;
        const float* bias = (mat ? p.rwkv_a0 : p.rwkv_w0) + (l * 2 + d) * 256 + 64 * w + 4 * fq;
        bf16_t* dst = (mat ? ws_sA0(p) : ws_sW0(p)) + d * SA_EL + mbase * 256 + 64 * w + 4 * fq;
        f32x4 bvh[4];
#pragma unroll
        for (int nt = 0; nt < 4; ++nt) bvh[nt] = *(const f32x4*)(bias + 16 * nt);
#pragma unroll 1
        for (int m = 0; m < 2; ++m) {
            bf16x8 af[2];
#pragma unroll
            for (int ks = 0; ks < 2; ++ks) af[ks] = *(const bf16x8*)(As + (16 * m + fr) * LLD + 32 * ks + 8 * fq);
#pragma unroll
            for (int nt = 0; nt < 4; ++nt) {
                f32x4 acc = (f32x4){0.f, 0.f, 0.f, 0.f};
#pragma unroll
                for (int ks = 0; ks < 2; ++ks) acc = __builtin_amdgcn_mfma_f32_16x16x32_bf16(bfr[nt][ks], af[ks], acc, 0, 0, 0);
                const f32x4 bv = bvh[nt];
                float ov[4];
#pragma unroll
                for (int jj = 0; jj < 4; ++jj) {
                    const float sg = sigm(acc[jj] + bv[jj]);
                    ov[jj] = mat ? sg : 1.f - __expf(-0.6065306597126334f * sg);
                }
                u32x2 o2; o2[0] = pk2(ov[0], ov[1]); o2[1] = pk2(ov[2], ov[3]);
                *(u32x2*)(dst + (size_t)(16 * m + fr) * 256 + 16 * nt) = o2;
            }
        }
    }
#pragma unroll 1
    for (int d = 0; d < 2; ++d) {
        bf16x8 bfr[2][4][2];
#pragma unroll
        for (int k = 0; k < 2; ++k)
#pragma unroll
            for (int nt = 0; nt < 4; ++nt)
#pragma unroll
                for (int ks = 0; ks < 2; ++ks)
                    bfr[k][nt][ks] = *(const bf16x8*)(ws_gw_t(p) + ((size_t)(((l * 2 + d) * 2 + k) * 4 + w) * 64 + 16 * nt + fr) * 64 + 32 * ks + 8 * fq);
        const int e00 = 64 * w + 4 * fq;
        f32x4 gb0h[4], gb1h[4], sph[4];
#pragma unroll
        for (int nt = 0; nt < 4; ++nt) {
            const int e0 = e00 + 16 * nt;
            gb0h[nt] = *(const f32x4*)(p.lru_gate_b + ((l * 2 + d) * 2 + 0) * 256 + e0); gb1h[nt] = *(const f32x4*)(p.lru_gate_b + ((l * 2 + d) * 2 + 1) * 256 + e0);
            const f32x4 lam = *(const f32x4*)(p.lru_lambda + (l * 2 + d) * 256 + e0);
#pragma unroll
            for (int jj = 0; jj < 4; ++jj) sph[nt][jj] = __logf(1.f + __expf(-lam[jj]));
        }
#pragma unroll 1
        for (int m = 0; m < 2; ++m) {
            bf16x8 af[2];
#pragma unroll
            for (int ks = 0; ks < 2; ++ks) af[ks] = *(const bf16x8*)(xc_s + (16 * m + fr) * XLD + 64 * w + 32 * ks + 8 * fq);
#pragma unroll
            for (int nt = 0; nt < 4; ++nt) {
                f32x4 g0 = (f32x4){0.f, 0.f, 0.f, 0.f}, g1 = g0;
#pragma unroll
                for (int ks = 0; ks < 2; ++ks) {
                    g0 = __builtin_amdgcn_mfma_f32_16x16x32_bf16(bfr[0][nt][ks], af[ks], g0, 0, 0, 0);
                    g1 = __builtin_amdgcn_mfma_f32_16x16x32_bf16(bfr[1][nt][ks], af[ks], g1, 0, 0, 0);
                }
                const int e0 = e00 + 16 * nt;
                const f32x4 gb0 = gb0h[nt], gb1 = gb1h[nt];
                const u32x2 xu = *(const u32x2*)(xc_s + (16 * m + fr) * XLD + e0);
                const float xv[4] = {__uint_as_float(xu[0] << 16), __uint_as_float(xu[0] & 0xffff0000u), __uint_as_float(xu[1] << 16), __uint_as_float(xu[1] & 0xffff0000u)};
                float a1[4], bt[4];
#pragma unroll
                for (int jj = 0; jj < 4; ++jj) {
                    const float r = sigm(g0[jj] + gb0[jj]), ig = sigm(g1[jj] + gb1[jj]);
                    const float sp = sph[nt][jj];
                    const float a = __expf(-8.f * r * sp);
                    a1[jj] = 1.f - a;
                    bt[jj] = sqrtf(a1[jj] * (1.f + a)) * ig * xv[jj];
                }
                const size_t o = d * SA_EL + (mbase + 16 * m + fr) * 256 + e0;
                u32x2 oa; oa[0] = pk2(a1[0], a1[1]); oa[1] = pk2(a1[2], a1[3]);
                u32x2 ob; ob[0] = pk2(bt[0], bt[1]); ob[1] = pk2(bt[2], bt[3]);
                *(u32x2*)(ws_la(p) + o) = oa; *(u32x2*)(ws_h0(p) + o) = ob;
            }
        }
    }
}

DEVI f2 fma2(f2 a, f2 b, f2 c) { return __builtin_elementwise_fma(a, b, c); }
DEVI void ph_rwkv_scan(const Params& p, int l, int item, char* smem, bool dry = false) {
    const int wv = __builtin_amdgcn_readfirstlane(tidx() >> 6), lane = tidx() & 63;
    const int wi = item * 4 + wv;
    const int scan = wi / 3, part = wi - scan * 3;
    const int b = scan >> 3, h = (scan >> 1) & 3, d = scan & 1;
    const int c8 = lane & 7, r8 = lane >> 3;
    float* ring = (float*)smem + wv * 1280;
    const char* A = (const char*)(ws_sA0(p) + d * SA_EL);
    const char* Wm = (const char*)(ws_sW0(p) + d * SA_EL);
    const char *R = (const char*)ws_sR(p), *K = (const char*)ws_sK(p), *V = (const char*)ws_sV(p), *KK = (const char*)ws_sKK(p);
    char* Y = (char*)(ws_z(p) + 256 + 256 * d + h * 64);
#define LDB(base, bo) (*(const bf16_t*)((base) + (bo)))
    const float ka = p.rwkv_k_a[l * 256 + h * 64 + lane];
    f2 S[3][4];
#pragma unroll
    for (int pp = 0; pp < 3; ++pp)
#pragma unroll
        for (int k = 0; k < 4; ++k) S[pp][k] = (f2){0.f, 0.f};
    const unsigned t00 = (unsigned)(b * T_ + (d ? T_ - 1 : 0)) * 256u + h * 64;
    const unsigned o0 = (t00 + lane) * 2u;
    int rowp[3]; unsigned ov[3];
#pragma unroll
    for (int pp = 0; pp < 3; ++pp) { rowp[pp] = 24 * part + 8 * pp + r8; ov[pp] = (t00 + (rowp[pp] < 64 ? rowp[pp] : 63)) * 2u; }
    const int stp = d ? -512 : 512;
    const int myp = c8 < 3 ? c8 : 0;
    const int myrow = 24 * part + 8 * myp + r8;
    const bool ystore = c8 < 3 && myrow < 64 && !dry;
    const unsigned yrow_b = (unsigned)myrow * 2u;
    float vcur[3], vnx[3];
#pragma unroll
    for (int s_ = 0; s_ < 2; ++s_) {
        const unsigned o = o0 + s_ * stp;
        const float r = bf2f(LDB(R, o)), k = bf2f(LDB(K, o)), kk = bf2f(LDB(KK, o)), a = bf2f(LDB(A, o)), w = 1.f - bf2f(LDB(Wm, o));
#pragma unroll
        for (int pp = 0; pp < 3; ++pp) { const float vv = bf2f(LDB(V, ov[pp] + s_ * stp)); if (s_ == 0) vcur[pp] = vv; else vnx[pp] = vv; }
        float* sl = ring + s_ * 320;
        sl[0 * 64 + lane] = w; sl[1 * 64 + lane] = kk * a; sl[2 * 64 + lane] = k * (1.f + (a - 1.f) * ka); sl[3 * 64 + lane] = r; sl[4 * 64 + lane] = kk;
    }
    bf16_t rr[8], rk[8], rkk[8], ra[8], rw[8], rv[8][3];
#pragma unroll
    for (int i = 0; i < 8; ++i) {
        const int st = (i < 2 ? 8 + i : i) * stp;
        rr[i] = LDB(R, o0 + st); rk[i] = LDB(K, o0 + st); rkk[i] = LDB(KK, o0 + st); ra[i] = LDB(A, o0 + st); rw[i] = LDB(Wm, o0 + st);
#pragma unroll
        for (int pp = 0; pp < 3; ++pp) rv[i][pp] = LDB(V, ov[pp] + st);
    }
    __builtin_amdgcn_wave_barrier();
    f32x4 OB[2][5][2];
#define RW_LDO(set, slw, slk) { _Pragma("unroll") for (int g = 0; g < 2; ++g) { \
        OB[set][0][g] = *(const f32x4*)((slw) + 0 * 64 + 8 * c8 + 4 * g); OB[set][1][g] = *(const f32x4*)((slw) + 1 * 64 + 8 * c8 + 4 * g); \
        OB[set][2][g] = *(const f32x4*)((slw) + 2 * 64 + 8 * c8 + 4 * g); OB[set][3][g] = *(const f32x4*)((slw) + 3 * 64 + 8 * c8 + 4 * g); \
        OB[set][4][g] = *(const f32x4*)((slk) + 4 * 64 + 8 * c8 + 4 * g); } }
    RW_LDO(0, ring, ring + 320)
    float sktot[3] = {0.f, 0.f, 0.f};
    __builtin_amdgcn_s_setprio(3);
    for (int sb = 0; sb < T_; sb += 8) {
#pragma unroll
        for (int i = 0; i < 8; ++i) {
            const int step = sb + i;
            const int slot = (i + 2) & 7;
            float v2n[3];
            {
                float* sn = ring + ((i + 2) & 3) * 320;
                const float r1 = bf2f(rr[slot]), k1 = bf2f(rk[slot]), kk1 = bf2f(rkk[slot]), a1 = bf2f(ra[slot]), w1 = 1.f - bf2f(rw[slot]);
                sn[0 * 64 + lane] = w1; sn[1 * 64 + lane] = kk1 * a1; sn[2 * 64 + lane] = k1 * (1.f + (a1 - 1.f) * ka); sn[3 * 64 + lane] = r1; sn[4 * 64 + lane] = kk1;
#pragma unroll
                for (int pp = 0; pp < 3; ++pp) v2n[pp] = bf2f(rv[slot][pp]);
            }
            {
                const int s10 = (step + 10 < T_ ? step + 10 : T_ - 1) * stp;
                const unsigned oc = o0 + s10;
                rr[slot] = LDB(R, oc); rk[slot] = LDB(K, oc); rkk[slot] = LDB(KK, oc); ra[slot] = LDB(A, oc); rw[slot] = LDB(Wm, oc);
#pragma unroll
                for (int pp = 0; pp < 3; ++pp) rv[slot][pp] = LDB(V, ov[pp] + s10);
            }
            __builtin_amdgcn_wave_barrier();
            RW_LDO((i + 1) & 1, ring + ((i + 1) & 3) * 320, ring + ((i + 2) & 3) * 320)
            const unsigned tok_b = (unsigned)(b * T_ + (d ? T_ - 1 - step : step)) * (unsigned)(DIN * 2);
            float pyv[3];
#pragma unroll
            for (int pp = 0; pp < 3; ++pp) {
                const f2 nsk2 = (f2){-sktot[pp], -sktot[pp]}, v2 = (f2){vcur[pp], vcur[pp]};
                f2 y2 = (f2){0.f, 0.f}, sk2 = (f2){0.f, 0.f};
#pragma unroll
                for (int g = 0; g < 2; ++g) {
                    const f32x4 w4 = OB[i & 1][0][g], b4 = OB[i & 1][1][g], kd4 = OB[i & 1][2][g], r4 = OB[i & 1][3][g], kn4 = OB[i & 1][4][g];
                    f2 t0 = v2 * kd4.xy; t0 = fma2(nsk2, b4.xy, t0);
                    S[pp][2 * g] = fma2(S[pp][2 * g], w4.xy, t0);
                    y2 = fma2(S[pp][2 * g], r4.xy, y2); sk2 = fma2(S[pp][2 * g], kn4.xy, sk2);
                    f2 t1 = v2 * kd4.zw; t1 = fma2(nsk2, b4.zw, t1);
                    S[pp][2 * g + 1] = fma2(S[pp][2 * g + 1], w4.zw, t1);
                    y2 = fma2(S[pp][2 * g + 1], r4.zw, y2); sk2 = fma2(S[pp][2 * g + 1], kn4.zw, sk2);
                }
                float ps = sk2.x + sk2.y, py = y2.x + y2.y;
                ps += dppx<0xB1>(ps); py += dppx<0xB1>(py);
                ps += dppx<0x4E>(ps); py += dppx<0x4E>(py);
                ps += dppx<0x141>(ps); py += dppx<0x141>(py);
                sktot[pp] = ps; pyv[pp] = py;
                vcur[pp] = vnx[pp]; vnx[pp] = v2n[pp];
            }
            {
                const float ysel = c8 == 0 ? pyv[0] : c8 == 1 ? pyv[1] : pyv[2];
                if (ystore) *(bf16_t*)(Y + (tok_b + yrow_b)) = f2bf(ysel);
            }
        }
    }
    __builtin_amdgcn_s_setprio(0);
#undef RW_LDO
#undef LDB
}

DEVI void ph_lru_scan(const Params& p, int l, int item, bool dry = false) {
    const int lane = tidx() & 63, idx = item * 4 + (tidx() >> 6);
    const int b = idx >> 3, n = (idx >> 1) & 3, d = idx & 1;
    const bf16_t* A = ws_la(p) + d * SA_EL + (size_t)b * T_ * 256 + n * 64 + lane;
    bf16_t* H = ws_h0(p) + d * SA_EL + (size_t)b * T_ * 256 + n * 64 + lane;
    float h = 0.f;
    for (int s0 = 0; s0 < T_; s0 += 32) {
        bf16_t av[32], bv[32];
#pragma unroll
        for (int i = 0; i < 32; ++i) { const int t = d ? T_ - 1 - (s0 + i) : s0 + i; av[i] = A[(size_t)t * 256]; bv[i] = H[(size_t)t * 256]; }
#pragma unroll
        for (int i = 0; i < 32; ++i) {
            const int t = d ? T_ - 1 - (s0 + i) : s0 + i;
            h = (1.f - bf2f(av[i])) * h + bf2f(bv[i]);
            if (!dry) H[(size_t)t * 256] = f2bf(h);
        }
    }
}

DEVI void ph_post_all(const Params& p, int l, int bid, int G) {
    const int j = tidx();
    const float lg = p.rwkv_ln_g[l * 256 + j], lb = p.rwkv_ln_b[l * 256 + j], ka = p.rwkv_k_a[l * 256 + j], rk_ = p.rwkv_r_k[l * 256 + j];
    constexpr int NIT = NTOK / 8;
    if (bid >= NIT) return;
    const int ng = (NIT - bid + G - 1) / G;
    bf16_t yf[2][8], yr[2][8], r_[2][8], k_[2][8], v_[2][8], af[2][8], ar[2][8], ga[2][8], hf[2][8], hr[2][8], gc[2][8];
#define POST_LOAD(B_, GI_) { \
        _Pragma("unroll") for (int i = 0; i < 8; ++i) { \
            const int m = (bid + (GI_) * G) * 8 + i; \
            const size_t o = (size_t)m * 256 + j; \
            const bf16_t* zr = ws_z(p) + (size_t)m * DIN; \
            yf[B_][i] = zr[256 + j]; yr[B_][i] = zr[512 + j]; r_[B_][i] = ws_sR(p)[o]; k_[B_][i] = ws_sK(p)[o]; v_[B_][i] = ws_sV(p)[o]; \
            af[B_][i] = ws_sA0(p)[o]; ar[B_][i] = ws_sA0(p)[o + SA_EL]; ga[B_][i] = zr[OFF_A + 896 + j]; \
            hf[B_][i] = ws_h0(p)[o]; hr[B_][i] = ws_h0(p)[o + SA_EL]; gc[B_][i] = zr[OFF_C + 256 + j]; \
        } }
#define POST_COMP(B_, GI_) { \
        _Pragma("unroll") for (int i = 0; i < 8; ++i) { \
            const int m = (bid + (GI_) * G) * 8 + i; \
            bf16_t* zr = ws_z(p) + (size_t)m * DIN; \
            const float y = bf2f(yf[B_][i]) + bf2f(yr[B_][i]); \
            const float mu = wave_sum(y) * (1.f / 64.f); \
            const float dv = y - mu; \
            const float var = wave_sum(dv * dv) * (1.f / 64.f); \
            const float yn = dv * rsqrtf(var + 64e-5f) * lg + lb; \
            const float r = bf2f(r_[B_][i]), k = bf2f(k_[B_][i]), v = bf2f(v_[B_][i]), a_f = bf2f(af[B_][i]), a_r = bf2f(ar[B_][i]); \
            const float ksum = k * (1.f + (a_f - 1.f) * ka) + k * (1.f + (a_r - 1.f) * ka); \
            const float bon = wave_sum(r * ksum * rk_) * v; \
            const float g = bf2f(ga[B_][i]); \
            zr[OFF_A + j] = f2bf((yn + bon) * g * sigm(g)); \
            const float h = bf2f(hf[B_][i]) + bf2f(hr[B_][i]); \
            const float g2 = bf2f(gc[B_][i]); \
            zr[OFF_C + j] = f2bf(h * g2 * sigm(g2)); \
        } }
    POST_LOAD(0, 0)
#pragma unroll 1
    for (int gi = 0; gi < ng; gi += 2) {
        if (gi + 1 < ng) POST_LOAD(1, gi + 1)
        POST_COMP(0, gi)
        if (gi + 2 < ng) POST_LOAD(0, gi + 2)
        if (gi + 1 < ng) POST_COMP(1, gi + 1)
    }
#undef POST_LOAD
#undef POST_COMP
}

template <int WIN>
DEVI void ph_attn_naive(const Params& p, int l, int item) {
    const int lane = tidx() & 63, idx = item * 4 + (tidx() >> 6);
    const int qb = idx & 31, hq = (idx >> 5) & 3, b = idx >> 7;
    const int g = hq >> 1;
    constexpr int OFF = WIN ? OFF_D : OFF_B;
    const int t0 = qb * 64, t = t0 + lane;
    bf16_t* zq = ws_z(p) + ((size_t)b * T_ + t) * DIN + OFF + hq * 64;
    float q[64], o[64];
#pragma unroll
    for (int c = 0; c < 8; ++c) {
        const uint4 u = *(const uint4*)(zq + c * 8);
        const unsigned uu[4] = {u.x, u.y, u.z, u.w};
#pragma unroll
        for (int e = 0; e < 4; ++e) { q[c * 8 + 2 * e] = __uint_as_float(uu[e] << 16); q[c * 8 + 2 * e + 1] = __uint_as_float(uu[e] & 0xffff0000u); }
    }
#pragma unroll
    for (int dd = 0; dd < 64; ++dd) o[dd] = 0.f;
    float mx, ls;
    float slope = 0.f;
    if (WIN) { mx = p.swa_sink[l * 4 + hq]; ls = 1.f; slope = exp2f(-8.f * (float)(hq + 1) / 4.f); }
    else { mx = -1e30f; ls = 0.f; }
    const int s0 = WIN ? max(0, t0 - 128) : 0, s1 = WIN ? min(T_ - 1, t0 + 63 + 128) : T_ - 1;
    const bf16_t* kb = ws_z(p) + (size_t)b * T_ * DIN + OFF + 256 + g * 64;
    for (int s = s0; s <= s1; ++s) {
        const bf16_t* kr = kb + (size_t)s * DIN;
        float sc = 0.f;
#pragma unroll
        for (int c = 0; c < 8; ++c) {
            const uint4 u = *(const uint4*)(kr + c * 8);
            const unsigned uu[4] = {u.x, u.y, u.z, u.w};
#pragma unroll
            for (int e = 0; e < 4; ++e) { sc += q[c * 8 + 2 * e] * __uint_as_float(uu[e] << 16); sc += q[c * 8 + 2 * e + 1] * __uint_as_float(uu[e] & 0xffff0000u); }
        }
        bool valid = true;
        if (WIN) { const int dist = abs(t - s); valid = dist <= 128; sc = sc * 0.125f - slope * (float)dist; }
        const float mn = valid ? fmaxf(mx, sc) : mx;
        const float al = __expf(mx - mn);
        const float pp = valid ? __expf(sc - mn) : 0.f;
        mx = mn; ls = ls * al + pp;
#pragma unroll
        for (int c = 0; c < 8; ++c) {
            const uint4 u = *(const uint4*)(kr + 128 + c * 8);
            const unsigned uu[4] = {u.x, u.y, u.z, u.w};
#pragma unroll
            for (int e = 0; e < 4; ++e) {
                o[c * 8 + 2 * e] = o[c * 8 + 2 * e] * al + pp * __uint_as_float(uu[e] << 16);
                o[c * 8 + 2 * e + 1] = o[c * 8 + 2 * e + 1] * al + pp * __uint_as_float(uu[e] & 0xffff0000u);
            }
        }
    }
    const float il = 1.f / ls;
    const bf16_t* zg = zq - hq * 64 + 512 + hq * 64;
#pragma unroll
    for (int c = 0; c < 8; ++c) {
        const uint4 u = *(const uint4*)(zg + c * 8);
        const unsigned uu[4] = {u.x, u.y, u.z, u.w};
        unsigned ov[4];
#pragma unroll
        for (int e = 0; e < 4; ++e) {
            const float g0 = __uint_as_float(uu[e] << 16), g1 = __uint_as_float(uu[e] & 0xffff0000u);
            ov[e] = pk2(o[c * 8 + 2 * e] * il * g0 * sigm(g0), o[c * 8 + 2 * e + 1] * il * g1 * sigm(g1));
        }
        *(uint4*)(zq + c * 8) = make_uint4(ov[0], ov[1], ov[2], ov[3]);
    }
}

constexpr int ALD = 72;
template <int WIN>
DEVI void ph_attn(const Params& p, int l, int item, char* smem, bool dry = false) {
    constexpr int OFF = WIN ? OFF_D : OFF_B;
    const int qb = item & 15, hq = (item >> 4) & 3, b = item >> 6, g = hq >> 1;
    const int tid = tidx(), w = tid >> 6, lane = tid & 63, fr = lane & 15, fq = lane >> 4;
    const int t0 = qb * 128, tw = t0 + 32 * w;
    bf16_t* Ks = (bf16_t*)smem;
    bf16_t* Vt = Ks + 2 * 64 * ALD;
    bf16_t* zb = ws_z(p) + (size_t)b * T_ * DIN;
    bf16x8 qf[2][2];
#pragma unroll
    for (int n = 0; n < 2; ++n)
#pragma unroll
        for (int ks = 0; ks < 2; ++ks) {
            u32x4 u = *(const u32x4*)(zb + (size_t)(tw + 16 * n + fr) * DIN + OFF + hq * 64 + 32 * ks + 8 * fq);
            if (WIN) {
                constexpr float sc = 0.125f * 1.4426950408889634f;
#pragma unroll
                for (int e = 0; e < 4; ++e) u[e] = pk2(__uint_as_float(u[e] << 16) * sc, __uint_as_float(u[e] & 0xffff0000u) * sc);
            }
            qf[n][ks] = __builtin_bit_cast(bf16x8, u);
        }
    const int kt0 = WIN ? max(0, t0 - 128) / 64 : 0, kt1 = WIN ? min(T_, t0 + 256) / 64 : T_ / 64;
    f32x4 ot[4][2];
#pragma unroll
    for (int dm = 0; dm < 4; ++dm)
#pragma unroll
        for (int n = 0; n < 2; ++n) ot[dm][n] = (f32x4){0.f, 0.f, 0.f, 0.f};
    float mrun[2], lrun[2];
    float slope2 = 0.f;
    if (WIN) {
        const float sk = p.swa_sink[l * 4 + hq] * 1.4426950408889634f;
        mrun[0] = mrun[1] = sk; lrun[0] = lrun[1] = fq == 0 ? 1.f : 0.f;
        slope2 = exp2f(-2.f * (float)(hq + 1)) * 1.4426950408889634f;
    } else { mrun[0] = mrun[1] = -1e30f; lrun[0] = lrun[1] = 0.f; }
    const bf16_t* kbase = zb + OFF + 256 + g * 64;
    const bf16_t* vbase = zb + OFF + 384 + g * 64;
    u32x4 rk[2], rv[2];
    const int kkey = tid >> 2, kc = tid & 3, vkey = tid & 63, vc = tid >> 6;
    auto gload = [&](int kt) __attribute__((always_inline)) {
        const bf16_t* kp = kbase + (size_t)(kt * 64 + kkey) * DIN + kc * 16;
        rk[0] = *(const u32x4*)kp; rk[1] = *(const u32x4*)(kp + 8);
        const bf16_t* vp = vbase + (size_t)(kt * 64 + vkey) * DIN + vc * 16;
        rv[0] = *(const u32x4*)vp; rv[1] = *(const u32x4*)(vp + 8);
    };
    auto swrite = [&](int buf) __attribute__((always_inline)) {
        bf16_t* kd = Ks + (buf * 64 + kkey) * ALD + kc * 16;
        *(u32x4*)kd = rk[0]; *(u32x4*)(kd + 8) = rk[1];
        bf16_t* vd = Vt + (buf * 64 + vc * 16) * ALD + vkey;
#pragma unroll
        for (int h = 0; h < 2; ++h)
#pragma unroll
            for (int e = 0; e < 4; ++e) {
                vd[(h * 8 + 2 * e) * ALD] = (bf16_t)(rv[h][e] & 0xffffu);
                vd[(h * 8 + 2 * e + 1) * ALD] = (bf16_t)(rv[h][e] >> 16);
            }
    };
    __syncthreads();
    gload(kt0); swrite(0);
    __syncthreads();
    for (int kt = kt0; kt < kt1; ++kt) {
        const int buf = (kt - kt0) & 1;
        if (kt + 1 < kt1) gload(kt + 1);
        f32x4 st[4][2];
#pragma unroll
        for (int m = 0; m < 4; ++m)
#pragma unroll
            for (int n = 0; n < 2; ++n) st[m][n] = (f32x4){0.f, 0.f, 0.f, 0.f};
#pragma unroll
        for (int ks = 0; ks < 2; ++ks)
#pragma unroll
            for (int m = 0; m < 4; ++m) {
                const bf16x8 kf = *(const bf16x8*)(Ks + (buf * 64 + 16 * m + fr) * ALD + 32 * ks + 8 * fq);
#pragma unroll
                for (int n = 0; n < 2; ++n) st[m][n] = __builtin_amdgcn_mfma_f32_16x16x32_bf16(kf, qf[n][ks], st[m][n], 0, 0, 0);
            }
        if (WIN) {
#pragma unroll
            for (int m = 0; m < 4; ++m)
#pragma unroll
                for (int n = 0; n < 2; ++n)
#pragma unroll
                    for (int j = 0; j < 4; ++j) {
                        const int dist = abs((tw + 16 * n + fr) - (kt * 64 + 16 * m + 4 * fq + j));
                        st[m][n][j] = dist <= 128 ? st[m][n][j] - slope2 * (float)dist : -1e30f;
                    }
        }
#pragma unroll
        for (int n = 0; n < 2; ++n) {
            float mt = st[0][n][0];
#pragma unroll
            for (int m = 0; m < 4; ++m)
#pragma unroll
                for (int j = 0; j < 4; ++j) mt = fmaxf(mt, st[m][n][j]);
            mt = fmaxf(mt, __shfl_xor(mt, 16)); mt = fmaxf(mt, __shfl_xor(mt, 32));
            const float mn = fmaxf(mrun[n], mt);
            const float alpha = __builtin_amdgcn_exp2f(mrun[n] - mn);
            mrun[n] = mn;
            float lsum = 0.f;
#pragma unroll
            for (int m = 0; m < 4; ++m)
#pragma unroll
                for (int j = 0; j < 4; ++j) { const float pv = __builtin_amdgcn_exp2f(st[m][n][j] - mn); lsum += pv; st[m][n][j] = pv; }
            lrun[n] = lrun[n] * alpha + lsum;
#pragma unroll
            for (int dm = 0; dm < 4; ++dm) ot[dm][n] = ot[dm][n] * alpha;
        }
#pragma unroll
        for (int kk = 0; kk < 2; ++kk) {
            bf16x8 pf[2];
#pragma unroll
            for (int n = 0; n < 2; ++n) {
                u32x4 u;
                u[0] = pk2(st[2 * kk][n][0], st[2 * kk][n][1]); u[1] = pk2(st[2 * kk][n][2], st[2 * kk][n][3]);
                u[2] = pk2(st[2 * kk + 1][n][0], st[2 * kk + 1][n][1]); u[3] = pk2(st[2 * kk + 1][n][2], st[2 * kk + 1][n][3]);
                pf[n] = __builtin_bit_cast(bf16x8, u);
            }
#pragma unroll
            for (int dm = 0; dm < 4; ++dm) {
                const bf16_t* vp = Vt + (buf * 64 + 16 * dm + fr) * ALD + 32 * kk + 4 * fq;
                const u32x2 v0 = *(const u32x2*)vp, v1 = *(const u32x2*)(vp + 16);
                const bf16x8 vf = __builtin_bit_cast(bf16x8, (u32x4){v0[0], v0[1], v1[0], v1[1]});
#pragma unroll
                for (int n = 0; n < 2; ++n) ot[dm][n] = __builtin_amdgcn_mfma_f32_16x16x32_bf16(vf, pf[n], ot[dm][n], 0, 0, 0);
            }
        }
        if (kt + 1 < kt1) swrite(buf ^ 1);
        __syncthreads();
    }
#pragma unroll
    for (int n = 0; n < 2; ++n) {
        float lt = lrun[n];
        lt += __shfl_xor(lt, 16); lt += __shfl_xor(lt, 32);
        const float il = 1.f / lt;
        bf16_t* zr = zb + (size_t)(tw + 16 * n + fr) * DIN + OFF + hq * 64 + 4 * fq;
#pragma unroll
        for (int dm = 0; dm < 4; ++dm) {
            const u32x2 gu = *(const u32x2*)(zr + 512 + 16 * dm);
            float gv[4] = {__uint_as_float(gu[0] << 16), __uint_as_float(gu[0] & 0xffff0000u), __uint_as_float(gu[1] << 16), __uint_as_float(gu[1] & 0xffff0000u)};
            float ov[4];
#pragma unroll
            for (int j = 0; j < 4; ++j) ov[j] = ot[dm][n][j] * il * gv[j] * sigm(gv[j]);
            u32x2 o2; o2[0] = pk2(ov[0], ov[1]); o2[1] = pk2(ov[2], ov[3]);
            if (!dry) *(u32x2*)(zr + 16 * dm) = o2;
        }
    }
}

DEVI void gbar(unsigned* ctr, unsigned target) {
    asm volatile("s_waitcnt vmcnt(0)" ::: "memory");
    __syncthreads();
    if (threadIdx.x == 0) {
        __builtin_amdgcn_fence(__ATOMIC_RELEASE, "agent");
        asm volatile("s_waitcnt vmcnt(0)" ::: "memory");
        (void)__hip_atomic_fetch_add(ctr, 1u, __ATOMIC_RELAXED, __HIP_MEMORY_SCOPE_AGENT);
        while (__hip_atomic_load(ctr, __ATOMIC_RELAXED, __HIP_MEMORY_SCOPE_AGENT) < target) __builtin_amdgcn_s_sleep(1);
        __builtin_amdgcn_fence(__ATOMIC_ACQUIRE, "agent");
        asm volatile("s_waitcnt vmcnt(0)" ::: "memory");
    }
    __syncthreads();
}

enum { PH_CONVW, PH_ROWNORM, PH_GEMM1, PH_PREP, PH_RWKV, PH_LRU, PH_ATTNB, PH_ATTND, PH_POST, PH_GEMM2, PH_FINAL };
#ifndef MK_MULTI
#define MK_MULTI 0
#endif
#ifndef PROBE_PREP
#define PROBE_PREP 0
#endif
#ifndef PROBE_MIX
#define PROBE_MIX 0
#endif
#ifndef PROBE_G2
#define PROBE_G2 0
#endif
#if MK_MULTI
template <int PH>
__global__ void __launch_bounds__(256) kph(Params p, int l, int nitems) {
    extern __shared__ __attribute__((aligned(16))) char smem[];
    for (int item = blockIdx.x; item < nitems; item += gridDim.x) {
        if (PH == PH_CONVW) ph_convw(p, item, smem);
        if (PH == PH_ROWNORM) ph_rownorm(p, l, item);
        if (PH == PH_GEMM1) { if (item == (int)blockIdx.x) ph_gemm_all<0>(p, l, blockIdx.x, gridDim.x, smem); }
        if (PH == PH_PREP) ph_prep(p, l, item, smem);
        if (PH == PH_RWKV) ph_rwkv_scan(p, l, item, smem);
        if (PH == PH_LRU) ph_lru_scan(p, l, item);
        if (PH == PH_ATTNB) ph_attn_naive<0>(p, l, item);
        if (PH == PH_ATTND) ph_attn_naive<1>(p, l, item);
        if (PH == PH_POST) { if (item == (int)blockIdx.x) ph_post_all(p, l, blockIdx.x, gridDim.x); }
        if (PH == PH_GEMM2) { if (item == (int)blockIdx.x) ph_gemm_all<1>(p, l, blockIdx.x, gridDim.x, smem); }
        if (PH == PH_FINAL) ph_final(p, item);
    }
}
template <int PH>
static void launch(const Params& p, int l, int nitems, int lds, hipStream_t stream) {
    if (lds > 48 * 1024) (void)hipFuncSetAttribute((const void*)kph<PH>, hipFuncAttributeMaxDynamicSharedMemorySize, lds);
    int grid = nitems < 65536 ? nitems : 65536;
    hipLaunchKernelGGL(kph<PH>, dim3(grid), dim3(256), lds, stream, p, l, nitems);
}
#else
constexpr int MIX_ITEMS = 80 + 2560 + 2560;
__global__ void __launch_bounds__(256, 2) mega(Params p) {
    extern __shared__ __attribute__((aligned(16))) char smem[];
    __shared__ int s_item;
    cg::grid_group grid = cg::this_grid();
    const int G = gridDim.x, bid = blockIdx.x;
    unsigned nbar = 0;
    if (bid == 0 && threadIdx.x < 64) ws_ctr(p)[threadIdx.x] = 0;
    for (int it = bid; it < CW_ITEMS; it += G) ph_convw(p, it, smem);
    grid.sync();
    for (int l = 0; l < NL; ++l) {
        if (l == 0) {
            for (int it = bid; it < NTOK / 4; it += G) ph_rownorm(p, l, it);
            gbar(ws_gbar(p), (nbar += (unsigned)G));
        }
        ph_gemm_all<0>(p, l, bid, G, smem);
        gbar(ws_gbar(p), (nbar += (unsigned)G));
#if PROBE_PREP
        for (int it = bid; it < NTOK / 32; it += G) ph_prep(p, l, it, smem, true);
#endif
        for (int it = bid; it < NTOK / 32; it += G) ph_prep(p, l, it, smem);
        gbar(ws_gbar(p), (nbar += (unsigned)G));
#if PROBE_MIX
        for (int rep = 0; rep < 2; ++rep) {
        const bool dry = rep == 0;
        int* ctrp = &ws_ctr(p)[l + 4 * rep];
#else
        {
        const bool dry = false;
        int* ctrp = &ws_ctr(p)[l];
#endif
        for (int it = bid; it < 240; it += G) ph_rwkv_scan(p, l, it, smem, dry);
        for (;;) {
            __syncthreads();
            if (threadIdx.x == 0) s_item = atomicAdd(ctrp, 1);
            __syncthreads();
            const int it = s_item;
            if (it >= MIX_ITEMS) break;
            if (it < 80) ph_lru_scan(p, l, it, dry);
            else if (it < 2640) ph_attn<0>(p, l, it - 80, smem, dry);
            else ph_attn<1>(p, l, it - 2640, smem, dry);
        }
        }
        gbar(ws_gbar(p), (nbar += (unsigned)G));
        ph_post_all(p, l, bid, G);
        gbar(ws_gbar(p), (nbar += (unsigned)G));
#if PROBE_G2
        ph_gemm_all<1>(p, l, bid, G, smem, true);
#endif
        ph_gemm_all<1>(p, l, bid, G, smem);
        gbar(ws_gbar(p), (nbar += (unsigned)G));
    }
    for (int it = bid; it < NTOK / 4; it += G) ph_final(p, it);
}
#endif

extern "C" void kernel_launch(void* const* d_in, const int* in_sizes, int n_in, void* d_out, int out_size, void* d_ws, size_t ws_size,
                              hipStream_t stream) {
    Params p{};
    const float* const* in = (const float* const*)d_in;
    p.x_prompt = in[0]; p.x_sample = in[1]; p.norm_g = in[2]; p.w_in = in[3]; p.w_out = in[4]; p.rwkv_shift = in[5]; p.rwkv_w0 = in[6];
    p.rwkv_w_up = in[7]; p.rwkv_a0 = in[8]; p.rwkv_a_up = in[9]; p.rwkv_k_k = in[10]; p.rwkv_k_a = in[11]; p.rwkv_r_k = in[12];
    p.rwkv_ln_g = in[13]; p.rwkv_ln_b = in[14]; p.attn_q_norm = in[15]; p.attn_k_norm = in[16]; p.lru_conv_w = in[17]; p.lru_conv_b = in[18];
    p.lru_gate_w = in[19]; p.lru_gate_b = in[20]; p.lru_lambda = in[21]; p.swa_sink = in[22]; p.final_g = in[23];
    p.out = (float*)d_out;
    p.ws = (char*)d_ws;
    if (WS_NEED > ws_size) { fprintf(stderr, "workspace too small: need %zu have %zu\n", (size_t)WS_NEED, ws_size); }

#if MK_MULTI
    launch<PH_CONVW>(p, 0, CW_ITEMS, 64 * 65 * 4, stream);
    for (int l = 0; l < NL; ++l) {
        if (l == 0) launch<PH_ROWNORM>(p, l, NTOK / 4, 0, stream);
        launch<PH_GEMM1>(p, l, (NTOK / GBM) * (DIN / GBN), GEMM_LDS, stream);
        launch<PH_PREP>(p, l, NTOK / 32, PREP_LDS, stream);
        launch<PH_RWKV>(p, l, 240, 4 * 5120, stream);
        launch<PH_LRU>(p, l, 80, 0, stream);
        launch<PH_ATTNB>(p, l, 1280, 0, stream);
        launch<PH_ATTND>(p, l, 1280, 0, stream);
        launch<PH_POST>(p, l, NTOK / 8, 0, stream);
        launch<PH_GEMM2>(p, l, (NTOK / GBM) * (DM / GBN), GEMM_LDS, stream);
    }
    launch<PH_FINAL>(p, 0, NTOK / 4, 0, stream);
#else
    constexpr size_t kDynLds = GEMM_LDS;
    static int grid_blocks = 0;
    if (!grid_blocks) {
        (void)hipFuncSetAttribute((const void*)mega, hipFuncAttributeMaxDynamicSharedMemorySize, (int)kDynLds);
        int dev = 0, cus = 0, per_cu = 0;
        (void)hipGetDevice(&dev);
        (void)hipDeviceGetAttribute(&cus, hipDeviceAttributeMultiprocessorCount, dev);
        (void)hipOccupancyMaxActiveBlocksPerMultiprocessor(&per_cu, mega, 256, kDynLds);
        if (per_cu < 1) per_cu = 1;
        grid_blocks = cus * per_cu;
    }
    (void)hipMemsetAsync((char*)d_ws + WO_GBAR, 0, 256, stream);
    void* args[] = {&p};
    hipError_t e = hipLaunchCooperativeKernel((void*)mega, dim3(grid_blocks), dim3(256), args, kDynLds, stream);
    if (e != hipSuccess) fprintf(stderr, "cooperative launch failed: %s (grid %d)\n", hipGetErrorString(e), grid_blocks);
#endif
}
```

```cpp
#include <hip/hip_runtime.h>
#include <hip/hip_cooperative_groups.h>
#include <cstdio>
#include <cstdint>
namespace cg = cooperative_groups;

#define DEVI __device__ __forceinline__
typedef unsigned short bf16_t;
typedef short bf16x8 __attribute__((ext_vector_type(8)));
typedef float f32x4 __attribute__((ext_vector_type(4)));

constexpr int T_ = 2048, NB_ = 40, NTOK = NB_ * T_, DM = 1024, DIN = 3200, NL = 4;
constexpr int NPROMPT = 32 * T_;
constexpr size_t SA_EL = (size_t)NTOK * 256;
constexpr int OFF_A = 0, OFF_B = 1152, OFF_C = 1920, OFF_D = 2432;

struct Params {
    const float *x_prompt, *x_sample, *norm_g, *w_in, *w_out, *rwkv_shift, *rwkv_w0, *rwkv_w_up, *rwkv_a0, *rwkv_a_up,
        *rwkv_k_k, *rwkv_k_a, *rwkv_r_k, *rwkv_ln_g, *rwkv_ln_b, *attn_q_norm, *attn_k_norm, *lru_conv_w, *lru_conv_b,
        *lru_gate_w, *lru_gate_b, *lru_lambda, *swa_sink, *final_g;
    float* out;
    char* ws;
};
constexpr size_t al256(size_t x) { return (x + 255) & ~(size_t)255; }
constexpr size_t WO_WT_IN = 0;
constexpr size_t WO_WT_OUT = WO_WT_IN + al256((size_t)NL * DIN * DM * 2);
constexpr size_t WO_XB = WO_WT_OUT + al256((size_t)NL * DM * DM * 2);
constexpr size_t WO_Z = WO_XB + al256((size_t)NTOK * DM * 2);
constexpr size_t WO_SR = WO_Z + al256((size_t)NTOK * DIN * 2);
constexpr size_t WO_SK = WO_SR + SA_EL * 2, WO_SV = WO_SK + SA_EL * 2, WO_SKK = WO_SV + SA_EL * 2, WO_SA0 = WO_SKK + SA_EL * 2, WO_SW0 = WO_SA0 + 2 * SA_EL * 2;
constexpr size_t WO_CTR = WO_SW0 + 2 * SA_EL * 2;
constexpr size_t WO_WUP = WO_CTR + 256, WO_AUP = WO_WUP + (size_t)NL * 2 * 256 * 64 * 2, WO_GW = WO_AUP + (size_t)NL * 2 * 256 * 64 * 2, WO_ROPE = WO_GW + (size_t)NL * 16 * 4096 * 2;
constexpr size_t WO_GBAR = WO_ROPE + 2048 * 4;
constexpr size_t WO_PART = WO_GBAR + 256;
constexpr size_t WS_NEED = WO_PART + (size_t)NTOK * 16 * 4;
#define WSF(name, T, off) DEVI T* ws_##name(const Params& p) { return (T*)(p.ws + (off)); }
WSF(wt_in, bf16_t, WO_WT_IN) WSF(wt_out, bf16_t, WO_WT_OUT) WSF(xb, bf16_t, WO_XB) WSF(z, bf16_t, WO_Z) WSF(sR, bf16_t, WO_SR) WSF(sK, bf16_t, WO_SK)
WSF(sV, bf16_t, WO_SV) WSF(sKK, bf16_t, WO_SKK) WSF(sA0, bf16_t, WO_SA0) WSF(sW0, bf16_t, WO_SW0) WSF(la, bf16_t, WO_XB) WSF(h0, bf16_t, WO_XB + 2 * SA_EL * 2)
WSF(ctr, int, WO_CTR) WSF(gbar, unsigned, WO_GBAR) WSF(part, float, WO_PART) WSF(wup_t, bf16_t, WO_WUP) WSF(aup_t, bf16_t, WO_AUP) WSF(gw_t, bf16_t, WO_GW) WSF(rope, float, WO_ROPE)

DEVI float bf2f(bf16_t h) { return __uint_as_float(((unsigned)h) << 16); }
DEVI bf16_t f2bf(float f) { return __builtin_bit_cast(bf16_t, (__bf16)f); }
typedef float f2 __attribute__((ext_vector_type(2)));
typedef __bf16 b2_t __attribute__((ext_vector_type(2)));
DEVI unsigned pk2(float lo, float hi) { f2 v = {lo, hi}; return __builtin_bit_cast(unsigned, __builtin_convertvector(v, b2_t)); }
typedef unsigned u32x4 __attribute__((ext_vector_type(4)));
typedef unsigned u32x2 __attribute__((ext_vector_type(2)));
DEVI float sigm(float x) { return 1.f / (1.f + __expf(-x)); }
DEVI float dpp_f(float v, int) { return v; }
template <int CTRL> DEVI float dppx(float v) { return __builtin_bit_cast(float, __builtin_amdgcn_update_dpp(0, __builtin_bit_cast(int, v), CTRL, 0xf, 0xf, true)); }
DEVI float wave_sum(float v) {
    v += dppx<0xB1>(v);
    v += dppx<0x4E>(v);
    v += dppx<0x141>(v);
    v += dppx<0x140>(v);
    v += __shfl_xor(v, 16); v += __shfl_xor(v, 32);
    return v;
}
DEVI float rdl(float v, int j) { return __builtin_bit_cast(float, __builtin_amdgcn_readlane(__builtin_bit_cast(int, v), j)); }
DEVI const float* xrow(const Params& p, int l, int m) {
    if (l > 0) return p.out + (size_t)m * DM;
    const float* xp = p.x_prompt; const float* xs = p.x_sample;
    const long delta = (xs - xp) - (long)NPROMPT * DM;
    return xp + (size_t)m * DM + (m >= NPROMPT ? delta : (long)0);
}

DEVI int tidx() { int t = threadIdx.x; asm volatile("" : "+v"(t)); return t; }
constexpr int CW_PER_L = 1088, CW_ITEMS = NL * CW_PER_L + 1;
DEVI void ph_convw(const Params& p, int item, char* smem) {
    float* tile = (float*)smem;
    if (item == NL * CW_PER_L) {
        for (int e = tidx(); e < 1024; e += 256) {
            const int pos = e >> 4, i = e & 15;
            const float inv = exp2f(-(float)i * (13.287712379549449f / 16.f));
            const float ang = (float)pos * inv;
            ws_rope(p)[2 * e] = cosf(ang); ws_rope(p)[2 * e + 1] = sinf(ang);
        }
        return;
    }
    const int l = item / CW_PER_L; int r = item % CW_PER_L;
    const float* src; bf16_t* dst; int N, K, k0, n0;
    if (r < 800) { src = p.w_in + (size_t)l * DM * DIN; dst = ws_wt_in(p) + (size_t)l * DIN * DM; N = DIN; K = DM; k0 = (r / 50) * 64; n0 = (r % 50) * 64; }
    else if (r < 1056) { r -= 800; src = p.w_out + (size_t)l * DM * DM; dst = ws_wt_out(p) + (size_t)l * DM * DM; N = DM; K = DM; k0 = (r / 16) * 64; n0 = (r % 16) * 64; }
    else if (r < 1072) { r -= 1056; const int d = (r >> 2) & 1, up = r >> 3; const size_t o = (size_t)(l * 2 + d) * 64 * 256;
        src = (up ? p.rwkv_a_up : p.rwkv_w_up) + o; dst = (up ? ws_aup_t(p) : ws_wup_t(p)) + o; N = 256; K = 64; k0 = 0; n0 = (r & 3) * 64; }
    else { r -= 1072; const size_t o = (size_t)(l * 16 + r) * 4096; src = p.lru_gate_w + o; dst = ws_gw_t(p) + o; N = 64; K = 64; k0 = 0; n0 = 0; }
    int tx = tidx() & 63, ty = tidx() >> 6;
    __syncthreads();
    for (int i = 0; i < 16; ++i) { int k = ty + 4 * i; tile[k * 65 + tx] = src[(size_t)(k0 + k) * N + n0 + tx]; }
    __syncthreads();
    for (int i = 0; i < 16; ++i) { int n = ty + 4 * i; dst[(size_t)(n0 + n) * K + k0 + tx] = f2bf(tile[tx * 65 + n]); }
}

DEVI void ph_rownorm(const Params& p, int l, int item) {
    int w = tidx() >> 6, lane = tidx() & 63;
    int m = item * 4 + w;
    const float* x = xrow(p, l, m);
    const float* g = p.norm_g + l * DM;
    float4 v[4]; float ss = 0.f;
#pragma unroll
    for (int i = 0; i < 4; ++i) { v[i] = *(const float4*)(x + lane * 4 + 256 * i); ss += v[i].x * v[i].x + v[i].y * v[i].y + v[i].z * v[i].z + v[i].w * v[i].w; }
    ss = wave_sum(ss);
    if (lane < 16) ws_part(p)[(size_t)m * 16 + lane] = lane == 0 ? ss : 0.f;
#pragma unroll
    for (int i = 0; i < 4; ++i) {
        float4 gg = *(const float4*)(g + lane * 4 + 256 * i);
        uint2 o; o.x = pk2(v[i].x * gg.x, v[i].y * gg.y); o.y = pk2(v[i].z * gg.z, v[i].w * gg.w);
        *(uint2*)(ws_xb(p) + (size_t)m * DM + lane * 4 + 256 * i) = o;
    }
}

DEVI void ph_final(const Params& p, int item) {
    int w = tidx() >> 6, lane = tidx() & 63;
    int m = item * 4 + w;
    float* x = p.out + (size_t)m * DM;
    float4 v[4]; float ss = 0.f;
#pragma unroll
    for (int i = 0; i < 4; ++i) { v[i] = *(const float4*)(x + lane * 4 + 256 * i); ss += v[i].x * v[i].x + v[i].y * v[i].y + v[i].z * v[i].z + v[i].w * v[i].w; }
    ss = wave_sum(ss);
    float rs = rsqrtf(ss * (1.f / DM) + 1e-6f);
#pragma unroll
    for (int i = 0; i < 4; ++i) {
        float4 gg = *(const float4*)(p.final_g + lane * 4 + 256 * i);
        float4 o; o.x = v[i].x * rs * gg.x; o.y = v[i].y * rs * gg.y; o.z = v[i].z * rs * gg.z; o.w = v[i].w * rs * gg.w;
        *(float4*)(x + lane * 4 + 256 * i) = o;
    }
}

constexpr int GBM = 128, GBN = 128, GBK = 64, GLD = 72;
constexpr int GEMM_LDS = 2 * 2 * 128 * GLD * 2;
template <int EPI>
DEVI void ph_gemm_all(const Params& p, int l, int bid, int G, char* smem, bool dry = false) {
    constexpr int NT = EPI == 0 ? DIN / GBN : DM / GBN;
    constexpr int NTILES = (NTOK / GBM) * NT;
    if (bid >= NTILES) return;
#define G_COORDS(item_, r0_, c0_, pn_) { const int xcd_ = (item_) & 7, jx_ = (item_) >> 3; const int rg_ = jx_ / (8 * NT), wi_ = jx_ % (8 * NT); \
        pn_ = wi_ >> 3; r0_ = (xcd_ * 80 + rg_ * 8 + (wi_ & 7)) * GBM; c0_ = pn_ * GBN; }
    const bf16_t* A = EPI == 0 ? ws_xb(p) : ws_z(p);
    const int lda = EPI == 0 ? DM : DIN;
    const bf16_t* Bt = EPI == 0 ? ws_wt_in(p) + (size_t)l * DIN * DM : ws_wt_out(p) + (size_t)l * DM * DM;
    bf16_t* As = (bf16_t*)smem;
    bf16_t* Bs = As + 2 * 128 * GLD;
    const int tid = tidx(), wid = tid >> 6, lane = tid & 63, wr = wid >> 1, wc = wid & 1, fr = lane & 15, fq = lane >> 4;
    int item = bid, row0, col0, pn, nrow0 = 0, ncol0 = 0, npn = 0;
    G_COORDS(item, row0, col0, pn)
    bool hasn = item + G < NTILES;
    nrow0 = row0; ncol0 = col0; npn = pn;
    if (hasn) G_COORDS(item + G, nrow0, ncol0, npn)
    f32x4 acc[4][4];
#pragma unroll
    for (int m = 0; m < 4; ++m)
#pragma unroll
        for (int n = 0; n < 4; ++n) acc[m][n] = (f32x4){0.f, 0.f, 0.f, 0.f};
    u32x4 ra0[4], rb0[4], ra1[4], rb1[4];
    auto aoff = [&](int kt) __attribute__((always_inline)) -> int {
        if (EPI == 0) return kt * 64;
        const int blk = kt >> 2;
        const int bo = blk == 0 ? OFF_A : blk == 1 ? OFF_B : blk == 2 ? OFF_C : OFF_D;
        return bo + (kt & 3) * 64;
    };
    const int lr = tid >> 3, lch = (tid & 7) * 8;
    const unsigned va0 = (unsigned)(lr * lda + lch) * 2u, vb0 = (unsigned)(lr * DM + lch) * 2u;
    const unsigned vas = (unsigned)(32 * lda) * 2u, vbs = (unsigned)(32 * DM) * 2u;
#define G_LOAD1(ra, rb, i) ra[i] = *(const u32x4*)(ab_ + (va0 + (i) * vas)); rb[i] = *(const u32x4*)(bb_ + (vb0 + (i) * vbs));
#define G_LOAD(ra, rb, r0_, c0_, kt_) { const char* ab_ = (const char*)(A + (size_t)(r0_) * lda + aoff(kt_)); const char* bb_ = (const char*)(Bt + (size_t)(c0_) * DM + (kt_) * 64); \
        G_LOAD1(ra, rb, 0) G_LOAD1(ra, rb, 1) G_LOAD1(ra, rb, 2) G_LOAD1(ra, rb, 3) }
#define S_WRITE1(ra, rb, buf_, i) *(u32x4*)(As + ((buf_) * 128 + lr + 32 * (i)) * GLD + lch) = ra[i]; *(u32x4*)(Bs + ((buf_) * 128 + lr + 32 * (i)) * GLD + lch) = rb[i];
#define S_WRITE(ra, rb, buf_) { S_WRITE1(ra, rb, buf_, 0) S_WRITE1(ra, rb, buf_, 1) S_WRITE1(ra, rb, buf_, 2) S_WRITE1(ra, rb, buf_, 3) }
#define G_COMPUTE_W(buf_, ra, rb, wbuf_, dow_) { \
    bf16x8 af[2][4], bfr[2][4]; \
    _Pragma("unroll") for (int ks = 0; ks < 2; ++ks) { \
        _Pragma("unroll") for (int m = 0; m < 4; ++m) af[ks][m] = *(const bf16x8*)(As + ((buf_) * 128 + wr * 64 + m * 16 + fr) * GLD + ks * 32 + fq * 8); \
        _Pragma("unroll") for (int n = 0; n < 4; ++n) bfr[ks][n] = *(const bf16x8*)(Bs + ((buf_) * 128 + wc * 64 + n * 16 + fr) * GLD + ks * 32 + fq * 8); \
    } \
    if (dow_) S_WRITE(ra, rb, wbuf_) \
    __builtin_amdgcn_s_setprio(1); \
    _Pragma("unroll") for (int ks = 0; ks < 2; ++ks) \
        _Pragma("unroll") for (int m = 0; m < 4; ++m) \
            _Pragma("unroll") for (int n = 0; n < 4; ++n) acc[m][n] = __builtin_amdgcn_mfma_f32_16x16x32_bf16(bfr[ks][n], af[ks][m], acc[m][n], 0, 0, 0); \
    __builtin_amdgcn_s_setprio(0); }
    constexpr int NK = DM / GBK;
    __syncthreads();
    G_LOAD(ra0, rb0, row0, col0, 0) G_LOAD(ra1, rb1, row0, col0, 1)
    S_WRITE(ra0, rb0, 0)
    G_LOAD(ra0, rb0, row0, col0, 2)
    __syncthreads();
#pragma unroll 1
    for (;;) {
#pragma unroll 1
        for (int kt = 0; kt < NK; kt += 2) {
            G_COMPUTE_W(0, ra1, rb1, 1, true)
            __syncthreads();
            { const bool nx = kt + 3 >= NK; const int r_ = nx ? nrow0 : row0, c_ = nx ? ncol0 : col0, k_ = nx ? kt + 3 - NK : kt + 3; G_LOAD(ra1, rb1, r_, c_, k_) }
            G_COMPUTE_W(1, ra0, rb0, 0, true)
            __syncthreads();
            { const bool nx = kt + 4 >= NK; const int r_ = nx ? nrow0 : row0, c_ = nx ? ncol0 : col0, k_ = nx ? kt + 4 - NK : kt + 4; G_LOAD(ra0, rb0, r_, c_, k_) }
        }
#pragma unroll
        for (int mh = 0; mh < 2; ++mh) {
            float rsm[2] = {1.f, 1.f};
            f32x4 xres[2][4], ggn[4];
            if (EPI == 1 && !dry && l + 1 < NL) {
#pragma unroll
                for (int n = 0; n < 4; ++n) ggn[n] = *(const f32x4*)(p.norm_g + (l + 1) * DM + col0 + wc * 64 + n * 16 + fq * 4);
            }
            if (EPI == 0) {
                f32x4 q[2][4];
#pragma unroll
                for (int mm = 0; mm < 2; ++mm) {
                    const f32x4* pp = (const f32x4*)(ws_part(p) + (size_t)(row0 + wr * 64 + (2 * mh + mm) * 16 + fr) * 16);
#pragma unroll
                    for (int k = 0; k < 4; ++k) q[mm][k] = pp[k];
                }
#pragma unroll
                for (int mm = 0; mm < 2; ++mm) {
                    const f32x4 t = (q[mm][0] + q[mm][1]) + (q[mm][2] + q[mm][3]);
                    rsm[mm] = rsqrtf(((t[0] + t[1]) + (t[2] + t[3])) * (1.f / DM) + 1e-6f);
                }
            } else if (!dry) {
#pragma unroll
                for (int mm = 0; mm < 2; ++mm)
#pragma unroll
                    for (int n = 0; n < 4; ++n) xres[mm][n] = *(const f32x4*)(xrow(p, l, row0 + wr * 64 + (2 * mh + mm) * 16 + fr) + col0 + wc * 64 + n * 16 + fq * 4);
            }
#pragma unroll
            for (int mm = 0; mm < 2; ++mm) {
                const int m = 2 * mh + mm;
                const int row = row0 + wr * 64 + m * 16 + fr;
                const float rs = rsm[mm];
                float ssq = 0.f;
#pragma unroll
                for (int n = 0; n < 4; ++n) {
                    const int col = col0 + wc * 64 + n * 16 + fq * 4;
                    if (dry) { if (acc[m][n][0] == 1.2345e30f) ws_ctr(p)[63] = 1; }
                    else if (EPI == 0) {
                        if (pn == 12 || pn == 22) {
                            const unsigned tb = (unsigned)((row0 + wr * 64 + fq * 4) * DIN + col0 + wc * 64 + fr) * 2u;
#pragma unroll
                            for (int jj = 0; jj < 4; ++jj)
                                *(bf16_t*)((char*)ws_z(p) + (tb + (unsigned)((n * 16 + jj) * DIN + m * 16) * 2u)) = f2bf(acc[m][n][jj] * rs);
                        } else {
                            uint2 o; o.x = pk2(acc[m][n][0] * rs, acc[m][n][1] * rs); o.y = pk2(acc[m][n][2] * rs, acc[m][n][3] * rs);
                            *(uint2*)(ws_z(p) + (size_t)row * DIN + col) = o;
                        }
                    } else {
                        const f32x4 o = xres[mm][n] + acc[m][n];
                        *(f32x4*)(p.out + (size_t)row * DM + col) = o;
                        ssq += (o[0] * o[0] + o[1] * o[1]) + (o[2] * o[2] + o[3] * o[3]);
                        if (l + 1 < NL) {
                            const f32x4 og = o * ggn[n];
                            uint2 ob; ob.x = pk2(og[0], og[1]); ob.y = pk2(og[2], og[3]);
                            *(uint2*)(ws_xb(p) + (size_t)row * DM + col) = ob;
                        }
                    }
                }
                if (EPI == 1 && !dry) {
                    ssq += __shfl_xor(ssq, 16); ssq += __shfl_xor(ssq, 32);
                    if (fq == 0) ws_part(p)[(size_t)row * 16 + pn * 2 + wc] = ssq;
                }
            }
        }
        if (!hasn) break;
#pragma unroll
        for (int m = 0; m < 4; ++m)
#pragma unroll
            for (int n = 0; n < 4; ++n) acc[m][n] = (f32x4){0.f, 0.f, 0.f, 0.f};
        item += G; row0 = nrow0; col0 = ncol0; pn = npn;
        hasn = item + G < NTILES;
        if (hasn) G_COORDS(item + G, nrow0, ncol0, npn)
    }
#undef G_LOAD
#undef S_WRITE
#undef G_LOAD1
#undef S_WRITE1
#undef G_COMPUTE_W
#undef G_COORDS
}

constexpr int XLD = 264, LLD = 72;
constexpr int PREP_LDS = 64 * XLD * 2 + 2 * 64 * LLD * 2;
DEVI float ropeT(f2 cs, float x, int d) {
    const int e = d & 31;
    const float pr = __shfl_xor(x, 16);
    return (e < 16) ? x * cs.x - pr * cs.y : pr * cs.y + x * cs.x;
}
DEVI void ph_prep(const Params& p, int l, int item, char* smem, bool dry = false) {
    bf16_t* xc_s = (bf16_t*)smem;
    bf16_t* wl_s = xc_s + 64 * XLD;
    bf16_t* al_s = wl_s + 64 * LLD;
    const int tid = tidx(), w = tid >> 6, lane = tid & 63, fr = lane & 15, fq = lane >> 4;
    const int b = item >> 6, t0 = (item & 63) * 32;
    const size_t mbase = (size_t)b * T_ + t0;
    bf16_t* zt = ws_z(p) + mbase * DIN;
    __syncthreads();
    {
        const float* sh = p.rwkv_shift + l * 2 * 896;
        float s0[4], s1[4], pv[4], cu[4];
#pragma unroll
        for (int s_ = 0; s_ < 4; ++s_) {
            const int c = tid + 256 * s_;
            const bool ok = c < 896;
            s0[s_] = ok ? sh[c] : 0.f; s1[s_] = ok ? sh[896 + c] : 0.f;
            pv[s_] = (ok && t0 > 0) ? bf2f(zt[c - DIN]) : 0.f;
            cu[s_] = ok ? bf2f(zt[c]) : 0.f;
        }
        const float kkw = p.rwkv_k_k[l * 256 + tid];
        float cw[4];
#pragma unroll
        for (int jj = 0; jj < 4; ++jj) cw[jj] = p.lru_conv_w[(l * 4 + jj) * 256 + tid];
        const float cb = p.lru_conv_b[l * 256 + tid];
        float xm2 = t0 >= 2 ? bf2f(zt[OFF_C + tid - 2 * DIN]) : 0.f, xm1 = t0 >= 1 ? bf2f(zt[OFF_C + tid - DIN]) : 0.f, x0 = bf2f(zt[OFF_C + tid]);
        const float qnw = p.attn_q_norm[l * 64 + lane], knw = p.attn_k_norm[l * 64 + lane];
        const bool c3 = tid < 128;
        bf16_t nA[2][4][4], nC[2][4], qB[2][4], kB[2][4];
        f2 cs8[2][4];
#define PREP_LOADG(B_, G_) { \
            _Pragma("unroll") for (int i8 = 0; i8 < 4; ++i8) { \
                const int tt = (G_) * 4 + i8; \
                const bf16_t* zr = zt + (size_t)tt * DIN; \
                const bool hasn = t0 + tt + 1 < T_; \
                _Pragma("unroll") for (int s_ = 0; s_ < 4; ++s_) nA[B_][i8][s_] = (hasn && (s_ < 3 || c3)) ? zr[tid + 256 * s_ + DIN] : (bf16_t)0; \
                nC[B_][i8] = hasn ? zr[OFF_C + tid + DIN] : (bf16_t)0; \
                qB[B_][i8] = zr[OFF_B + tid]; \
                kB[B_][i8] = c3 ? zr[OFF_B + 256 + tid] : (bf16_t)0; \
                cs8[B_][i8] = *(const f2*)(ws_rope(p) + 2 * (((lane >> 5) ? (t0 & 63) + tt : (t0 >> 6)) * 16 + (lane & 15))); \
            } }
#define PREP_COMPG(B_, G_) { \
            _Pragma("unroll") for (int i8 = 0; i8 < 4; ++i8) { \
                const int tt = (G_) * 4 + i8; \
                bf16_t* zr = zt + (size_t)tt * DIN; \
                float xs[4]; \
                _Pragma("unroll") for (int s_ = 0; s_ < 4; ++s_) { \
                    const float nx = bf2f(nA[B_][i8][s_]); \
                    xs[s_] = cu[s_] + s0[s_] * (pv[s_] - cu[s_]) + s1[s_] * (nx - cu[s_]); \
                    pv[s_] = cu[s_]; cu[s_] = nx; \
                } \
                const size_t o = (mbase + tt) * 256 + tid; \
                const float kkv = xs[1] * kkw; \
                const float ss = wave_sum(kkv * kkv); \
                ws_sR(p)[o] = f2bf(xs[0]); ws_sK(p)[o] = f2bf(xs[1]); ws_sV(p)[o] = f2bf(xs[2]); ws_sKK(p)[o] = f2bf(kkv * rsqrtf(fmaxf(ss, 1e-24f))); \
                if (tid < 64) wl_s[tt * LLD + tid] = f2bf(1.f - 2.f / (1.f + __expf(2.f * xs[3]))); \
                else if (tid < 128) al_s[tt * LLD + tid - 64] = f2bf(xs[3]); \
                const float xp1 = bf2f(nC[B_][i8]); \
                xc_s[tt * XLD + tid] = f2bf(cb + cw[0] * xm2 + cw[1] * xm1 + cw[2] * x0 + cw[3] * xp1); \
                xm2 = xm1; xm1 = x0; x0 = xp1; \
                const float q = bf2f(qB[B_][i8]); \
                const float s2 = wave_sum(q * q); \
                const float qn = ropeT(cs8[B_][i8], q * rsqrtf(s2 * (1.f / 64.f) + 1e-6f) * qnw, lane) * (0.125f * 1.4426950408889634f); \
                if (!dry) zr[OFF_B + tid] = f2bf(qn); \
                if (c3) { \
                    const float kx = bf2f(kB[B_][i8]); \
                    const float s3 = wave_sum(kx * kx); \
                    const float kro = ropeT(cs8[B_][i8], kx * rsqrtf(s3 * (1.f / 64.f) + 1e-6f) * knw, lane); \
                    if (!dry) zr[OFF_B + 256 + tid] = f2bf(kro); \
                } \
            } }
        PREP_LOADG(0, 0)
#pragma unroll 1
        for (int g = 0; g < 8; g += 2) {
            PREP_LOADG(1, g + 1)
            PREP_COMPG(0, g)
            if (g + 2 < 8) PREP_LOADG(0, g + 2)
            PREP_COMPG(1, g + 1)
        }
#undef PREP_LOADG
#undef PREP_COMPG
    }
    __syncthreads();
#pragma unroll 1
    for (int dm = 0; dm < 4; ++dm) {
        const int d = dm >> 1, mat = dm & 1;
        const bf16_t* Bt = (mat ? ws_aup_t(p) : ws_wup_t(p)) + ((size_t)(l * 2 + d) * 256 + 64 * w) * 64;
        bf16x8 bfr[4][2];
#pragma unroll
        for (int nt = 0; nt < 4; ++nt)
#pragma unroll
            for (int ks = 0; ks < 2; ++ks) bfr[nt][ks] = *(const bf16x8*)(Bt + (16 * nt + fr) * 64 + 32 * ks + 8 * fq);
        const bf16_t* As = mat ? al_s : wl_s;
        const float* bias = (mat ? p.rwkv_a0 : p.rwkv_w0) + (l * 2 + d) * 256 + 64 * w + 4 * fq;
        bf16_t* dst = (mat ? ws_sA0(p) : ws_sW0(p)) + d * SA_EL + mbase * 256 + 64 * w + 4 * fq;
        f32x4 bvh[4];
#pragma unroll
        for (int nt = 0; nt < 4; ++nt) bvh[nt] = *(const f32x4*)(bias + 16 * nt);
#pragma unroll 1
        for (int m = 0; m < 2; ++m) {
            bf16x8 af[2];
#pragma unroll
            for (int ks = 0; ks < 2; ++ks) af[ks] = *(const bf16x8*)(As + (16 * m + fr) * LLD + 32 * ks + 8 * fq);
#pragma unroll
            for (int nt = 0; nt < 4; ++nt) {
                f32x4 acc = (f32x4){0.f, 0.f, 0.f, 0.f};
#pragma unroll
                for (int ks = 0; ks < 2; ++ks) acc = __builtin_amdgcn_mfma_f32_16x16x32_bf16(bfr[nt][ks], af[ks], acc, 0, 0, 0);
                const f32x4 bv = bvh[nt];
                float ov[4];
#pragma unroll
                for (int jj = 0; jj < 4; ++jj) {
                    const float sg = sigm(acc[jj] + bv[jj]);
                    ov[jj] = mat ? sg : 1.f - __expf(-0.6065306597126334f * sg);
                }
                u32x2 o2; o2[0] = pk2(ov[0], ov[1]); o2[1] = pk2(ov[2], ov[3]);
                *(u32x2*)(dst + (size_t)(16 * m + fr) * 256 + 16 * nt) = o2;
            }
        }
    }
#pragma unroll 1
    for (int d = 0; d < 2; ++d) {
        bf16x8 bfr[2][4][2];
#pragma unroll
        for (int k = 0; k < 2; ++k)
#pragma unroll
            for (int nt = 0; nt < 4; ++nt)
#pragma unroll
                for (int ks = 0; ks < 2; ++ks)
                    bfr[k][nt][ks] = *(const bf16x8*)(ws_gw_t(p) + ((size_t)(((l * 2 + d) * 2 + k) * 4 + w) * 64 + 16 * nt + fr) * 64 + 32 * ks + 8 * fq);
        const int e00 = 64 * w + 4 * fq;
        f32x4 gb0h[4], gb1h[4], sph[4];
#pragma unroll
        for (int nt = 0; nt < 4; ++nt) {
            const int e0 = e00 + 16 * nt;
            gb0h[nt] = *(const f32x4*)(p.lru_gate_b + ((l * 2 + d) * 2 + 0) * 256 + e0); gb1h[nt] = *(const f32x4*)(p.lru_gate_b + ((l * 2 + d) * 2 + 1) * 256 + e0);
            const f32x4 lam = *(const f32x4*)(p.lru_lambda + (l * 2 + d) * 256 + e0);
#pragma unroll
            for (int jj = 0; jj < 4; ++jj) sph[nt][jj] = __logf(1.f + __expf(-lam[jj]));
        }
#pragma unroll 1
        for (int m = 0; m < 2; ++m) {
            bf16x8 af[2];
#pragma unroll
            for (int ks = 0; ks < 2; ++ks) af[ks] = *(const bf16x8*)(xc_s + (16 * m + fr) * XLD + 64 * w + 32 * ks + 8 * fq);
#pragma unroll
            for (int nt = 0; nt < 4; ++nt) {
                f32x4 g0 = (f32x4){0.f, 0.f, 0.f, 0.f}, g1 = g0;
#pragma unroll
                for (int ks = 0; ks < 2; ++ks) {
                    g0 = __builtin_amdgcn_mfma_f32_16x16x32_bf16(bfr[0][nt][ks], af[ks], g0, 0, 0, 0);
                    g1 = __builtin_amdgcn_mfma_f32_16x16x32_bf16(bfr[1][nt][ks], af[ks], g1, 0, 0, 0);
                }
                const int e0 = e00 + 16 * nt;
                const f32x4 gb0 = gb0h[nt], gb1 = gb1h[nt];
                const u32x2 xu = *(const u32x2*)(xc_s + (16 * m + fr) * XLD + e0);
                const float xv[4] = {__uint_as_float(xu[0] << 16), __uint_as_float(xu[0] & 0xffff0000u), __uint_as_float(xu[1] << 16), __uint_as_float(xu[1] & 0xffff0000u)};
                float a1[4], bt[4];
#pragma unroll
                for (int jj = 0; jj < 4; ++jj) {
                    const float r = sigm(g0[jj] + gb0[jj]), ig = sigm(g1[jj] + gb1[jj]);
                    const float sp = sph[nt][jj];
                    const float a = __expf(-8.f * r * sp);
                    a1[jj] = 1.f - a;
                    bt[jj] = sqrtf(a1[jj] * (1.f + a)) * ig * xv[jj];
                }
                const size_t o = d * SA_EL + (mbase + 16 * m + fr) * 256 + e0;
                u32x2 oa; oa[0] = pk2(a1[0], a1[1]); oa[1] = pk2(a1[2], a1[3]);
                u32x2 ob; ob[0] = pk2(bt[0], bt[1]); ob[1] = pk2(bt[2], bt[3]);
                *(u32x2*)(ws_la(p) + o) = oa; *(u32x2*)(ws_h0(p) + o) = ob;
            }
        }
    }
}

DEVI f2 fma2(f2 a, f2 b, f2 c) { return __builtin_elementwise_fma(a, b, c); }
DEVI void ph_rwkv_scan(const Params& p, int l, int item, char* smem, bool dry = false) {
    const int wv = __builtin_amdgcn_readfirstlane(tidx() >> 6), lane = tidx() & 63;
    const int wi = item * 4 + wv;
    const int scan = wi / 3, part = wi - scan * 3;
    const int b = scan >> 3, h = (scan >> 1) & 3, d = scan & 1;
    const int c8 = lane & 7, r8 = lane >> 3;
    float* ring = (float*)smem + wv * 1280;
    const char* A = (const char*)(ws_sA0(p) + d * SA_EL);
    const char* Wm = (const char*)(ws_sW0(p) + d * SA_EL);
    const char *R = (const char*)ws_sR(p), *K = (const char*)ws_sK(p), *V = (const char*)ws_sV(p), *KK = (const char*)ws_sKK(p);
    char* Y = (char*)(ws_z(p) + 256 + 256 * d + h * 64);
#define LDB(base, bo) (*(const bf16_t*)((base) + (bo)))
    const float ka = p.rwkv_k_a[l * 256 + h * 64 + lane];
    f2 S[3][4];
#pragma unroll
    for (int pp = 0; pp < 3; ++pp)
#pragma unroll
        for (int k = 0; k < 4; ++k) S[pp][k] = (f2){0.f, 0.f};
    const unsigned t00 = (unsigned)(b * T_ + (d ? T_ - 1 : 0)) * 256u + h * 64;
    const unsigned o0 = (t00 + lane) * 2u;
    int rowp[3]; unsigned ov[3];
#pragma unroll
    for (int pp = 0; pp < 3; ++pp) { rowp[pp] = 24 * part + 8 * pp + r8; ov[pp] = (t00 + (rowp[pp] < 64 ? rowp[pp] : 63)) * 2u; }
    const int stp = d ? -512 : 512;
    const int myp = c8 < 3 ? c8 : 0;
    const int myrow = 24 * part + 8 * myp + r8;
    const bool ystore = c8 < 3 && myrow < 64 && !dry;
    const unsigned yrow_b = (unsigned)myrow * 2u;
    float vcur[3], vnx[3];
#pragma unroll
    for (int s_ = 0; s_ < 2; ++s_) {
        const unsigned o = o0 + s_ * stp;
        const float r = bf2f(LDB(R, o)), k = bf2f(LDB(K, o)), kk = bf2f(LDB(KK, o)), a = bf2f(LDB(A, o)), w = 1.f - bf2f(LDB(Wm, o));
#pragma unroll
        for (int pp = 0; pp < 3; ++pp) { const float vv = bf2f(LDB(V, ov[pp] + s_ * stp)); if (s_ == 0) vcur[pp] = vv; else vnx[pp] = vv; }
        float* sl = ring + s_ * 320;
        sl[0 * 64 + lane] = w; sl[1 * 64 + lane] = kk * a; sl[2 * 64 + lane] = k * (1.f + (a - 1.f) * ka); sl[3 * 64 + lane] = r; sl[4 * 64 + lane] = kk;
    }
    bf16_t rr[8], rk[8], rkk[8], ra[8], rw[8], rv[8][3];
#pragma unroll
    for (int i = 0; i < 8; ++i) {
        const int st = (i < 2 ? 8 + i : i) * stp;
        rr[i] = LDB(R, o0 + st); rk[i] = LDB(K, o0 + st); rkk[i] = LDB(KK, o0 + st); ra[i] = LDB(A, o0 + st); rw[i] = LDB(Wm, o0 + st);
#pragma unroll
        for (int pp = 0; pp < 3; ++pp) rv[i][pp] = LDB(V, ov[pp] + st);
    }
    __builtin_amdgcn_wave_barrier();
    f32x4 OB[2][5][2];
#define RW_LDO(set, slw, slk) { _Pragma("unroll") for (int g = 0; g < 2; ++g) { \
        OB[set][0][g] = *(const f32x4*)((slw) + 0 * 64 + 8 * c8 + 4 * g); OB[set][1][g] = *(const f32x4*)((slw) + 1 * 64 + 8 * c8 + 4 * g); \
        OB[set][2][g] = *(const f32x4*)((slw) + 2 * 64 + 8 * c8 + 4 * g); OB[set][3][g] = *(const f32x4*)((slw) + 3 * 64 + 8 * c8 + 4 * g); \
        OB[set][4][g] = *(const f32x4*)((slk) + 4 * 64 + 8 * c8 + 4 * g); } }
    RW_LDO(0, ring, ring + 320)
    float sktot[3] = {0.f, 0.f, 0.f};
    __builtin_amdgcn_s_setprio(3);
    for (int sb = 0; sb < T_; sb += 8) {
#pragma unroll
        for (int i = 0; i < 8; ++i) {
            const int step = sb + i;
            const int slot = (i + 2) & 7;
            float v2n[3];
            {
                float* sn = ring + ((i + 2) & 3) * 320;
                const float r1 = bf2f(rr[slot]), k1 = bf2f(rk[slot]), kk1 = bf2f(rkk[slot]), a1 = bf2f(ra[slot]), w1 = 1.f - bf2f(rw[slot]);
                sn[0 * 64 + lane] = w1; sn[1 * 64 + lane] = kk1 * a1; sn[2 * 64 + lane] = k1 * (1.f + (a1 - 1.f) * ka); sn[3 * 64 + lane] = r1; sn[4 * 64 + lane] = kk1;
#pragma unroll
                for (int pp = 0; pp < 3; ++pp) v2n[pp] = bf2f(rv[slot][pp]);
            }
            {
                const int s10 = (step + 10 < T_ ? step + 10 : T_ - 1) * stp;
                const unsigned oc = o0 + s10;
                rr[slot] = LDB(R, oc); rk[slot] = LDB(K, oc); rkk[slot] = LDB(KK, oc); ra[slot] = LDB(A, oc); rw[slot] = LDB(Wm, oc);
#pragma unroll
                for (int pp = 0; pp < 3; ++pp) rv[slot][pp] = LDB(V, ov[pp] + s10);
            }
            __builtin_amdgcn_wave_barrier();
            RW_LDO((i + 1) & 1, ring + ((i + 1) & 3) * 320, ring + ((i + 2) & 3) * 320)
            const unsigned tok_b = (unsigned)(b * T_ + (d ? T_ - 1 - step : step)) * (unsigned)(DIN * 2);
            float pyv[3];
#pragma unroll
            for (int pp = 0; pp < 3; ++pp) {
                const f2 nsk2 = (f2){-sktot[pp], -sktot[pp]}, v2 = (f2){vcur[pp], vcur[pp]};
                f2 y2 = (f2){0.f, 0.f}, sk2 = (f2){0.f, 0.f};
#pragma unroll
                for (int g = 0; g < 2; ++g) {
                    const f32x4 w4 = OB[i & 1][0][g], b4 = OB[i & 1][1][g], kd4 = OB[i & 1][2][g], r4 = OB[i & 1][3][g], kn4 = OB[i & 1][4][g];
                    f2 t0 = v2 * kd4.xy; t0 = fma2(nsk2, b4.xy, t0);
                    S[pp][2 * g] = fma2(S[pp][2 * g], w4.xy, t0);
                    y2 = fma2(S[pp][2 * g], r4.xy, y2); sk2 = fma2(S[pp][2 * g], kn4.xy, sk2);
                    f2 t1 = v2 * kd4.zw; t1 = fma2(nsk2, b4.zw, t1);
                    S[pp][2 * g + 1] = fma2(S[pp][2 * g + 1], w4.zw, t1);
                    y2 = fma2(S[pp][2 * g + 1], r4.zw, y2); sk2 = fma2(S[pp][2 * g + 1], kn4.zw, sk2);
                }
                float ps = sk2.x + sk2.y, py = y2.x + y2.y;
                ps += dppx<0xB1>(ps); py += dppx<0xB1>(py);
                ps += dppx<0x4E>(ps); py += dppx<0x4E>(py);
                ps += dppx<0x141>(ps); py += dppx<0x141>(py);
                sktot[pp] = ps; pyv[pp] = py;
                vcur[pp] = vnx[pp]; vnx[pp] = v2n[pp];
            }
            {
                const float ysel = c8 == 0 ? pyv[0] : c8 == 1 ? pyv[1] : pyv[2];
                if (ystore) *(bf16_t*)(Y + (tok_b + yrow_b)) = f2bf(ysel);
            }
        }
    }
    __builtin_amdgcn_s_setprio(0);
#undef RW_LDO
#undef LDB
}

DEVI void ph_lru_scan(const Params& p, int l, int item, bool dry = false) {
    const int lane = tidx() & 63, idx = item * 4 + (tidx() >> 6);
    const int b = idx >> 3, n = (idx >> 1) & 3, d = idx & 1;
    const bf16_t* A = ws_la(p) + d * SA_EL + (size_t)b * T_ * 256 + n * 64 + lane;
    bf16_t* H = ws_h0(p) + d * SA_EL + (size_t)b * T_ * 256 + n * 64 + lane;
    float h = 0.f;
    for (int s0 = 0; s0 < T_; s0 += 32) {
        bf16_t av[32], bv[32];
#pragma unroll
        for (int i = 0; i < 32; ++i) { const int t = d ? T_ - 1 - (s0 + i) : s0 + i; av[i] = A[(size_t)t * 256]; bv[i] = H[(size_t)t * 256]; }
#pragma unroll
        for (int i = 0; i < 32; ++i) {
            const int t = d ? T_ - 1 - (s0 + i) : s0 + i;
            h = (1.f - bf2f(av[i])) * h + bf2f(bv[i]);
            if (!dry) H[(size_t)t * 256] = f2bf(h);
        }
    }
}

DEVI void ph_post_all(const Params& p, int l, int bid, int G) {
    const int j = tidx();
    const float lg = p.rwkv_ln_g[l * 256 + j], lb = p.rwkv_ln_b[l * 256 + j], ka = p.rwkv_k_a[l * 256 + j], rk_ = p.rwkv_r_k[l * 256 + j];
    constexpr int NIT = NTOK / 8;
    if (bid >= NIT) return;
    const int ng = (NIT - bid + G - 1) / G;
    bf16_t yf[2][8], yr[2][8], r_[2][8], k_[2][8], v_[2][8], af[2][8], ar[2][8], ga[2][8], hf[2][8], hr[2][8], gc[2][8];
#define POST_LOAD(B_, GI_) { \
        _Pragma("unroll") for (int i = 0; i < 8; ++i) { \
            const int m = (bid + (GI_) * G) * 8 + i; \
            const size_t o = (size_t)m * 256 + j; \
            const bf16_t* zr = ws_z(p) + (size_t)m * DIN; \
            yf[B_][i] = zr[256 + j]; yr[B_][i] = zr[512 + j]; r_[B_][i] = ws_sR(p)[o]; k_[B_][i] = ws_sK(p)[o]; v_[B_][i] = ws_sV(p)[o]; \
            af[B_][i] = ws_sA0(p)[o]; ar[B_][i] = ws_sA0(p)[o + SA_EL]; ga[B_][i] = zr[OFF_A + 896 + j]; \
            hf[B_][i] = ws_h0(p)[o]; hr[B_][i] = ws_h0(p)[o + SA_EL]; gc[B_][i] = zr[OFF_C + 256 + j]; \
        } }
#define POST_COMP(B_, GI_) { \
        _Pragma("unroll") for (int i = 0; i < 8; ++i) { \
            const int m = (bid + (GI_) * G) * 8 + i; \
            bf16_t* zr = ws_z(p) + (size_t)m * DIN; \
            const float y = bf2f(yf[B_][i]) + bf2f(yr[B_][i]); \
            const float mu = wave_sum(y) * (1.f / 64.f); \
            const float dv = y - mu; \
            const float var = wave_sum(dv * dv) * (1.f / 64.f); \
            const float yn = dv * rsqrtf(var + 64e-5f) * lg + lb; \
            const float r = bf2f(r_[B_][i]), k = bf2f(k_[B_][i]), v = bf2f(v_[B_][i]), a_f = bf2f(af[B_][i]), a_r = bf2f(ar[B_][i]); \
            const float ksum = k * (1.f + (a_f - 1.f) * ka) + k * (1.f + (a_r - 1.f) * ka); \
            const float bon = wave_sum(r * ksum * rk_) * v; \
            const float g = bf2f(ga[B_][i]); \
            zr[OFF_A + j] = f2bf((yn + bon) * g * sigm(g)); \
            const float h = bf2f(hf[B_][i]) + bf2f(hr[B_][i]); \
            const float g2 = bf2f(gc[B_][i]); \
            zr[OFF_C + j] = f2bf(h * g2 * sigm(g2)); \
        } }
    POST_LOAD(0, 0)
#pragma unroll 1
    for (int gi = 0; gi < ng; gi += 2) {
        if (gi + 1 < ng) POST_LOAD(1, gi + 1)
        POST_COMP(0, gi)
        if (gi + 2 < ng) POST_LOAD(0, gi + 2)
        if (gi + 1 < ng) POST_COMP(1, gi + 1)
    }
#undef POST_LOAD
#undef POST_COMP
}

template <int WIN>
DEVI void ph_attn_naive(const Params& p, int l, int item) {
    const int lane = tidx() & 63, idx = item * 4 + (tidx() >> 6);
    const int qb = idx & 31, hq = (idx >> 5) & 3, b = idx >> 7;
    const int g = hq >> 1;
    constexpr int OFF = WIN ? OFF_D : OFF_B;
    const int t0 = qb * 64, t = t0 + lane;
    bf16_t* zq = ws_z(p) + ((size_t)b * T_ + t) * DIN + OFF + hq * 64;
    float q[64], o[64];
#pragma unroll
    for (int c = 0; c < 8; ++c) {
        const uint4 u = *(const uint4*)(zq + c * 8);
        const unsigned uu[4] = {u.x, u.y, u.z, u.w};
#pragma unroll
        for (int e = 0; e < 4; ++e) { q[c * 8 + 2 * e] = __uint_as_float(uu[e] << 16); q[c * 8 + 2 * e + 1] = __uint_as_float(uu[e] & 0xffff0000u); }
    }
#pragma unroll
    for (int dd = 0; dd < 64; ++dd) o[dd] = 0.f;
    float mx, ls;
    float slope = 0.f;
    if (WIN) { mx = p.swa_sink[l * 4 + hq]; ls = 1.f; slope = exp2f(-8.f * (float)(hq + 1) / 4.f); }
    else { mx = -1e30f; ls = 0.f; }
    const int s0 = WIN ? max(0, t0 - 128) : 0, s1 = WIN ? min(T_ - 1, t0 + 63 + 128) : T_ - 1;
    const bf16_t* kb = ws_z(p) + (size_t)b * T_ * DIN + OFF + 256 + g * 64;
    for (int s = s0; s <= s1; ++s) {
        const bf16_t* kr = kb + (size_t)s * DIN;
        float sc = 0.f;
#pragma unroll
        for (int c = 0; c < 8; ++c) {
            const uint4 u = *(const uint4*)(kr + c * 8);
            const unsigned uu[4] = {u.x, u.y, u.z, u.w};
#pragma unroll
            for (int e = 0; e < 4; ++e) { sc += q[c * 8 + 2 * e] * __uint_as_float(uu[e] << 16); sc += q[c * 8 + 2 * e + 1] * __uint_as_float(uu[e] & 0xffff0000u); }
        }
        bool valid = true;
        if (WIN) { const int dist = abs(t - s); valid = dist <= 128; sc = sc * 0.125f - slope * (float)dist; }
        const float mn = valid ? fmaxf(mx, sc) : mx;
        const float al = __expf(mx - mn);
        const float pp = valid ? __expf(sc - mn) : 0.f;
        mx = mn; ls = ls * al + pp;
#pragma unroll
        for (int c = 0; c < 8; ++c) {
            const uint4 u = *(const uint4*)(kr + 128 + c * 8);
            const unsigned uu[4] = {u.x, u.y, u.z, u.w};
#pragma unroll
            for (int e = 0; e < 4; ++e) {
                o[c * 8 + 2 * e] = o[c * 8 + 2 * e] * al + pp * __uint_as_float(uu[e] << 16);
                o[c * 8 + 2 * e + 1] = o[c * 8 + 2 * e + 1] * al + pp * __uint_as_float(uu[e] & 0xffff0000u);
            }
        }
    }
    const float il = 1.f / ls;
    const bf16_t* zg = zq - hq * 64 + 512 + hq * 64;
#pragma unroll
    for (int c = 0; c < 8; ++c) {
        const uint4 u = *(const uint4*)(zg + c * 8);
        const unsigned uu[4] = {u.x, u.y, u.z, u.w};
        unsigned ov[4];
#pragma unroll
        for (int e = 0; e < 4; ++e) {
            const float g0 = __uint_as_float(uu[e] << 16), g1 = __uint_as_float(uu[e] & 0xffff0000u);
            ov[e] = pk2(o[c * 8 + 2 * e] * il * g0 * sigm(g0), o[c * 8 + 2 * e + 1] * il * g1 * sigm(g1));
        }
        *(uint4*)(zq + c * 8) = make_uint4(ov[0], ov[1], ov[2], ov[3]);
    }
}

constexpr int ALD = 72;
template <int WIN>
DEVI void ph_attn(const Params& p, int l, int item, char* smem, bool dry = false) {
    constexpr int OFF = WIN ? OFF_D : OFF_B;
    const int qb = item & 15, hq = (item >> 4) & 3, b = item >> 6, g = hq >> 1;
    const int tid = tidx(), w = tid >> 6, lane = tid & 63, fr = lane & 15, fq = lane >> 4;
    const int t0 = qb * 128, tw = t0 + 32 * w;
    bf16_t* Ks = (bf16_t*)smem;
    bf16_t* Vt = Ks + 2 * 64 * ALD;
    bf16_t* zb = ws_z(p) + (size_t)b * T_ * DIN;
    bf16x8 qf[2][2];
#pragma unroll
    for (int n = 0; n < 2; ++n)
#pragma unroll
        for (int ks = 0; ks < 2; ++ks) {
            u32x4 u = *(const u32x4*)(zb + (size_t)(tw + 16 * n + fr) * DIN + OFF + hq * 64 + 32 * ks + 8 * fq);
            if (WIN) {
                constexpr float sc = 0.125f * 1.4426950408889634f;
#pragma unroll
                for (int e = 0; e < 4; ++e) u[e] = pk2(__uint_as_float(u[e] << 16) * sc, __uint_as_float(u[e] & 0xffff0000u) * sc);
            }
            qf[n][ks] = __builtin_bit_cast(bf16x8, u);
        }
    const int kt0 = WIN ? max(0, t0 - 128) / 64 : 0, kt1 = WIN ? min(T_, t0 + 256) / 64 : T_ / 64;
    f32x4 ot[4][2];
#pragma unroll
    for (int dm = 0; dm < 4; ++dm)
#pragma unroll
        for (int n = 0; n < 2; ++n) ot[dm][n] = (f32x4){0.f, 0.f, 0.f, 0.f};
    float mrun[2], lrun[2];
    float slope2 = 0.f;
    if (WIN) {
        const float sk = p.swa_sink[l * 4 + hq] * 1.4426950408889634f;
        mrun[0] = mrun[1] = sk; lrun[0] = lrun[1] = fq == 0 ? 1.f : 0.f;
        slope2 = exp2f(-2.f * (float)(hq + 1)) * 1.4426950408889634f;
    } else { mrun[0] = mrun[1] = -1e30f; lrun[0] = lrun[1] = 0.f; }
    const bf16_t* kbase = zb + OFF + 256 + g * 64;
    const bf16_t* vbase = zb + OFF + 384 + g * 64;
    u32x4 rk[2], rv[2];
    const int kkey = tid >> 2, kc = tid & 3;
    auto gload = [&](int kt) __attribute__((always_inline)) {
        const bf16_t* kp = kbase + (size_t)(kt * 64 + kkey) * DIN + kc * 16;
        rk[0] = *(const u32x4*)kp; rk[1] = *(const u32x4*)(kp + 8);
        const bf16_t* vp = vbase + (size_t)(kt * 64 + kkey) * DIN + kc * 16;
        rv[0] = *(const u32x4*)vp; rv[1] = *(const u32x4*)(vp + 8);
    };
    auto swrite = [&](int buf) __attribute__((always_inline)) {
        bf16_t* kd = Ks + (buf * 64 + kkey) * ALD + kc * 16;
        *(u32x4*)kd = rk[0]; *(u32x4*)(kd + 8) = rk[1];
        bf16_t* vd = Vt + (buf * 64 + kkey) * ALD + kc * 16;
        *(u32x4*)vd = rv[0]; *(u32x4*)(vd + 8) = rv[1];
    };
    __syncthreads();
    gload(kt0); swrite(0);
    __syncthreads();
    for (int kt = kt0; kt < kt1; ++kt) {
        const int buf = (kt - kt0) & 1;
        if (kt + 1 < kt1) gload(kt + 1);
        f32x4 st[4][2];
#pragma unroll
        for (int m = 0; m < 4; ++m)
#pragma unroll
            for (int n = 0; n < 2; ++n) st[m][n] = (f32x4){0.f, 0.f, 0.f, 0.f};
#pragma unroll
        for (int ks = 0; ks < 2; ++ks)
#pragma unroll
            for (int m = 0; m < 4; ++m) {
                const bf16x8 kf = *(const bf16x8*)(Ks + (buf * 64 + 16 * m + fr) * ALD + 32 * ks + 8 * fq);
#pragma unroll
                for (int n = 0; n < 2; ++n) st[m][n] = __builtin_amdgcn_mfma_f32_16x16x32_bf16(kf, qf[n][ks], st[m][n], 0, 0, 0);
            }
        if (WIN) {
#pragma unroll
            for (int m = 0; m < 4; ++m)
#pragma unroll
                for (int n = 0; n < 2; ++n)
#pragma unroll
                    for (int j = 0; j < 4; ++j) {
                        const int dist = abs((tw + 16 * n + fr) - (kt * 64 + 16 * m + 4 * fq + j));
                        st[m][n][j] = dist <= 128 ? st[m][n][j] - slope2 * (float)dist : -1e30f;
                    }
        }
#pragma unroll
        for (int n = 0; n < 2; ++n) {
            float mt = st[0][n][0];
#pragma unroll
            for (int m = 0; m < 4; ++m)
#pragma unroll
                for (int j = 0; j < 4; ++j) mt = fmaxf(mt, st[m][n][j]);
            mt = fmaxf(mt, __shfl_xor(mt, 16)); mt = fmaxf(mt, __shfl_xor(mt, 32));
            const float mn = fmaxf(mrun[n], mt);
            const float alpha = __builtin_amdgcn_exp2f(mrun[n] - mn);
            mrun[n] = mn;
            float lsum = 0.f;
#pragma unroll
            for (int m = 0; m < 4; ++m)
#pragma unroll
                for (int j = 0; j < 4; ++j) { const float pv = __builtin_amdgcn_exp2f(st[m][n][j] - mn); lsum += pv; st[m][n][j] = pv; }
            lrun[n] = lrun[n] * alpha + lsum;
#pragma unroll
            for (int dm = 0; dm < 4; ++dm) ot[dm][n] = ot[dm][n] * alpha;
        }
#pragma unroll
        for (int kk = 0; kk < 2; ++kk) {
            bf16x8 pf[2];
#pragma unroll
            for (int n = 0; n < 2; ++n) {
                u32x4 u;
                u[0] = pk2(st[2 * kk][n][0], st[2 * kk][n][1]); u[1] = pk2(st[2 * kk][n][2], st[2 * kk][n][3]);
                u[2] = pk2(st[2 * kk + 1][n][0], st[2 * kk + 1][n][1]); u[3] = pk2(st[2 * kk + 1][n][2], st[2 * kk + 1][n][3]);
                pf[n] = __builtin_bit_cast(bf16x8, u);
            }
#pragma unroll
            for (int dm = 0; dm < 4; ++dm) {
                const bf16_t* vp = Vt + (buf * 64 + 16 * dm + fr) * ALD + 32 * kk + 4 * fq;
                const u32x2 v0 = *(const u32x2*)vp, v1 = *(const u32x2*)(vp + 16);
                const bf16x8 vf = __builtin_bit_cast(bf16x8, (u32x4){v0[0], v0[1], v1[0], v1[1]});
#pragma unroll
                for (int n = 0; n < 2; ++n) ot[dm][n] = __builtin_amdgcn_mfma_f32_16x16x32_bf16(vf, pf[n], ot[dm][n], 0, 0, 0);
            }
        }
        if (kt + 1 < kt1) swrite(buf ^ 1);
        __syncthreads();
    }
#pragma unroll
    for (int n = 0; n < 2; ++n) {
        float lt = lrun[n];
        lt += __shfl_xor(lt, 16); lt += __shfl_xor(lt, 32);
        const float il = 1.f / lt;
        bf16_t* zr = zb + (size_t)(tw + 16 * n + fr) * DIN + OFF + hq * 64 + 4 * fq;
#pragma unroll
        for (int dm = 0; dm < 4; ++dm) {
            const u32x2 gu = *(const u32x2*)(zr + 512 + 16 * dm);
            float gv[4] = {__uint_as_float(gu[0] << 16), __uint_as_float(gu[0] & 0xffff0000u), __uint_as_float(gu[1] << 16), __uint_as_float(gu[1] & 0xffff0000u)};
            float ov[4];
#pragma unroll
            for (int j = 0; j < 4; ++j) ov[j] = ot[dm][n][j] * il * gv[j] * sigm(gv[j]);
            u32x2 o2; o2[0] = pk2(ov[0], ov[1]); o2[1] = pk2(ov[2], ov[3]);
            if (!dry) *(u32x2*)(zr + 16 * dm) = o2;
        }
    }
}

DEVI void gbar(unsigned* ctr, unsigned target) {
    asm volatile("s_waitcnt vmcnt(0)" ::: "memory");
    __syncthreads();
    if (threadIdx.x == 0) {
        __builtin_amdgcn_fence(__ATOMIC_RELEASE, "agent");
        asm volatile("s_waitcnt vmcnt(0)" ::: "memory");
        (void)__hip_atomic_fetch_add(ctr, 1u, __ATOMIC_RELAXED, __HIP_MEMORY_SCOPE_AGENT);
        while (__hip_atomic_load(ctr, __ATOMIC_RELAXED, __HIP_MEMORY_SCOPE_AGENT) < target) __builtin_amdgcn_s_sleep(1);
        __builtin_amdgcn_fence(__ATOMIC_ACQUIRE, "agent");
        asm volatile("s_waitcnt vmcnt(0)" ::: "memory");
    }
    __syncthreads();
}

enum { PH_CONVW, PH_ROWNORM, PH_GEMM1, PH_PREP, PH_RWKV, PH_LRU, PH_ATTNB, PH_ATTND, PH_POST, PH_GEMM2, PH_FINAL };
#ifndef MK_MULTI
#define MK_MULTI 0
#endif
#ifndef PROBE_PREP
#define PROBE_PREP 0
#endif
#ifndef PROBE_MIX
#define PROBE_MIX 0
#endif
#ifndef PROBE_G2
#define PROBE_G2 0
#endif
#if MK_MULTI
template <int PH>
__global__ void __launch_bounds__(256) kph(Params p, int l, int nitems) {
    extern __shared__ __attribute__((aligned(16))) char smem[];
    for (int item = blockIdx.x; item < nitems; item += gridDim.x) {
        if (PH == PH_CONVW) ph_convw(p, item, smem);
        if (PH == PH_ROWNORM) ph_rownorm(p, l, item);
        if (PH == PH_GEMM1) { if (item == (int)blockIdx.x) ph_gemm_all<0>(p, l, blockIdx.x, gridDim.x, smem); }
        if (PH == PH_PREP) ph_prep(p, l, item, smem);
        if (PH == PH_RWKV) ph_rwkv_scan(p, l, item, smem);
        if (PH == PH_LRU) ph_lru_scan(p, l, item);
        if (PH == PH_ATTNB) ph_attn_naive<0>(p, l, item);
        if (PH == PH_ATTND) ph_attn_naive<1>(p, l, item);
        if (PH == PH_POST) { if (item == (int)blockIdx.x) ph_post_all(p, l, blockIdx.x, gridDim.x); }
        if (PH == PH_GEMM2) { if (item == (int)blockIdx.x) ph_gemm_all<1>(p, l, blockIdx.x, gridDim.x, smem); }
        if (PH == PH_FINAL) ph_final(p, item);
    }
}
template <int PH>
static void launch(const Params& p, int l, int nitems, int lds, hipStream_t stream) {
    if (lds > 48 * 1024) (void)hipFuncSetAttribute((const void*)kph<PH>, hipFuncAttributeMaxDynamicSharedMemorySize, lds);
    int grid = nitems < 65536 ? nitems : 65536;
    hipLaunchKernelGGL(kph<PH>, dim3(grid), dim3(256), lds, stream, p, l, nitems);
}
#else
constexpr int MIX_ITEMS = 80 + 2560 + 2560;
__global__ void __launch_bounds__(256, 2) mega(Params p) {
    extern __shared__ __attribute__((aligned(16))) char smem[];
    __shared__ int s_item;
    cg::grid_group grid = cg::this_grid();
    const int G = gridDim.x, bid = blockIdx.x;
    unsigned nbar = 0;
    if (bid == 0 && threadIdx.x < 64) ws_ctr(p)[threadIdx.x] = 0;
    for (int it = bid; it < CW_ITEMS; it += G) ph_convw(p, it, smem);
    grid.sync();
    for (int l = 0; l < NL; ++l) {
        if (l == 0) {
            for (int it = bid; it < NTOK / 4; it += G) ph_rownorm(p, l, it);
            gbar(ws_gbar(p), (nbar += (unsigned)G));
        }
        ph_gemm_all<0>(p, l, bid, G, smem);
        gbar(ws_gbar(p), (nbar += (unsigned)G));
#if PROBE_PREP
        for (int it = bid; it < NTOK / 32; it += G) ph_prep(p, l, it, smem, true);
#endif
        for (int it = bid; it < NTOK / 32; it += G) ph_prep(p, l, it, smem);
        gbar(ws_gbar(p), (nbar += (unsigned)G));
#if PROBE_MIX
        for (int rep = 0; rep < 2; ++rep) {
        const bool dry = rep == 0;
        int* ctrp = &ws_ctr(p)[l + 4 * rep];
#else
        {
        const bool dry = false;
        int* ctrp = &ws_ctr(p)[l];
#endif
        for (int it = bid; it < 240; it += G) ph_rwkv_scan(p, l, it, smem, dry);
        for (;;) {
            __syncthreads();
            if (threadIdx.x == 0) s_item = atomicAdd(ctrp, 1);
            __syncthreads();
            const int it = s_item;
            if (it >= MIX_ITEMS) break;
            if (it < 80) ph_lru_scan(p, l, it, dry);
            else if (it < 2640) ph_attn<0>(p, l, it - 80, smem, dry);
            else ph_attn<1>(p, l, it - 2640, smem, dry);
        }
        }
        gbar(ws_gbar(p), (nbar += (unsigned)G));
        ph_post_all(p, l, bid, G);
        gbar(ws_gbar(p), (nbar += (unsigned)G));
#if PROBE_G2
        ph_gemm_all<1>(p, l, bid, G, smem, true);
#endif
        ph_gemm_all<1>(p, l, bid, G, smem);
        gbar(ws_gbar(p), (nbar += (unsigned)G));
    }
    for (int it = bid; it < NTOK / 4; it += G) ph_final(p, it);
}
#endif

extern "C" void kernel_launch(void* const* d_in, const int* in_sizes, int n_in, void* d_out, int out_size, void* d_ws, size_t ws_size,
                              hipStream_t stream) {
    Params p{};
    const float* const* in = (const float* const*)d_in;
    p.x_prompt = in[0]; p.x_sample = in[1]; p.norm_g = in[2]; p.w_in = in[3]; p.w_out = in[4]; p.rwkv_shift = in[5]; p.rwkv_w0 = in[6];
    p.rwkv_w_up = in[7]; p.rwkv_a0 = in[8]; p.rwkv_a_up = in[9]; p.rwkv_k_k = in[10]; p.rwkv_k_a = in[11]; p.rwkv_r_k = in[12];
    p.rwkv_ln_g = in[13]; p.rwkv_ln_b = in[14]; p.attn_q_norm = in[15]; p.attn_k_norm = in[16]; p.lru_conv_w = in[17]; p.lru_conv_b = in[18];
    p.lru_gate_w = in[19]; p.lru_gate_b = in[20]; p.lru_lambda = in[21]; p.swa_sink = in[22]; p.final_g = in[23];
    p.out = (float*)d_out;
    p.ws = (char*)d_ws;
    if (WS_NEED > ws_size) { fprintf(stderr, "workspace too small: need %zu have %zu\n", (size_t)WS_NEED, ws_size); }

#if MK_MULTI
    launch<PH_CONVW>(p, 0, CW_ITEMS, 64 * 65 * 4, stream);
    for (int l = 0; l < NL; ++l) {
        if (l == 0) launch<PH_ROWNORM>(p, l, NTOK / 4, 0, stream);
        launch<PH_GEMM1>(p, l, (NTOK / GBM) * (DIN / GBN), GEMM_LDS, stream);
        launch<PH_PREP>(p, l, NTOK / 32, PREP_LDS, stream);
        launch<PH_RWKV>(p, l, 240, 4 * 5120, stream);
        launch<PH_LRU>(p, l, 80, 0, stream);
        launch<PH_ATTNB>(p, l, 1280, 0, stream);
        launch<PH_ATTND>(p, l, 1280, 0, stream);
        launch<PH_POST>(p, l, NTOK / 8, 0, stream);
        launch<PH_GEMM2>(p, l, (NTOK / GBM) * (DM / GBN), GEMM_LDS, stream);
    }
    launch<PH_FINAL>(p, 0, NTOK / 4, 0, stream);
#else
    constexpr size_t kDynLds = GEMM_LDS;
    static int grid_blocks = 0;
    if (!grid_blocks) {
        (void)hipFuncSetAttribute((const void*)mega, hipFuncAttributeMaxDynamicSharedMemorySize, (int)kDynLds);
        int dev = 0, cus = 0, per_cu = 0;
        (void)hipGetDevice(&dev);
        (void)hipDeviceGetAttribute(&cus, hipDeviceAttributeMultiprocessorCount, dev);
        (void)hipOccupancyMaxActiveBlocksPerMultiprocessor(&per_cu, mega, 256, kDynLds);
        if (per_cu < 1) per_cu = 1;
        grid_blocks = cus * per_cu;
    }
    (void)hipMemsetAsync((char*)d_ws + WO_GBAR, 0, 256, stream);
    void* args[] = {&p};
    hipError_t e = hipLaunchCooperativeKernel((void*)mega, dim3(grid_blocks), dim3(256), args, kDynLds, stream);
    if (e != hipSuccess) fprintf(stderr, "cooperative launch failed: %s (grid %d)\n", hipGetErrorString(e), grid_blocks);
#endif
}
```

```cpp
#include <hip/hip_runtime.h>
#include <hip/hip_cooperative_groups.h>
#include <cstdio>
#include <cstdint>
namespace cg = cooperative_groups;

#define DEVI __device__ __forceinline__
typedef unsigned short bf16_t;
typedef short bf16x8 __attribute__((ext_vector_type(8)));
typedef float f32x4 __attribute__((ext_vector_type(4)));

constexpr int T_ = 2048, NB_ = 40, NTOK = NB_ * T_, DM = 1024, DIN = 3200, NL = 4;
constexpr int NPROMPT = 32 * T_;
constexpr size_t SA_EL = (size_t)NTOK * 256;
constexpr int OFF_A = 0, OFF_B = 1152, OFF_C = 1920, OFF_D = 2432;

struct Params {
    const float *x_prompt, *x_sample, *norm_g, *w_in, *w_out, *rwkv_shift, *rwkv_w0, *rwkv_w_up, *rwkv_a0, *rwkv_a_up,
        *rwkv_k_k, *rwkv_k_a, *rwkv_r_k, *rwkv_ln_g, *rwkv_ln_b, *attn_q_norm, *attn_k_norm, *lru_conv_w, *lru_conv_b,
        *lru_gate_w, *lru_gate_b, *lru_lambda, *swa_sink, *final_g;
    float* out;
    char* ws;
};
constexpr size_t al256(size_t x) { return (x + 255) & ~(size_t)255; }
constexpr size_t WO_WT_IN = 0;
constexpr size_t WO_WT_OUT = WO_WT_IN + al256((size_t)NL * DIN * DM * 2);
constexpr size_t WO_XB = WO_WT_OUT + al256((size_t)NL * DM * DM * 2);
constexpr size_t WO_Z = WO_XB + al256((size_t)NTOK * DM * 2);
constexpr size_t WO_SR = WO_Z + al256((size_t)NTOK * DIN * 2);
constexpr size_t WO_SK = WO_SR + SA_EL * 2, WO_SV = WO_SK + SA_EL * 2, WO_SKK = WO_SV + SA_EL * 2, WO_SA0 = WO_SKK + SA_EL * 2, WO_SW0 = WO_SA0 + 2 * SA_EL * 2;
constexpr size_t WO_CTR = WO_SW0 + 2 * SA_EL * 2;
constexpr size_t WO_WUP = WO_CTR + 256, WO_AUP = WO_WUP + (size_t)NL * 2 * 256 * 64 * 2, WO_GW = WO_AUP + (size_t)NL * 2 * 256 * 64 * 2, WO_ROPE = WO_GW + (size_t)NL * 16 * 4096 * 2;
constexpr size_t WO_GBAR = WO_ROPE + 2048 * 4;
constexpr size_t WO_PART = WO_GBAR + 256;
constexpr size_t WS_NEED = WO_PART + (size_t)NTOK * 16 * 4;
#define WSF(name, T, off) DEVI T* ws_##name(const Params& p) { return (T*)(p.ws + (off)); }
WSF(wt_in, bf16_t, WO_WT_IN) WSF(wt_out, bf16_t, WO_WT_OUT) WSF(xb, bf16_t, WO_XB) WSF(z, bf16_t, WO_Z) WSF(sR, bf16_t, WO_SR) WSF(sK, bf16_t, WO_SK)
WSF(sV, bf16_t, WO_SV) WSF(sKK, bf16_t, WO_SKK) WSF(sA0, bf16_t, WO_SA0) WSF(sW0, bf16_t, WO_SW0) WSF(la, bf16_t, WO_XB) WSF(h0, bf16_t, WO_XB + 2 * SA_EL * 2)
WSF(ctr, int, WO_CTR) WSF(gbar, unsigned, WO_GBAR) WSF(part, float, WO_PART) WSF(wup_t, bf16_t, WO_WUP) WSF(aup_t, bf16_t, WO_AUP) WSF(gw_t, bf16_t, WO_GW) WSF(rope, float, WO_ROPE)

DEVI float bf2f(bf16_t h) { return __uint_as_float(((unsigned)h) << 16); }
DEVI bf16_t f2bf(float f) { return __builtin_bit_cast(bf16_t, (__bf16)f); }
typedef float f2 __attribute__((ext_vector_type(2)));
typedef __bf16 b2_t __attribute__((ext_vector_type(2)));
DEVI unsigned pk2(float lo, float hi) { f2 v = {lo, hi}; return __builtin_bit_cast(unsigned, __builtin_convertvector(v, b2_t)); }
typedef unsigned u32x4 __attribute__((ext_vector_type(4)));
typedef unsigned u32x2 __attribute__((ext_vector_type(2)));
DEVI float sigm(float x) { return 1.f / (1.f + __expf(-x)); }
DEVI float dpp_f(float v, int) { return v; }
template <int CTRL> DEVI float dppx(float v) { return __builtin_bit_cast(float, __builtin_amdgcn_update_dpp(0, __builtin_bit_cast(int, v), CTRL, 0xf, 0xf, true)); }
DEVI float wave_sum(float v) {
    v += dppx<0xB1>(v);
    v += dppx<0x4E>(v);
    v += dppx<0x141>(v);
    v += dppx<0x140>(v);
    v += __shfl_xor(v, 16); v += __shfl_xor(v, 32);
    return v;
}
DEVI float rdl(float v, int j) { return __builtin_bit_cast(float, __builtin_amdgcn_readlane(__builtin_bit_cast(int, v), j)); }
DEVI const float* xrow(const Params& p, int l, int m) {
    if (l > 0) return p.out + (size_t)m * DM;
    const float* xp = p.x_prompt; const float* xs = p.x_sample;
    const long delta = (xs - xp) - (long)NPROMPT * DM;
    return xp + (size_t)m * DM + (m >= NPROMPT ? delta : (long)0);
}

DEVI int tidx() { int t = threadIdx.x; asm volatile("" : "+v"(t)); return t; }
constexpr int CW_PER_L = 1088, CW_ITEMS = NL * CW_PER_L + 1;
DEVI void ph_convw(const Params& p, int item, char* smem) {
    float* tile = (float*)smem;
    if (item == NL * CW_PER_L) {
        for (int e = tidx(); e < 1024; e += 256) {
            const int pos = e >> 4, i = e & 15;
            const float inv = exp2f(-(float)i * (13.287712379549449f / 16.f));
            const float ang = (float)pos * inv;
            ws_rope(p)[2 * e] = cosf(ang); ws_rope(p)[2 * e + 1] = sinf(ang);
        }
        return;
    }
    const int l = item / CW_PER_L; int r = item % CW_PER_L;
    const float* src; bf16_t* dst; int N, K, k0, n0;
    if (r < 800) { src = p.w_in + (size_t)l * DM * DIN; dst = ws_wt_in(p) + (size_t)l * DIN * DM; N = DIN; K = DM; k0 = (r / 50) * 64; n0 = (r % 50) * 64; }
    else if (r < 1056) { r -= 800; src = p.w_out + (size_t)l * DM * DM; dst = ws_wt_out(p) + (size_t)l * DM * DM; N = DM; K = DM; k0 = (r / 16) * 64; n0 = (r % 16) * 64; }
    else if (r < 1072) { r -= 1056; const int d = (r >> 2) & 1, up = r >> 3; const size_t o = (size_t)(l * 2 + d) * 64 * 256;
        src = (up ? p.rwkv_a_up : p.rwkv_w_up) + o; dst = (up ? ws_aup_t(p) : ws_wup_t(p)) + o; N = 256; K = 64; k0 = 0; n0 = (r & 3) * 64; }
    else { r -= 1072; const size_t o = (size_t)(l * 16 + r) * 4096; src = p.lru_gate_w + o; dst = ws_gw_t(p) + o; N = 64; K = 64; k0 = 0; n0 = 0; }
    int tx = tidx() & 63, ty = tidx() >> 6;
    __syncthreads();
    for (int i = 0; i < 16; ++i) { int k = ty + 4 * i; tile[k * 65 + tx] = src[(size_t)(k0 + k) * N + n0 + tx]; }
    __syncthreads();
    for (int i = 0; i < 16; ++i) { int n = ty + 4 * i; dst[(size_t)(n0 + n) * K + k0 + tx] = f2bf(tile[tx * 65 + n]); }
}

DEVI void ph_rownorm(const Params& p, int l, int item) {
    int w = tidx() >> 6, lane = tidx() & 63;
    int m = item * 4 + w;
    const float* x = xrow(p, l, m);
    const float* g = p.norm_g + l * DM;
    float4 v[4]; float ss = 0.f;
#pragma unroll
    for (int i = 0; i < 4; ++i) { v[i] = *(const float4*)(x + lane * 4 + 256 * i); ss += v[i].x * v[i].x + v[i].y * v[i].y + v[i].z * v[i].z + v[i].w * v[i].w; }
    ss = wave_sum(ss);
    if (lane < 16) ws_part(p)[(size_t)m * 16 + lane] = lane == 0 ? ss : 0.f;
#pragma unroll
    for (int i = 0; i < 4; ++i) {
        float4 gg = *(const float4*)(g + lane * 4 + 256 * i);
        uint2 o; o.x = pk2(v[i].x * gg.x, v[i].y * gg.y); o.y = pk2(v[i].z * gg.z, v[i].w * gg.w);
        *(uint2*)(ws_xb(p) + (size_t)m * DM + lane * 4 + 256 * i) = o;
    }
}

DEVI void ph_final(const Params& p, int item) {
    int w = tidx() >> 6, lane = tidx() & 63;
    int m = item * 4 + w;
    float* x = p.out + (size_t)m * DM;
    float4 v[4]; float ss = 0.f;
#pragma unroll
    for (int i = 0; i < 4; ++i) { v[i] = *(const float4*)(x + lane * 4 + 256 * i); ss += v[i].x * v[i].x + v[i].y * v[i].y + v[i].z * v[i].z + v[i].w * v[i].w; }
    ss = wave_sum(ss);
    float rs = rsqrtf(ss * (1.f / DM) + 1e-6f);
#pragma unroll
    for (int i = 0; i < 4; ++i) {
        float4 gg = *(const float4*)(p.final_g + lane * 4 + 256 * i);
        float4 o; o.x = v[i].x * rs * gg.x; o.y = v[i].y * rs * gg.y; o.z = v[i].z * rs * gg.z; o.w = v[i].w * rs * gg.w;
        *(float4*)(x + lane * 4 + 256 * i) = o;
    }
}

constexpr int GBM = 128, GBN = 128, GBK = 64, GLD = 72;
constexpr int GEMM_LDS = 2 * 2 * 128 * GLD * 2;
template <int EPI>
DEVI void ph_gemm_all(const Params& p, int l, int bid, int G, char* smem, bool dry = false) {
    constexpr int NT = EPI == 0 ? DIN / GBN : DM / GBN;
    constexpr int NTILES = (NTOK / GBM) * NT;
    if (bid >= NTILES) return;
#define G_COORDS(item_, r0_, c0_, pn_) { const int xcd_ = (item_) & 7, jx_ = (item_) >> 3; const int rg_ = jx_ / (8 * NT), wi_ = jx_ % (8 * NT); \
        pn_ = wi_ >> 3; r0_ = (xcd_ * 80 + rg_ * 8 + (wi_ & 7)) * GBM; c0_ = pn_ * GBN; }
    const bf16_t* A = EPI == 0 ? ws_xb(p) : ws_z(p);
    const int lda = EPI == 0 ? DM : DIN;
    const bf16_t* Bt = EPI == 0 ? ws_wt_in(p) + (size_t)l * DIN * DM : ws_wt_out(p) + (size_t)l * DM * DM;
    bf16_t* As = (bf16_t*)smem;
    bf16_t* Bs = As + 2 * 128 * GLD;
    const int tid = tidx(), wid = tid >> 6, lane = tid & 63, wr = wid >> 1, wc = wid & 1, fr = lane & 15, fq = lane >> 4;
    int item = bid, row0, col0, pn, nrow0 = 0, ncol0 = 0, npn = 0;
    G_COORDS(item, row0, col0, pn)
    bool hasn = item + G < NTILES;
    nrow0 = row0; ncol0 = col0; npn = pn;
    if (hasn) G_COORDS(item + G, nrow0, ncol0, npn)
    f32x4 acc[4][4];
#pragma unroll
    for (int m = 0; m < 4; ++m)
#pragma unroll
        for (int n = 0; n < 4; ++n) acc[m][n] = (f32x4){0.f, 0.f, 0.f, 0.f};
    u32x4 ra0[4], rb0[4], ra1[4], rb1[4];
    auto aoff = [&](int kt) __attribute__((always_inline)) -> int {
        if (EPI == 0) return kt * 64;
        const int blk = kt >> 2;
        const int bo = blk == 0 ? OFF_A : blk == 1 ? OFF_B : blk == 2 ? OFF_C : OFF_D;
        return bo + (kt & 3) * 64;
    };
    const int lr = tid >> 3, lch = (tid & 7) * 8;
    const unsigned va0 = (unsigned)(lr * lda + lch) * 2u, vb0 = (unsigned)(lr * DM + lch) * 2u;
    const unsigned vas = (unsigned)(32 * lda) * 2u, vbs = (unsigned)(32 * DM) * 2u;
#define G_LOAD1(ra, rb, i) ra[i] = *(const u32x4*)(ab_ + (va0 + (i) * vas)); rb[i] = *(const u32x4*)(bb_ + (vb0 + (i) * vbs));
#define G_LOAD(ra, rb, r0_, c0_, kt_) { const char* ab_ = (const char*)(A + (size_t)(r0_) * lda + aoff(kt_)); const char* bb_ = (const char*)(Bt + (size_t)(c0_) * DM + (kt_) * 64); \
        G_LOAD1(ra, rb, 0) G_LOAD1(ra, rb, 1) G_LOAD1(ra, rb, 2) G_LOAD1(ra, rb, 3) }
#define S_WRITE1(ra, rb, buf_, i) *(u32x4*)(As + ((buf_) * 128 + lr + 32 * (i)) * GLD + lch) = ra[i]; *(u32x4*)(Bs + ((buf_) * 128 + lr + 32 * (i)) * GLD + lch) = rb[i];
#define S_WRITE(ra, rb, buf_) { S_WRITE1(ra, rb, buf_, 0) S_WRITE1(ra, rb, buf_, 1) S_WRITE1(ra, rb, buf_, 2) S_WRITE1(ra, rb, buf_, 3) }
#define G_COMPUTE_W(buf_, ra, rb, wbuf_, dow_) { \
    bf16x8 af[2][4], bfr[2][4]; \
    _Pragma("unroll") for (int ks = 0; ks < 2; ++ks) { \
        _Pragma("unroll") for (int m = 0; m < 4; ++m) af[ks][m] = *(const bf16x8*)(As + ((buf_) * 128 + wr * 64 + m * 16 + fr) * GLD + ks * 32 + fq * 8); \
        _Pragma("unroll") for (int n = 0; n < 4; ++n) bfr[ks][n] = *(const bf16x8*)(Bs + ((buf_) * 128 + wc * 64 + n * 16 + fr) * GLD + ks * 32 + fq * 8); \
    } \
    if (dow_) S_WRITE(ra, rb, wbuf_) \
    __builtin_amdgcn_s_setprio(1); \
    _Pragma("unroll") for (int ks = 0; ks < 2; ++ks) \
        _Pragma("unroll") for (int m = 0; m < 4; ++m) \
            _Pragma("unroll") for (int n = 0; n < 4; ++n) acc[m][n] = __builtin_amdgcn_mfma_f32_16x16x32_bf16(bfr[ks][n], af[ks][m], acc[m][n], 0, 0, 0); \
    __builtin_amdgcn_s_setprio(0); }
    constexpr int NK = DM / GBK;
    __syncthreads();
    G_LOAD(ra0, rb0, row0, col0, 0) G_LOAD(ra1, rb1, row0, col0, 1)
    S_WRITE(ra0, rb0, 0)
    G_LOAD(ra0, rb0, row0, col0, 2)
    __syncthreads();
#pragma unroll 1
    for (;;) {
#pragma unroll 1
        for (int kt = 0; kt < NK; kt += 2) {
            G_COMPUTE_W(0, ra1, rb1, 1, true)
            __syncthreads();
            { const bool nx = kt + 3 >= NK; const int r_ = nx ? nrow0 : row0, c_ = nx ? ncol0 : col0, k_ = nx ? kt + 3 - NK : kt + 3; G_LOAD(ra1, rb1, r_, c_, k_) }
            G_COMPUTE_W(1, ra0, rb0, 0, true)
            __syncthreads();
            { const bool nx = kt + 4 >= NK; const int r_ = nx ? nrow0 : row0, c_ = nx ? ncol0 : col0, k_ = nx ? kt + 4 - NK : kt + 4; G_LOAD(ra0, rb0, r_, c_, k_) }
        }
#pragma unroll
        for (int mh = 0; mh < 2; ++mh) {
            float rsm[2] = {1.f, 1.f};
            f32x4 xres[2][4], ggn[4];
            if (EPI == 1 && !dry && l + 1 < NL) {
#pragma unroll
                for (int n = 0; n < 4; ++n) ggn[n] = *(const f32x4*)(p.norm_g + (l + 1) * DM + col0 + wc * 64 + n * 16 + fq * 4);
            }
            if (EPI == 0) {
                f32x4 q[2][4];
#pragma unroll
                for (int mm = 0; mm < 2; ++mm) {
                    const f32x4* pp = (const f32x4*)(ws_part(p) + (size_t)(row0 + wr * 64 + (2 * mh + mm) * 16 + fr) * 16);
#pragma unroll
                    for (int k = 0; k < 4; ++k) q[mm][k] = pp[k];
                }
#pragma unroll
                for (int mm = 0; mm < 2; ++mm) {
                    const f32x4 t = (q[mm][0] + q[mm][1]) + (q[mm][2] + q[mm][3]);
                    rsm[mm] = rsqrtf(((t[0] + t[1]) + (t[2] + t[3])) * (1.f / DM) + 1e-6f);
                }
            } else if (!dry) {
#pragma unroll
                for (int mm = 0; mm < 2; ++mm)
#pragma unroll
                    for (int n = 0; n < 4; ++n) xres[mm][n] = *(const f32x4*)(xrow(p, l, row0 + wr * 64 + (2 * mh + mm) * 16 + fr) + col0 + wc * 64 + n * 16 + fq * 4);
            }
#pragma unroll
            for (int mm = 0; mm < 2; ++mm) {
                const int m = 2 * mh + mm;
                const int row = row0 + wr * 64 + m * 16 + fr;
                const float rs = rsm[mm];
                float ssq = 0.f;
#pragma unroll
                for (int n = 0; n < 4; ++n) {
                    const int col = col0 + wc * 64 + n * 16 + fq * 4;
                    if (dry) { if (acc[m][n][0] == 1.2345e30f) ws_ctr(p)[63] = 1; }
                    else if (EPI == 0) {
                        if (pn == 12 || pn == 22) {
                            const unsigned tb = (unsigned)((row0 + wr * 64 + fq * 4) * DIN + col0 + wc * 64 + fr) * 2u;
#pragma unroll
                            for (int jj = 0; jj < 4; ++jj)
                                *(bf16_t*)((char*)ws_z(p) + (tb + (unsigned)((n * 16 + jj) * DIN + m * 16) * 2u)) = f2bf(acc[m][n][jj] * rs);
                        } else {
                            uint2 o; o.x = pk2(acc[m][n][0] * rs, acc[m][n][1] * rs); o.y = pk2(acc[m][n][2] * rs, acc[m][n][3] * rs);
                            *(uint2*)(ws_z(p) + (size_t)row * DIN + col) = o;
                        }
                    } else {
                        const f32x4 o = xres[mm][n] + acc[m][n];
                        *(f32x4*)(p.out + (size_t)row * DM + col) = o;
                        ssq += (o[0] * o[0] + o[1] * o[1]) + (o[2] * o[2] + o[3] * o[3]);
                        if (l + 1 < NL) {
                            const f32x4 og = o * ggn[n];
                            uint2 ob; ob.x = pk2(og[0], og[1]); ob.y = pk2(og[2], og[3]);
                            *(uint2*)(ws_xb(p) + (size_t)row * DM + col) = ob;
                        }
                    }
                }
                if (EPI == 1 && !dry) {
                    ssq += __shfl_xor(ssq, 16); ssq += __shfl_xor(ssq, 32);
                    if (fq == 0) ws_part(p)[(size_t)row * 16 + pn * 2 + wc] = ssq;
                }
            }
        }
        if (!hasn) break;
#pragma unroll
        for (int m = 0; m < 4; ++m)
#pragma unroll
            for (int n = 0; n < 4; ++n) acc[m][n] = (f32x4){0.f, 0.f, 0.f, 0.f};
        item += G; row0 = nrow0; col0 = ncol0; pn = npn;
        hasn = item + G < NTILES;
        if (hasn) G_COORDS(item + G, nrow0, ncol0, npn)
    }
#undef G_LOAD
#undef S_WRITE
#undef G_LOAD1
#undef S_WRITE1
#undef G_COMPUTE_W
#undef G_COORDS
}

constexpr int XLD = 264, LLD = 72;
constexpr int PREP_LDS = 64 * XLD * 2 + 2 * 64 * LLD * 2;
DEVI float ropeT(f2 cs, float x, int d) {
    const int e = d & 31;
    const float pr = __shfl_xor(x, 16);
    return (e < 16) ? x * cs.x - pr * cs.y : pr * cs.y + x * cs.x;
}
DEVI void ph_prep(const Params& p, int l, int item, char* smem, bool dry = false) {
    bf16_t* xc_s = (bf16_t*)smem;
    bf16_t* wl_s = xc_s + 64 * XLD;
    bf16_t* al_s = wl_s + 64 * LLD;
    const int tid = tidx(), w = tid >> 6, lane = tid & 63, fr = lane & 15, fq = lane >> 4;
    const int b = item >> 6, t0 = (item & 63) * 32;
    const size_t mbase = (size_t)b * T_ + t0;
    bf16_t* zt = ws_z(p) + mbase * DIN;
    __syncthreads();
    {
        const float* sh = p.rwkv_shift + l * 2 * 896;
        float s0[4], s1[4], pv[4], cu[4];
#pragma unroll
        for (int s_ = 0; s_ < 4; ++s_) {
            const int c = tid + 256 * s_;
            const bool ok = c < 896;
            s0[s_] = ok ? sh[c] : 0.f; s1[s_] = ok ? sh[896 + c] : 0.f;
            pv[s_] = (ok && t0 > 0) ? bf2f(zt[c - DIN]) : 0.f;
            cu[s_] = ok ? bf2f(zt[c]) : 0.f;
        }
        const float kkw = p.rwkv_k_k[l * 256 + tid];
        float cw[4];
#pragma unroll
        for (int jj = 0; jj < 4; ++jj) cw[jj] = p.lru_conv_w[(l * 4 + jj) * 256 + tid];
        const float cb = p.lru_conv_b[l * 256 + tid];
        float xm2 = t0 >= 2 ? bf2f(zt[OFF_C + tid - 2 * DIN]) : 0.f, xm1 = t0 >= 1 ? bf2f(zt[OFF_C + tid - DIN]) : 0.f, x0 = bf2f(zt[OFF_C + tid]);
        const float qnw = p.attn_q_norm[l * 64 + lane], knw = p.attn_k_norm[l * 64 + lane];
        const bool c3 = tid < 128;
        bf16_t nA[2][4][4], nC[2][4], qB[2][4], kB[2][4];
        f2 cs8[2][4];
#define PREP_LOADG(B_, G_) { \
            _Pragma("unroll") for (int i8 = 0; i8 < 4; ++i8) { \
                const int tt = (G_) * 4 + i8; \
                const bf16_t* zr = zt + (size_t)tt * DIN; \
                const bool hasn = t0 + tt + 1 < T_; \
                _Pragma("unroll") for (int s_ = 0; s_ < 4; ++s_) nA[B_][i8][s_] = (hasn && (s_ < 3 || c3)) ? zr[tid + 256 * s_ + DIN] : (bf16_t)0; \
                nC[B_][i8] = hasn ? zr[OFF_C + tid + DIN] : (bf16_t)0; \
                qB[B_][i8] = zr[OFF_B + tid]; \
                kB[B_][i8] = c3 ? zr[OFF_B + 256 + tid] : (bf16_t)0; \
                cs8[B_][i8] = *(const f2*)(ws_rope(p) + 2 * (((lane >> 5) ? (t0 & 63) + tt : (t0 >> 6)) * 16 + (lane & 15))); \
            } }
#define PREP_COMPG(B_, G_) { \
            _Pragma("unroll") for (int i8 = 0; i8 < 4; ++i8) { \
                const int tt = (G_) * 4 + i8; \
                bf16_t* zr = zt + (size_t)tt * DIN; \
                float xs[4]; \
                _Pragma("unroll") for (int s_ = 0; s_ < 4; ++s_) { \
                    const float nx = bf2f(nA[B_][i8][s_]); \
                    xs[s_] = cu[s_] + s0[s_] * (pv[s_] - cu[s_]) + s1[s_] * (nx - cu[s_]); \
                    pv[s_] = cu[s_]; cu[s_] = nx; \
                } \
                const size_t o = (mbase + tt) * 256 + tid; \
                const float kkv = xs[1] * kkw; \
                const float ss = wave_sum(kkv * kkv); \
                ws_sR(p)[o] = f2bf(xs[0]); ws_sK(p)[o] = f2bf(xs[1]); ws_sV(p)[o] = f2bf(xs[2]); ws_sKK(p)[o] = f2bf(kkv * rsqrtf(fmaxf(ss, 1e-24f))); \
                if (tid < 64) wl_s[tt * LLD + tid] = f2bf(1.f - 2.f / (1.f + __expf(2.f * xs[3]))); \
                else if (tid < 128) al_s[tt * LLD + tid - 64] = f2bf(xs[3]); \
                const float xp1 = bf2f(nC[B_][i8]); \
                xc_s[tt * XLD + tid] = f2bf(cb + cw[0] * xm2 + cw[1] * xm1 + cw[2] * x0 + cw[3] * xp1); \
                xm2 = xm1; xm1 = x0; x0 = xp1; \
                const float q = bf2f(qB[B_][i8]); \
                const float s2 = wave_sum(q * q); \
                const float qn = ropeT(cs8[B_][i8], q * rsqrtf(s2 * (1.f / 64.f) + 1e-6f) * qnw, lane) * (0.125f * 1.4426950408889634f); \
                if (!dry) zr[OFF_B + tid] = f2bf(qn); \
                if (c3) { \
                    const float kx = bf2f(kB[B_][i8]); \
                    const float s3 = wave_sum(kx * kx); \
                    const float kro = ropeT(cs8[B_][i8], kx * rsqrtf(s3 * (1.f / 64.f) + 1e-6f) * knw, lane); \
                    if (!dry) zr[OFF_B + 256 + tid] = f2bf(kro); \
                } \
            } }
        PREP_LOADG(0, 0)
#pragma unroll 1
        for (int g = 0; g < 8; g += 2) {
            PREP_LOADG(1, g + 1)
            PREP_COMPG(0, g)
            if (g + 2 < 8) PREP_LOADG(0, g + 2)
            PREP_COMPG(1, g + 1)
        }
#undef PREP_LOADG
#undef PREP_COMPG
    }
    __syncthreads();
#pragma unroll 1
    for (int dm = 0; dm < 4; ++dm) {
        const int d = dm >> 1, mat = dm & 1;
        const bf16_t* Bt = (mat ? ws_aup_t(p) : ws_wup_t(p)) + ((size_t)(l * 2 + d) * 256 + 64 * w) * 64;
        bf16x8 bfr[4][2];
#pragma unroll
        for (int nt = 0; nt < 4; ++nt)
#pragma unroll
            for (int ks = 0; ks < 2; ++ks) bfr[nt][ks] = *(const bf16x8*)(Bt + (16 * nt + fr) * 64 + 32 * ks + 8 * fq);
        const bf16_t* As = mat ? al_s : wl_s;
        const float* bias = (mat ? p.rwkv_a0 : p.rwkv_w0) + (l * 2 + d) * 256 + 64 * w + 4 * fq;
        bf16_t* dst = (mat ? ws_sA0(p) : ws_sW0(p)) + d * SA_EL + mbase * 256 + 64 * w + 4 * fq;
        f32x4 bvh[4];
#pragma unroll
        for (int nt = 0; nt < 4; ++nt) bvh[nt] = *(const f32x4*)(bias + 16 * nt);
#pragma unroll 1
        for (int m = 0; m < 2; ++m) {
            bf16x8 af[2];
#pragma unroll
            for (int ks = 0; ks < 2; ++ks) af[ks] = *(const bf16x8*)(As + (16 * m + fr) * LLD + 32 * ks + 8 * fq);
#pragma unroll
            for (int nt = 0; nt < 4; ++nt) {
                f32x4 acc = (f32x4){0.f, 0.f, 0.f, 0.f};
#pragma unroll
                for (int ks = 0; ks < 2; ++ks) acc = __builtin_amdgcn_mfma_f32_16x16x32_bf16(bfr[nt][ks], af[ks], acc, 0, 0, 0);
                const f32x4 bv = bvh[nt];
                float ov[4];
#pragma unroll
                for (int jj = 0; jj < 4; ++jj) {
                    const float sg = sigm(acc[jj] + bv[jj]);
                    ov[jj] = mat ? sg : 1.f - __expf(-0.6065306597126334f * sg);
                }
                u32x2 o2; o2[0] = pk2(ov[0], ov[1]); o2[1] = pk2(ov[2], ov[3]);
                *(u32x2*)(dst + (size_t)(16 * m + fr) * 256 + 16 * nt) = o2;
            }
        }
    }
#pragma unroll 1
    for (int d = 0; d < 2; ++d) {
        bf16x8 bfr[2][4][2];
#pragma unroll
        for (int k = 0; k < 2; ++k)
#pragma unroll
            for (int nt = 0; nt < 4; ++nt)
#pragma unroll
                for (int ks = 0; ks < 2; ++ks)
                    bfr[k][nt][ks] = *(const bf16x8*)(ws_gw_t(p) + ((size_t)(((l * 2 + d) * 2 + k) * 4 + w) * 64 + 16 * nt + fr) * 64 + 32 * ks + 8 * fq);
        const int e00 = 64 * w + 4 * fq;
        f32x4 gb0h[4], gb1h[4], sph[4];
#pragma unroll
        for (int nt = 0; nt < 4; ++nt) {
            const int e0 = e00 + 16 * nt;
            gb0h[nt] = *(const f32x4*)(p.lru_gate_b + ((l * 2 + d) * 2 + 0) * 256 + e0); gb1h[nt] = *(const f32x4*)(p.lru_gate_b + ((l * 2 + d) * 2 + 1) * 256 + e0);
            const f32x4 lam = *(const f32x4*)(p.lru_lambda + (l * 2 + d) * 256 + e0);
#pragma unroll
            for (int jj = 0; jj < 4; ++jj) sph[nt][jj] = __logf(1.f + __expf(-lam[jj]));
        }
#pragma unroll 1
        for (int m = 0; m < 2; ++m) {
            bf16x8 af[2];
#pragma unroll
            for (int ks = 0; ks < 2; ++ks) af[ks] = *(const bf16x8*)(xc_s + (16 * m + fr) * XLD + 64 * w + 32 * ks + 8 * fq);
#pragma unroll
            for (int nt = 0; nt < 4; ++nt) {
                f32x4 g0 = (f32x4){0.f, 0.f, 0.f, 0.f}, g1 = g0;
#pragma unroll
                for (int ks = 0; ks < 2; ++ks) {
                    g0 = __builtin_amdgcn_mfma_f32_16x16x32_bf16(bfr[0][nt][ks], af[ks], g0, 0, 0, 0);
                    g1 = __builtin_amdgcn_mfma_f32_16x16x32_bf16(bfr[1][nt][ks], af[ks], g1, 0, 0, 0);
                }
                const int e0 = e00 + 16 * nt;
                const f32x4 gb0 = gb0h[nt], gb1 = gb1h[nt];
                const u32x2 xu = *(const u32x2*)(xc_s + (16 * m + fr) * XLD + e0);
                const float xv[4] = {__uint_as_float(xu[0] << 16), __uint_as_float(xu[0] & 0xffff0000u), __uint_as_float(xu[1] << 16), __uint_as_float(xu[1] & 0xffff0000u)};
                float a1[4], bt[4];
#pragma unroll
                for (int jj = 0; jj < 4; ++jj) {
                    const float r = sigm(g0[jj] + gb0[jj]), ig = sigm(g1[jj] + gb1[jj]);
                    const float sp = sph[nt][jj];
                    const float a = __expf(-8.f * r * sp);
                    a1[jj] = 1.f - a;
                    bt[jj] = sqrtf(a1[jj] * (1.f + a)) * ig * xv[jj];
                }
                const size_t o = d * SA_EL + (mbase + 16 * m + fr) * 256 + e0;
                u32x2 oa; oa[0] = pk2(a1[0], a1[1]); oa[1] = pk2(a1[2], a1[3]);
                u32x2 ob; ob[0] = pk2(bt[0], bt[1]); ob[1] = pk2(bt[2], bt[3]);
                *(u32x2*)(ws_la(p) + o) = oa; *(u32x2*)(ws_h0(p) + o) = ob;
            }
        }
    }
}

DEVI f2 fma2(f2 a, f2 b, f2 c) { return __builtin_elementwise_fma(a, b, c); }
DEVI void ph_rwkv_scan(const Params& p, int l, int item, char* smem, bool dry = false) {
    const int wv = __builtin_amdgcn_readfirstlane(tidx() >> 6), lane = tidx() & 63;
    const int wi = item * 4 + wv;
    const int scan = wi / 3, part = wi - scan * 3;
    const int b = scan >> 3, h = (scan >> 1) & 3, d = scan & 1;
    const int c8 = lane & 7, r8 = lane >> 3;
    float* ring = (float*)smem + wv * 1280;
    const char* A = (const char*)(ws_sA0(p) + d * SA_EL);
    const char* Wm = (const char*)(ws_sW0(p) + d * SA_EL);
    const char *R = (const char*)ws_sR(p), *K = (const char*)ws_sK(p), *V = (const char*)ws_sV(p), *KK = (const char*)ws_sKK(p);
    char* Y = (char*)(ws_z(p) + 256 + 256 * d + h * 64);
#define LDB(base, bo) (*(const bf16_t*)((base) + (bo)))
    const float ka = p.rwkv_k_a[l * 256 + h * 64 + lane];
    f2 S[3][4];
#pragma unroll
    for (int pp = 0; pp < 3; ++pp)
#pragma unroll
        for (int k = 0; k < 4; ++k) S[pp][k] = (f2){0.f, 0.f};
    const unsigned t00 = (unsigned)(b * T_ + (d ? T_ - 1 : 0)) * 256u + h * 64;
    const unsigned o0 = (t00 + lane) * 2u;
    int rowp[3]; unsigned ov[3];
#pragma unroll
    for (int pp = 0; pp < 3; ++pp) { rowp[pp] = 24 * part + 8 * pp + r8; ov[pp] = (t00 + (rowp[pp] < 64 ? rowp[pp] : 63)) * 2u; }
    const int stp = d ? -512 : 512;
    const int myp = c8 < 3 ? c8 : 0;
    const int myrow = 24 * part + 8 * myp + r8;
    const bool ystore = c8 < 3 && myrow < 64 && !dry;
    const unsigned yrow_b = (unsigned)myrow * 2u;
    float vcur[3], vnx[3];
#pragma unroll
    for (int s_ = 0; s_ < 2; ++s_) {
        const unsigned o = o0 + s_ * stp;
        const float r = bf2f(LDB(R, o)), k = bf2f(LDB(K, o)), kk = bf2f(LDB(KK, o)), a = bf2f(LDB(A, o)), w = 1.f - bf2f(LDB(Wm, o));
#pragma unroll
        for (int pp = 0; pp < 3; ++pp) { const float vv = bf2f(LDB(V, ov[pp] + s_ * stp)); if (s_ == 0) vcur[pp] = vv; else vnx[pp] = vv; }
        float* sl = ring + s_ * 320;
        sl[0 * 64 + lane] = w; sl[1 * 64 + lane] = kk * a; sl[2 * 64 + lane] = k * (1.f + (a - 1.f) * ka); sl[3 * 64 + lane] = r; sl[4 * 64 + lane] = kk;
    }
    bf16_t rr[8], rk[8], rkk[8], ra[8], rw[8], rv[8][3];
#pragma unroll
    for (int i = 0; i < 8; ++i) {
        const int st = (i < 2 ? 8 + i : i) * stp;
        rr[i] = LDB(R, o0 + st); rk[i] = LDB(K, o0 + st); rkk[i] = LDB(KK, o0 + st); ra[i] = LDB(A, o0 + st); rw[i] = LDB(Wm, o0 + st);
#pragma unroll
        for (int pp = 0; pp < 3; ++pp) rv[i][pp] = LDB(V, ov[pp] + st);
    }
    __builtin_amdgcn_wave_barrier();
    f32x4 OB[2][5][2];
#define RW_LDO(set, slw, slk) { _Pragma("unroll") for (int g = 0; g < 2; ++g) { \
        OB[set][0][g] = *(const f32x4*)((slw) + 0 * 64 + 8 * c8 + 4 * g); OB[set][1][g] = *(const f32x4*)((slw) + 1 * 64 + 8 * c8 + 4 * g); \
        OB[set][2][g] = *(const f32x4*)((slw) + 2 * 64 + 8 * c8 + 4 * g); OB[set][3][g] = *(const f32x4*)((slw) + 3 * 64 + 8 * c8 + 4 * g); \
        OB[set][4][g] = *(const f32x4*)((slk) + 4 * 64 + 8 * c8 + 4 * g); } }
    RW_LDO(0, ring, ring + 320)
    float sktot[3] = {0.f, 0.f, 0.f};
    __builtin_amdgcn_s_setprio(3);
    for (int sb = 0; sb < T_; sb += 8) {
#pragma unroll
        for (int i = 0; i < 8; ++i) {
            const int step = sb + i;
            const int slot = (i + 2) & 7;
            float v2n[3];
            {
                float* sn = ring + ((i + 2) & 3) * 320;
                const float r1 = bf2f(rr[slot]), k1 = bf2f(rk[slot]), kk1 = bf2f(rkk[slot]), a1 = bf2f(ra[slot]), w1 = 1.f - bf2f(rw[slot]);
                sn[0 * 64 + lane] = w1; sn[1 * 64 + lane] = kk1 * a1; sn[2 * 64 + lane] = k1 * (1.f + (a1 - 1.f) * ka); sn[3 * 64 + lane] = r1; sn[4 * 64 + lane] = kk1;
#pragma unroll
                for (int pp = 0; pp < 3; ++pp) v2n[pp] = bf2f(rv[slot][pp]);
            }
            {
                const int s10 = (step + 10 < T_ ? step + 10 : T_ - 1) * stp;
                const unsigned oc = o0 + s10;
                rr[slot] = LDB(R, oc); rk[slot] = LDB(K, oc); rkk[slot] = LDB(KK, oc); ra[slot] = LDB(A, oc); rw[slot] = LDB(Wm, oc);
#pragma unroll
                for (int pp = 0; pp < 3; ++pp) rv[slot][pp] = LDB(V, ov[pp] + s10);
            }
            __builtin_amdgcn_wave_barrier();
            RW_LDO((i + 1) & 1, ring + ((i + 1) & 3) * 320, ring + ((i + 2) & 3) * 320)
            const unsigned tok_b = (unsigned)(b * T_ + (d ? T_ - 1 - step : step)) * (unsigned)(DIN * 2);
            float pyv[3];
#pragma unroll
            for (int pp = 0; pp < 3; ++pp) {
                const f2 nsk2 = (f2){-sktot[pp], -sktot[pp]}, v2 = (f2){vcur[pp], vcur[pp]};
                f2 y2 = (f2){0.f, 0.f}, sk2 = (f2){0.f, 0.f};
#pragma unroll
                for (int g = 0; g < 2; ++g) {
                    const f32x4 w4 = OB[i & 1][0][g], b4 = OB[i & 1][1][g], kd4 = OB[i & 1][2][g], r4 = OB[i & 1][3][g], kn4 = OB[i & 1][4][g];
                    f2 t0 = v2 * kd4.xy; t0 = fma2(nsk2, b4.xy, t0);
                    S[pp][2 * g] = fma2(S[pp][2 * g], w4.xy, t0);
                    y2 = fma2(S[pp][2 * g], r4.xy, y2); sk2 = fma2(S[pp][2 * g], kn4.xy, sk2);
                    f2 t1 = v2 * kd4.zw; t1 = fma2(nsk2, b4.zw, t1);
                    S[pp][2 * g + 1] = fma2(S[pp][2 * g + 1], w4.zw, t1);
                    y2 = fma2(S[pp][2 * g + 1], r4.zw, y2); sk2 = fma2(S[pp][2 * g + 1], kn4.zw, sk2);
                }
                float ps = sk2.x + sk2.y, py = y2.x + y2.y;
                ps += dppx<0xB1>(ps); py += dppx<0xB1>(py);
                ps += dppx<0x4E>(ps); py += dppx<0x4E>(py);
                ps += dppx<0x141>(ps); py += dppx<0x141>(py);
                sktot[pp] = ps; pyv[pp] = py;
                vcur[pp] = vnx[pp]; vnx[pp] = v2n[pp];
            }
            {
                const float ysel = c8 == 0 ? pyv[0] : c8 == 1 ? pyv[1] : pyv[2];
                if (ystore) *(bf16_t*)(Y + (tok_b + yrow_b)) = f2bf(ysel);
            }
        }
    }
    __builtin_amdgcn_s_setprio(0);
#undef RW_LDO
#undef LDB
}

DEVI void ph_lru_scan(const Params& p, int l, int item, bool dry = false) {
    const int lane = tidx() & 63, idx = item * 4 + (tidx() >> 6);
    const int b = idx >> 3, n = (idx >> 1) & 3, d = idx & 1;
    const bf16_t* A = ws_la(p) + d * SA_EL + (size_t)b * T_ * 256 + n * 64 + lane;
    bf16_t* H = ws_h0(p) + d * SA_EL + (size_t)b * T_ * 256 + n * 64 + lane;
    float h = 0.f;
    for (int s0 = 0; s0 < T_; s0 += 32) {
        bf16_t av[32], bv[32];
#pragma unroll
        for (int i = 0; i < 32; ++i) { const int t = d ? T_ - 1 - (s0 + i) : s0 + i; av[i] = A[(size_t)t * 256]; bv[i] = H[(size_t)t * 256]; }
#pragma unroll
        for (int i = 0; i < 32; ++i) {
            const int t = d ? T_ - 1 - (s0 + i) : s0 + i;
            h = (1.f - bf2f(av[i])) * h + bf2f(bv[i]);
            if (!dry) H[(size_t)t * 256] = f2bf(h);
        }
    }
}

DEVI void ph_post_all(const Params& p, int l, int bid, int G) {
    const int j = tidx();
    const float lg = p.rwkv_ln_g[l * 256 + j], lb = p.rwkv_ln_b[l * 256 + j], ka = p.rwkv_k_a[l * 256 + j], rk_ = p.rwkv_r_k[l * 256 + j];
    constexpr int NIT = NTOK / 8;
    if (bid >= NIT) return;
    const int ng = (NIT - bid + G - 1) / G;
    bf16_t yf[2][8], yr[2][8], r_[2][8], k_[2][8], v_[2][8], af[2][8], ar[2][8], ga[2][8], hf[2][8], hr[2][8], gc[2][8];
#define POST_LOAD(B_, GI_) { \
        _Pragma("unroll") for (int i = 0; i < 8; ++i) { \
            const int m = (bid + (GI_) * G) * 8 + i; \
            const size_t o = (size_t)m * 256 + j; \
            const bf16_t* zr = ws_z(p) + (size_t)m * DIN; \
            yf[B_][i] = zr[256 + j]; yr[B_][i] = zr[512 + j]; r_[B_][i] = ws_sR(p)[o]; k_[B_][i] = ws_sK(p)[o]; v_[B_][i] = ws_sV(p)[o]; \
            af[B_][i] = ws_sA0(p)[o]; ar[B_][i] = ws_sA0(p)[o + SA_EL]; ga[B_][i] = zr[OFF_A + 896 + j]; \
            hf[B_][i] = ws_h0(p)[o]; hr[B_][i] = ws_h0(p)[o + SA_EL]; gc[B_][i] = zr[OFF_C + 256 + j]; \
        } }
#define POST_COMP(B_, GI_) { \
        _Pragma("unroll") for (int i = 0; i < 8; ++i) { \
            const int m = (bid + (GI_) * G) * 8 + i; \
            bf16_t* zr = ws_z(p) + (size_t)m * DIN; \
            const float y = bf2f(yf[B_][i]) + bf2f(yr[B_][i]); \
            const float mu = wave_sum(y) * (1.f / 64.f); \
            const float dv = y - mu; \
            const float var = wave_sum(dv * dv) * (1.f / 64.f); \
            const float yn = dv * rsqrtf(var + 64e-5f) * lg + lb; \
            const float r = bf2f(r_[B_][i]), k = bf2f(k_[B_][i]), v = bf2f(v_[B_][i]), a_f = bf2f(af[B_][i]), a_r = bf2f(ar[B_][i]); \
            const float ksum = k * (1.f + (a_f - 1.f) * ka) + k * (1.f + (a_r - 1.f) * ka); \
            const float bon = wave_sum(r * ksum * rk_) * v; \
            const float g = bf2f(ga[B_][i]); \
            zr[OFF_A + j] = f2bf((yn + bon) * g * sigm(g)); \
            const float h = bf2f(hf[B_][i]) + bf2f(hr[B_][i]); \
            const float g2 = bf2f(gc[B_][i]); \
            zr[OFF_C + j] = f2bf(h * g2 * sigm(g2)); \
        } }
    POST_LOAD(0, 0)
#pragma unroll 1
    for (int gi = 0; gi < ng; gi += 2) {
        if (gi + 1 < ng) POST_LOAD(1, gi + 1)
        POST_COMP(0, gi)
        if (gi + 2 < ng) POST_LOAD(0, gi + 2)
        if (gi + 1 < ng) POST_COMP(1, gi + 1)
    }
#undef POST_LOAD
#undef POST_COMP
}

template <int WIN>
DEVI void ph_attn_naive(const Params& p, int l, int item) {
    const int lane = tidx() & 63, idx = item * 4 + (tidx() >> 6);
    const int qb = idx & 31, hq = (idx >> 5) & 3, b = idx >> 7;
    const int g = hq >> 1;
    constexpr int OFF = WIN ? OFF_D : OFF_B;
    const int t0 = qb * 64, t = t0 + lane;
    bf16_t* zq = ws_z(p) + ((size_t)b * T_ + t) * DIN + OFF + hq * 64;
    float q[64], o[64];
#pragma unroll
    for (int c = 0; c < 8; ++c) {
        const uint4 u = *(const uint4*)(zq + c * 8);
        const unsigned uu[4] = {u.x, u.y, u.z, u.w};
#pragma unroll
        for (int e = 0; e < 4; ++e) { q[c * 8 + 2 * e] = __uint_as_float(uu[e] << 16); q[c * 8 + 2 * e + 1] = __uint_as_float(uu[e] & 0xffff0000u); }
    }
#pragma unroll
    for (int dd = 0; dd < 64; ++dd) o[dd] = 0.f;
    float mx, ls;
    float slope = 0.f;
    if (WIN) { mx = p.swa_sink[l * 4 + hq]; ls = 1.f; slope = exp2f(-8.f * (float)(hq + 1) / 4.f); }
    else { mx = -1e30f; ls = 0.f; }
    const int s0 = WIN ? max(0, t0 - 128) : 0, s1 = WIN ? min(T_ - 1, t0 + 63 + 128) : T_ - 1;
    const bf16_t* kb = ws_z(p) + (size_t)b * T_ * DIN + OFF + 256 + g * 64;
    for (int s = s0; s <= s1; ++s) {
        const bf16_t* kr = kb + (size_t)s * DIN;
        float sc = 0.f;
#pragma unroll
        for (int c = 0; c < 8; ++c) {
            const uint4 u = *(const uint4*)(kr + c * 8);
            const unsigned uu[4] = {u.x, u.y, u.z, u.w};
#pragma unroll
            for (int e = 0; e < 4; ++e) { sc += q[c * 8 + 2 * e] * __uint_as_float(uu[e] << 16); sc += q[c * 8 + 2 * e + 1] * __uint_as_float(uu[e] & 0xffff0000u); }
        }
        bool valid = true;
        if (WIN) { const int dist = abs(t - s); valid = dist <= 128; sc = sc * 0.125f - slope * (float)dist; }
        const float mn = valid ? fmaxf(mx, sc) : mx;
        const float al = __expf(mx - mn);
        const float pp = valid ? __expf(sc - mn) : 0.f;
        mx = mn; ls = ls * al + pp;
#pragma unroll
        for (int c = 0; c < 8; ++c) {
            const uint4 u = *(const uint4*)(kr + 128 + c * 8);
            const unsigned uu[4] = {u.x, u.y, u.z, u.w};
#pragma unroll
            for (int e = 0; e < 4; ++e) {
                o[c * 8 + 2 * e] = o[c * 8 + 2 * e] * al + pp * __uint_as_float(uu[e] << 16);
                o[c * 8 + 2 * e + 1] = o[c * 8 + 2 * e + 1] * al + pp * __uint_as_float(uu[e] & 0xffff0000u);
            }
        }
    }
    const float il = 1.f / ls;
    const bf16_t* zg = zq - hq * 64 + 512 + hq * 64;
#pragma unroll
    for (int c = 0; c < 8; ++c) {
        const uint4 u = *(const uint4*)(zg + c * 8);
        const unsigned uu[4] = {u.x, u.y, u.z, u.w};
        unsigned ov[4];
#pragma unroll
        for (int e = 0; e < 4; ++e) {
            const float g0 = __uint_as_float(uu[e] << 16), g1 = __uint_as_float(uu[e] & 0xffff0000u);
            ov[e] = pk2(o[c * 8 + 2 * e] * il * g0 * sigm(g0), o[c * 8 + 2 * e + 1] * il * g1 * sigm(g1));
        }
        *(uint4*)(zq + c * 8) = make_uint4(ov[0], ov[1], ov[2], ov[3]);
    }
}

constexpr int ALD = 72;
template <int WIN>
DEVI void ph_attn(const Params& p, int l, int item, char* smem, bool dry = false) {
    constexpr int OFF = WIN ? OFF_D : OFF_B;
    const int qb = item & 15, hq = (item >> 4) & 3, b = item >> 6, g = hq >> 1;
    const int tid = tidx(), w = tid >> 6, lane = tid & 63, fr = lane & 15, fq = lane >> 4;
    const int t0 = qb * 128, tw = t0 + 32 * w;
    bf16_t* Ks = (bf16_t*)smem;
    bf16_t* Vt = Ks + 2 * 64 * ALD;
    bf16_t* zb = ws_z(p) + (size_t)b * T_ * DIN;
    bf16x8 qf[2][2];
#pragma unroll
    for (int n = 0; n < 2; ++n)
#pragma unroll
        for (int ks = 0; ks < 2; ++ks) {
            u32x4 u = *(const u32x4*)(zb + (size_t)(tw + 16 * n + fr) * DIN + OFF + hq * 64 + 32 * ks + 8 * fq);
            if (WIN) {
                constexpr float sc = 0.125f * 1.4426950408889634f;
#pragma unroll
                for (int e = 0; e < 4; ++e) u[e] = pk2(__uint_as_float(u[e] << 16) * sc, __uint_as_float(u[e] & 0xffff0000u) * sc);
            }
            qf[n][ks] = __builtin_bit_cast(bf16x8, u);
        }
    const int kt0 = WIN ? max(0, t0 - 128) / 64 : 0, kt1 = WIN ? min(T_, t0 + 256) / 64 : T_ / 64;
    f32x4 ot[4][2];
#pragma unroll
    for (int dm = 0; dm < 4; ++dm)
#pragma unroll
        for (int n = 0; n < 2; ++n) ot[dm][n] = (f32x4){0.f, 0.f, 0.f, 0.f};
    float mrun[2];
    f32x4 ol[2];
    float slope2 = 0.f;
    if (WIN) {
        const float sk = p.swa_sink[l * 4 + hq] * 1.4426950408889634f;
        mrun[0] = mrun[1] = sk; ol[0] = ol[1] = (f32x4){1.f, 1.f, 1.f, 1.f};
        slope2 = exp2f(-2.f * (float)(hq + 1)) * 1.4426950408889634f;
    } else { mrun[0] = mrun[1] = -1e30f; ol[0] = ol[1] = (f32x4){0.f, 0.f, 0.f, 0.f}; }
    const bf16x8 ones8 = __builtin_bit_cast(bf16x8, (u32x4){0x3F803F80u, 0x3F803F80u, 0x3F803F80u, 0x3F803F80u});
    const bf16_t* kbase = zb + OFF + 256 + g * 64;
    const bf16_t* vbase = zb + OFF + 384 + g * 64;
    u32x4 rk[2], rv[2];
    const int kkey = tid >> 2, kc = tid & 3;
    auto gload = [&](int kt) __attribute__((always_inline)) {
        const bf16_t* kp = kbase + (size_t)(kt * 64 + kkey) * DIN + kc * 16;
        rk[0] = *(const u32x4*)kp; rk[1] = *(const u32x4*)(kp + 8);
        const bf16_t* vp = vbase + (size_t)(kt * 64 + kkey) * DIN + kc * 16;
        rv[0] = *(const u32x4*)vp; rv[1] = *(const u32x4*)(vp + 8);
    };
    auto swrite = [&](int buf) __attribute__((always_inline)) {
        bf16_t* kd = Ks + (buf * 64 + kkey) * ALD + kc * 16;
        *(u32x4*)kd = rk[0]; *(u32x4*)(kd + 8) = rk[1];
        bf16_t* vd = Vt + (buf * 64 + kkey) * ALD + kc * 16;
        *(u32x4*)vd = rv[0]; *(u32x4*)(vd + 8) = rv[1];
    };
    __syncthreads();
    gload(kt0); swrite(0);
    __syncthreads();
    for (int kt = kt0; kt < kt1; ++kt) {
        const int buf = (kt - kt0) & 1;
        if (kt + 1 < kt1) gload(kt + 1);
        f32x4 st[4][2];
#pragma unroll
        for (int m = 0; m < 4; ++m)
#pragma unroll
            for (int n = 0; n < 2; ++n) st[m][n] = (f32x4){0.f, 0.f, 0.f, 0.f};
#pragma unroll
        for (int ks = 0; ks < 2; ++ks)
#pragma unroll
            for (int m = 0; m < 4; ++m) {
                const bf16x8 kf = *(const bf16x8*)(Ks + (buf * 64 + 16 * m + fr) * ALD + 32 * ks + 8 * fq);
#pragma unroll
                for (int n = 0; n < 2; ++n) st[m][n] = __builtin_amdgcn_mfma_f32_16x16x32_bf16(kf, qf[n][ks], st[m][n], 0, 0, 0);
            }
        if (WIN) {
#pragma unroll
            for (int m = 0; m < 4; ++m)
#pragma unroll
                for (int n = 0; n < 2; ++n)
#pragma unroll
                    for (int j = 0; j < 4; ++j) {
                        const int dist = abs((tw + 16 * n + fr) - (kt * 64 + 16 * m + 4 * fq + j));
                        st[m][n][j] = dist <= 128 ? st[m][n][j] - slope2 * (float)dist : -1e30f;
                    }
        }
#pragma unroll
        for (int n = 0; n < 2; ++n) {
            float mt = st[0][n][0];
#pragma unroll
            for (int m = 0; m < 4; ++m)
#pragma unroll
                for (int j = 0; j < 4; ++j) mt = fmaxf(mt, st[m][n][j]);
            mt = fmaxf(mt, __shfl_xor(mt, 16)); mt = fmaxf(mt, __shfl_xor(mt, 32));
            const float mn = fmaxf(mrun[n], mt);
            if (__builtin_amdgcn_ballot_w64(mn != mrun[n]) != 0) {
                const float alpha = __builtin_amdgcn_exp2f(mrun[n] - mn);
                ol[n] = ol[n] * alpha;
#pragma unroll
                for (int dm = 0; dm < 4; ++dm) ot[dm][n] = ot[dm][n] * alpha;
            }
            mrun[n] = mn;
#pragma unroll
            for (int m = 0; m < 4; ++m)
#pragma unroll
                for (int j = 0; j < 4; ++j) st[m][n][j] = __builtin_amdgcn_exp2f(st[m][n][j] - mn);
        }
#pragma unroll
        for (int kk = 0; kk < 2; ++kk) {
            bf16x8 pf[2];
#pragma unroll
            for (int n = 0; n < 2; ++n) {
                u32x4 u;
                u[0] = pk2(st[2 * kk][n][0], st[2 * kk][n][1]); u[1] = pk2(st[2 * kk][n][2], st[2 * kk][n][3]);
                u[2] = pk2(st[2 * kk + 1][n][0], st[2 * kk + 1][n][1]); u[3] = pk2(st[2 * kk + 1][n][2], st[2 * kk + 1][n][3]);
                pf[n] = __builtin_bit_cast(bf16x8, u);
            }
#pragma unroll
            for (int n = 0; n < 2; ++n) ol[n] = __builtin_amdgcn_mfma_f32_16x16x32_bf16(ones8, pf[n], ol[n], 0, 0, 0);
#pragma unroll
            for (int dm = 0; dm < 4; ++dm) {
                const bf16_t* vp = Vt + (buf * 64 + 16 * dm + fr) * ALD + 32 * kk + 4 * fq;
                const u32x2 v0 = *(const u32x2*)vp, v1 = *(const u32x2*)(vp + 16);
                const bf16x8 vf = __builtin_bit_cast(bf16x8, (u32x4){v0[0], v0[1], v1[0], v1[1]});
#pragma unroll
                for (int n = 0; n < 2; ++n) ot[dm][n] = __builtin_amdgcn_mfma_f32_16x16x32_bf16(vf, pf[n], ot[dm][n], 0, 0, 0);
            }
        }
        if (kt + 1 < kt1) swrite(buf ^ 1);
        __syncthreads();
    }
#pragma unroll
    for (int n = 0; n < 2; ++n) {
        const float il = 1.f / ol[n][0];
        bf16_t* zr = zb + (size_t)(tw + 16 * n + fr) * DIN + OFF + hq * 64 + 4 * fq;
#pragma unroll
        for (int dm = 0; dm < 4; ++dm) {
            const u32x2 gu = *(const u32x2*)(zr + 512 + 16 * dm);
            float gv[4] = {__uint_as_float(gu[0] << 16), __uint_as_float(gu[0] & 0xffff0000u), __uint_as_float(gu[1] << 16), __uint_as_float(gu[1] & 0xffff0000u)};
            float ov[4];
#pragma unroll
            for (int j = 0; j < 4; ++j) ov[j] = ot[dm][n][j] * il * gv[j] * sigm(gv[j]);
            u32x2 o2; o2[0] = pk2(ov[0], ov[1]); o2[1] = pk2(ov[2], ov[3]);
            if (!dry) *(u32x2*)(zr + 16 * dm) = o2;
        }
    }
}

DEVI void gbar(unsigned* ctr, unsigned target) {
    asm volatile("s_waitcnt vmcnt(0)" ::: "memory");
    __syncthreads();
    if (threadIdx.x == 0) {
        __builtin_amdgcn_fence(__ATOMIC_RELEASE, "agent");
        asm volatile("s_waitcnt vmcnt(0)" ::: "memory");
        (void)__hip_atomic_fetch_add(ctr, 1u, __ATOMIC_RELAXED, __HIP_MEMORY_SCOPE_AGENT);
        while (__hip_atomic_load(ctr, __ATOMIC_RELAXED, __HIP_MEMORY_SCOPE_AGENT) < target) __builtin_amdgcn_s_sleep(1);
        __builtin_amdgcn_fence(__ATOMIC_ACQUIRE, "agent");
        asm volatile("s_waitcnt vmcnt(0)" ::: "memory");
    }
    __syncthreads();
}

enum { PH_CONVW, PH_ROWNORM, PH_GEMM1, PH_PREP, PH_RWKV, PH_LRU, PH_ATTNB, PH_ATTND, PH_POST, PH_GEMM2, PH_FINAL };
#ifndef MK_MULTI
#define MK_MULTI 0
#endif
#ifndef PROBE_PREP
#define PROBE_PREP 0
#endif
#ifndef PROBE_MIX
#define PROBE_MIX 0
#endif
#ifndef PROBE_G2
#define PROBE_G2 0
#endif
#if MK_MULTI
template <int PH>
__global__ void __launch_bounds__(256) kph(Params p, int l, int nitems) {
    extern __shared__ __attribute__((aligned(16))) char smem[];
    for (int item = blockIdx.x; item < nitems; item += gridDim.x) {
        if (PH == PH_CONVW) ph_convw(p, item, smem);
        if (PH == PH_ROWNORM) ph_rownorm(p, l, item);
        if (PH == PH_GEMM1) { if (item == (int)blockIdx.x) ph_gemm_all<0>(p, l, blockIdx.x, gridDim.x, smem); }
        if (PH == PH_PREP) ph_prep(p, l, item, smem);
        if (PH == PH_RWKV) ph_rwkv_scan(p, l, item, smem);
        if (PH == PH_LRU) ph_lru_scan(p, l, item);
        if (PH == PH_ATTNB) ph_attn_naive<0>(p, l, item);
        if (PH == PH_ATTND) ph_attn_naive<1>(p, l, item);
        if (PH == PH_POST) { if (item == (int)blockIdx.x) ph_post_all(p, l, blockIdx.x, gridDim.x); }
        if (PH == PH_GEMM2) { if (item == (int)blockIdx.x) ph_gemm_all<1>(p, l, blockIdx.x, gridDim.x, smem); }
        if (PH == PH_FINAL) ph_final(p, item);
    }
}
template <int PH>
static void launch(const Params& p, int l, int nitems, int lds, hipStream_t stream) {
    if (lds > 48 * 1024) (void)hipFuncSetAttribute((const void*)kph<PH>, hipFuncAttributeMaxDynamicSharedMemorySize, lds);
    int grid = nitems < 65536 ? nitems : 65536;
    hipLaunchKernelGGL(kph<PH>, dim3(grid), dim3(256), lds, stream, p, l, nitems);
}
#else
constexpr int MIX_ITEMS = 80 + 2560 + 2560;
__global__ void __launch_bounds__(256, 2) mega(Params p) {
    extern __shared__ __attribute__((aligned(16))) char smem[];
    __shared__ int s_item;
    cg::grid_group grid = cg::this_grid();
    const int G = gridDim.x, bid = blockIdx.x;
    unsigned nbar = 0;
    if (bid == 0 && threadIdx.x < 64) ws_ctr(p)[threadIdx.x] = 0;
    for (int it = bid; it < CW_ITEMS; it += G) ph_convw(p, it, smem);
    grid.sync();
    for (int l = 0; l < NL; ++l) {
        if (l == 0) {
            for (int it = bid; it < NTOK / 4; it += G) ph_rownorm(p, l, it);
            gbar(ws_gbar(p), (nbar += (unsigned)G));
        }
        ph_gemm_all<0>(p, l, bid, G, smem);
        gbar(ws_gbar(p), (nbar += (unsigned)G));
#if PROBE_PREP
        for (int it = bid; it < NTOK / 32; it += G) ph_prep(p, l, it, smem, true);
#endif
        for (int it = bid; it < NTOK / 32; it += G) ph_prep(p, l, it, smem);
        gbar(ws_gbar(p), (nbar += (unsigned)G));
#if PROBE_MIX
        for (int rep = 0; rep < 2; ++rep) {
        const bool dry = rep == 0;
        int* ctrp = &ws_ctr(p)[l + 4 * rep];
#else
        {
        const bool dry = false;
        int* ctrp = &ws_ctr(p)[l];
#endif
        for (int it = bid; it < 240; it += G) ph_rwkv_scan(p, l, it, smem, dry);
        for (;;) {
            __syncthreads();
            if (threadIdx.x == 0) s_item = atomicAdd(ctrp, 1);
            __syncthreads();
            const int it = s_item;
            if (it >= MIX_ITEMS) break;
            if (it < 80) ph_lru_scan(p, l, it, dry);
            else if (it < 2640) ph_attn<0>(p, l, it - 80, smem, dry);
            else ph_attn<1>(p, l, it - 2640, smem, dry);
        }
        }
        gbar(ws_gbar(p), (nbar += (unsigned)G));
        ph_post_all(p, l, bid, G);
        gbar(ws_gbar(p), (nbar += (unsigned)G));
#if PROBE_G2
        ph_gemm_all<1>(p, l, bid, G, smem, true);
#endif
        ph_gemm_all<1>(p, l, bid, G, smem);
        gbar(ws_gbar(p), (nbar += (unsigned)G));
    }
    for (int it = bid; it < NTOK / 4; it += G) ph_final(p, it);
}
#endif

extern "C" void kernel_launch(void* const* d_in, const int* in_sizes, int n_in, void* d_out, int out_size, void* d_ws, size_t ws_size,
                              hipStream_t stream) {
    Params p{};
    const float* const* in = (const float* const*)d_in;
    p.x_prompt = in[0]; p.x_sample = in[1]; p.norm_g = in[2]; p.w_in = in[3]; p.w_out = in[4]; p.rwkv_shift = in[5]; p.rwkv_w0 = in[6];
    p.rwkv_w_up = in[7]; p.rwkv_a0 = in[8]; p.rwkv_a_up = in[9]; p.rwkv_k_k = in[10]; p.rwkv_k_a = in[11]; p.rwkv_r_k = in[12];
    p.rwkv_ln_g = in[13]; p.rwkv_ln_b = in[14]; p.attn_q_norm = in[15]; p.attn_k_norm = in[16]; p.lru_conv_w = in[17]; p.lru_conv_b = in[18];
    p.lru_gate_w = in[19]; p.lru_gate_b = in[20]; p.lru_lambda = in[21]; p.swa_sink = in[22]; p.final_g = in[23];
    p.out = (float*)d_out;
    p.ws = (char*)d_ws;
    if (WS_NEED > ws_size) { fprintf(stderr, "workspace too small: need %zu have %zu\n", (size_t)WS_NEED, ws_size); }

#if MK_MULTI
    launch<PH_CONVW>(p, 0, CW_ITEMS, 64 * 65 * 4, stream);
    for (int l = 0; l < NL; ++l) {
        if (l == 0) launch<PH_ROWNORM>(p, l, NTOK / 4, 0, stream);
        launch<PH_GEMM1>(p, l, (NTOK / GBM) * (DIN / GBN), GEMM_LDS, stream);
        launch<PH_PREP>(p, l, NTOK / 32, PREP_LDS, stream);
        launch<PH_RWKV>(p, l, 240, 4 * 5120, stream);
        launch<PH_LRU>(p, l, 80, 0, stream);
        launch<PH_ATTNB>(p, l, 1280, 0, stream);
        launch<PH_ATTND>(p, l, 1280, 0, stream);
        launch<PH_POST>(p, l, NTOK / 8, 0, stream);
        launch<PH_GEMM2>(p, l, (NTOK / GBM) * (DM / GBN), GEMM_LDS, stream);
    }
    launch<PH_FINAL>(p, 0, NTOK / 4, 0, stream);
#else
    constexpr size_t kDynLds = GEMM_LDS;
    static int grid_blocks = 0;
    if (!grid_blocks) {
        (void)hipFuncSetAttribute((const void*)mega, hipFuncAttributeMaxDynamicSharedMemorySize, (int)kDynLds);
        int dev = 0, cus = 0, per_cu = 0;
        (void)hipGetDevice(&dev);
        (void)hipDeviceGetAttribute(&cus, hipDeviceAttributeMultiprocessorCount, dev);
        (void)hipOccupancyMaxActiveBlocksPerMultiprocessor(&per_cu, mega, 256, kDynLds);
        if (per_cu < 1) per_cu = 1;
        grid_blocks = cus * per_cu;
    }
    (void)hipMemsetAsync((char*)d_ws + WO_GBAR, 0, 256, stream);
    void* args[] = {&p};
    hipError_t e = hipLaunchCooperativeKernel((void*)mega, dim3(grid_blocks), dim3(256), args, kDynLds, stream);
    if (e != hipSuccess) fprintf(stderr, "cooperative launch failed: %s (grid %d)\n", hipGetErrorString(e), grid_blocks);
#endif
}
```
